# Optimizing an MI355X kernel written in HIP

```python
import math
import jax
import jax.numpy as jnp
from jax import lax
import numpy as np

D_MODEL = 1024
BATCH = 4
SEQ = 4096
DEPTH = 2

GRID_W = 64
CTX_LEN = 256
N_MIXERS = 2
N_ATTN_LAYERS = (DEPTH + 1) // 2
N_LRU_LAYERS = DEPTH // 2
HEAD_DIM = 64
N_HEADS = 16
N_KV_HEADS = 4
GROUP = N_HEADS // N_KV_HEADS
WINDOW = 128
ATTN_BLOCK = 128
ROPE_THETA = 10000.0
D_RNN = 1280
LRU_BLOCKS = 16
LRU_BLOCK_W = D_RNN // LRU_BLOCKS
CONV_W = 4
CONV_LEFT = 2
LRU_C = 8.0
N_EXPERTS = 64
TOP_K = 8
N_GROUPS = 8
TOPK_GROUPS = 4
D_EXPERT = 256
ROUTED_SCALE = 2.5
MOE_BLOCK = 128
RMS_EPS = 1e-6

kernel_name = 'hybrid_swa_sink_rglru_moe_dit'


def rms_norm(x, g):
    xf = x.astype(jnp.float32)
    y = xf * lax.rsqrt(jnp.mean(xf * xf, axis=-1, keepdims=True) + RMS_EPS)
    return (y * g.astype(jnp.float32)).astype(x.dtype)


def modulate(h, shift, scale):
    return h * (1 + scale) + shift


def swiglu(t, wg, wu, wd):
    return (jax.nn.silu(t @ wg) * (t @ wu)) @ wd


def rope_angles(n_tokens):
    rows = n_tokens // GRID_W
    row = jnp.repeat(jnp.arange(rows), GRID_W).astype(jnp.float32)
    col = jnp.tile(jnp.arange(GRID_W), rows).astype(jnp.float32)
    n_freq = HEAD_DIM // 4
    inv = jnp.exp(-math.log(ROPE_THETA) * jnp.arange(n_freq, dtype=jnp.float32) / n_freq)
    return row[:, None] * inv, col[:, None] * inv


def rotate_axis(u, ang):
    u1, u2 = jnp.split(u, 2, axis=-1)
    shape = (1, ang.shape[0]) + (1,) * (u.ndim - 3) + (ang.shape[-1],)
    cos = jnp.cos(ang).reshape(shape)
    sin = jnp.sin(ang).reshape(shape)
    return jnp.concatenate([u1 * cos - u2 * sin, u2 * cos + u1 * sin], axis=-1)


def rope_2d(u, ang_row, ang_col):
    ur, uc = jnp.split(u, 2, axis=-1)
    return jnp.concatenate([rotate_axis(ur, ang_row), rotate_axis(uc, ang_col)], axis=-1)


def softmax_with_sink(s, sink):
    full = jnp.concatenate([s, jnp.broadcast_to(sink, s.shape[:-1] + (1,))], axis=-1)
    return jax.nn.softmax(full, axis=-1)[..., :-1]


def window_gqa_mixer(h, hc, w_qkv, w_o, sink, ang_row, ang_col, need_ctx):
    f32 = jnp.float32
    B, S, _ = h.shape
    qd = N_HEADS * HEAD_DIM
    kd = N_KV_HEADS * HEAD_DIM
    scale = HEAD_DIM ** -0.5

    def project(t):
        L = t.shape[1]
        p = (t @ w_qkv).astype(f32)
        q = p[..., :qd].reshape(B, L, N_KV_HEADS, GROUP, HEAD_DIM)
        k = p[..., qd:qd + kd].reshape(B, L, N_KV_HEADS, HEAD_DIM)
        v = p[..., qd + kd:].reshape(B, L, N_KV_HEADS, HEAD_DIM)
        return q, k, v

    q, k, v = project(h)
    qc, kc, vc = project(hc)
    q = rope_2d(q, ang_row, ang_col) * scale
    k = rope_2d(k, ang_row, ang_col)
    qc = qc * scale
    sink_b = sink.astype(f32).reshape(1, N_KV_HEADS, GROUP, 1, 1)

    pad = ((0, 0), (WINDOW, WINDOW), (0, 0), (0, 0))
    k_pad = jnp.pad(k, pad)
    v_pad = jnp.pad(v, pad)
    span = ATTN_BLOCK + 2 * WINDOW
    n_blocks = S // ATTN_BLOCK
    q_off = jnp.arange(ATTN_BLOCK)
    k_off = jnp.arange(span) - WINDOW

    def block(n):
        start = n * ATTN_BLOCK
        qb = lax.dynamic_slice_in_dim(q, start, ATTN_BLOCK, axis=1)
        kb = lax.dynamic_slice_in_dim(k_pad, start, span, axis=1)
        vb = lax.dynamic_slice_in_dim(v_pad, start, span, axis=1)
        ipos = start + q_off
        jpos = start + k_off
        valid = (jnp.abs(jpos[None, :] - ipos[:, None]) <= WINDOW) & (jpos[None, :] >= 0) & (jpos[None, :] < S)
        s_loc = jnp.where(valid, jnp.einsum('bqkgd,bskd->bkgqs', qb, kb), -jnp.inf)
        s_ctx = jnp.einsum('bqkgd,bckd->bkgqc', qb, kc)
        p = softmax_with_sink(jnp.concatenate([s_loc, s_ctx], axis=-1), sink_b)
        return (jnp.einsum('bkgqs,bskd->bqkgd', p[..., :span], vb)
                + jnp.einsum('bkgqc,bckd->bqkgd', p[..., span:], vc))

    o = lax.map(block, jnp.arange(n_blocks))
    o = jnp.moveaxis(o, 0, 1).reshape(B, S, qd)
    y = o.astype(h.dtype) @ w_o
    yc = None
    if need_ctx:
        s = jnp.einsum('bqkgd,bskd->bkgqs', qc, kc)
        p = softmax_with_sink(s, sink_b)
        oc = jnp.einsum('bkgqs,bskd->bqkgd', p, vc).reshape(B, hc.shape[1], qd)
        yc = oc.astype(hc.dtype) @ w_o
    return y, yc


def depthwise_conv(t, w, b):
    L = t.shape[1]
    tp = jnp.pad(t, ((0, 0), (CONV_LEFT, CONV_W - 1 - CONV_LEFT), (0, 0)))
    out = tp[:, 0:L] * w[0] + b
    for j in range(1, CONV_W):
        out = out + tp[:, j:j + L] * w[j]
    return out


def rglru_gates(u, wa, ba, wx, bx, lam):
    f32 = jnp.float32
    uf = u.astype(f32)
    ub = uf.reshape(uf.shape[:-1] + (LRU_BLOCKS, LRU_BLOCK_W))
    r = jax.nn.sigmoid(jnp.einsum('blnc,ncd->blnd', ub, wa.astype(f32)).reshape(uf.shape) + ba.astype(f32))
    i_g = jax.nn.sigmoid(jnp.einsum('blnc,ncd->blnd', ub, wx.astype(f32)).reshape(uf.shape) + bx.astype(f32))
    log_a = -LRU_C * r * jax.nn.softplus(-lam.astype(f32))
    a = jnp.exp(log_a)
    b = jnp.sqrt(-jnp.expm1(2.0 * log_a)) * (i_g * uf)
    return a, b


def _lin_combine(left, right):
    a_l, b_l = left
    a_r, b_r = right
    return a_l * a_r, a_r * b_l + b_r


def linear_recurrence(a, b, h0, reverse):
    if reverse:
        b = b.at[:, -1].add(a[:, -1] * h0)
    else:
        b = b.at[:, 0].add(a[:, 0] * h0)
    return lax.associative_scan(_lin_combine, (a, b), reverse=reverse, axis=1)[1]


def rglru_mixer(h, hc, w_in, conv_w, conv_b, wa, ba, wx, bx, lam, w_out, need_ctx):
    f32 = jnp.float32
    B = h.shape[0]
    proj = h @ w_in
    gate = jax.nn.gelu(proj[..., :D_RNN]).astype(f32)
    u = depthwise_conv(proj[..., D_RNN:], conv_w, conv_b)
    proj_c = hc @ w_in
    u_c = depthwise_conv(proj_c[..., D_RNN:], conv_w, conv_b)
    zero = jnp.zeros((B, D_RNN), f32)
    h_lat = []
    h_ctx = []
    for d, reverse in ((0, False), (1, True)):
        a_c, b_c = rglru_gates(u_c, wa[d], ba[d], wx[d], bx[d], lam[d])
        hs_c = linear_recurrence(a_c, b_c, zero, reverse)
        final_c = hs_c[:, 0] if reverse else hs_c[:, -1]
        a, b = rglru_gates(u, wa[d], ba[d], wx[d], bx[d], lam[d])
        h_lat.append(linear_recurrence(a, b, final_c, reverse))
        h_ctx.append(hs_c)
    y = ((h_lat[0] + h_lat[1]) * gate).astype(h.dtype) @ w_out
    yc = None
    if need_ctx:
        gate_c = jax.nn.gelu(proj_c[..., :D_RNN]).astype(f32)
        yc = ((h_ctx[0] + h_ctx[1]) * gate_c).astype(hc.dtype) @ w_out
    return y, yc


def moe_ffn(t, router_w, router_bias, w_gate, w_up, w_down, s_gate, s_up, s_down):
    f32 = jnp.float32
    T, D = t.shape
    scores = jax.nn.sigmoid(t.astype(f32) @ router_w.astype(f32))
    sel = scores + router_bias.astype(f32)
    per_group = N_EXPERTS // N_GROUPS
    group_score = lax.top_k(sel.reshape(T, N_GROUPS, per_group), 2)[0].sum(-1)
    _, top_groups = lax.top_k(group_score, TOPK_GROUPS)
    group_mask = jax.nn.one_hot(top_groups, N_GROUPS, dtype=f32).sum(1) > 0
    expert_mask = jnp.repeat(group_mask, per_group, axis=1)
    _, idx = lax.top_k(jnp.where(expert_mask, sel, -jnp.inf), TOP_K)
    w = jnp.take_along_axis(scores, idx, axis=1)
    w = w / jnp.sum(w, axis=-1, keepdims=True) * ROUTED_SCALE

    A = T * TOP_K
    e_flat = idx.reshape(A)
    tok_flat = jnp.arange(A, dtype=jnp.int32) // TOP_K
    order = jnp.argsort(e_flat)
    e_sorted = e_flat[order]
    tok_sorted = tok_flat[order]
    w_sorted = w.reshape(A)[order]
    counts = jnp.bincount(e_flat, length=N_EXPERTS)
    padded = (counts + MOE_BLOCK - 1) // MOE_BLOCK * MOE_BLOCK
    pad_end = jnp.cumsum(padded)
    pad_start = pad_end - padded
    start = jnp.cumsum(counts) - counts
    dest = pad_start[e_sorted] + jnp.arange(A, dtype=jnp.int32) - start[e_sorted]
    n_blocks = -(-A // MOE_BLOCK) + N_EXPERTS
    P = n_blocks * MOE_BLOCK
    tok_buf = jnp.full((P,), T, jnp.int32).at[dest].set(tok_sorted)
    w_buf = jnp.zeros((P,), f32).at[dest].set(w_sorted)
    block_expert = jnp.minimum(
        jnp.searchsorted(pad_end, jnp.arange(n_blocks, dtype=jnp.int32) * MOE_BLOCK, side='right'),
        N_EXPERTS - 1)
    t_pad = jnp.concatenate([t, jnp.zeros((1, D), t.dtype)], axis=0)

    def expert_block(args):
        tok_b, w_b, e = args
        yb = swiglu(t_pad[tok_b], w_gate[e], w_up[e], w_down[e])
        return yb.astype(f32) * w_b[:, None]

    y = lax.map(expert_block, (tok_buf.reshape(n_blocks, MOE_BLOCK),
                               w_buf.reshape(n_blocks, MOE_BLOCK), block_expert))
    routed = jnp.zeros((T + 1, D), f32).at[tok_buf].add(y.reshape(P, D))[:T]
    shared = swiglu(t, s_gate, s_up, s_down).astype(f32)
    return (routed + shared).astype(t.dtype)


def setup_inputs(seed: int = 0) -> dict:
    key = jax.random.key(seed)
    ks = jax.random.split(key, 32)
    f32 = jnp.float32

    def nrm(k, shape, scale):
        return jax.random.normal(k, shape, f32) * scale

    qkv_cols = (N_HEADS + 2 * N_KV_HEADS) * HEAD_DIM
    u = jax.random.uniform(ks[18], (N_LRU_LAYERS, 2, D_RNN), f32, 0.9, 0.999)
    return {
        'x': nrm(ks[0], (BATCH, SEQ, D_MODEL), 1.0),
        'c': nrm(ks[1], (BATCH, D_MODEL), 1.0),
        'ctx': nrm(ks[2], (BATCH, CTX_LEN, D_MODEL), 1.0),
        'c_ctx': nrm(ks[3], (D_MODEL,), 1.0),
        'ada_w': nrm(ks[4], (DEPTH, D_MODEL, 6 * D_MODEL), 0.5 * D_MODEL ** -0.5),
        'ada_b': nrm(ks[5], (DEPTH, 6 * D_MODEL), 0.02),
        'norm1_g': 1.0 + nrm(ks[6], (DEPTH, D_MODEL), 0.05),
        'norm2_g': 1.0 + nrm(ks[7], (DEPTH, D_MODEL), 0.05),
        'attn_w_qkv': nrm(ks[8], (N_ATTN_LAYERS, D_MODEL, qkv_cols), D_MODEL ** -0.5),
        'attn_w_o': nrm(ks[9], (N_ATTN_LAYERS, N_HEADS * HEAD_DIM, D_MODEL), (N_HEADS * HEAD_DIM) ** -0.5),
        'attn_sink': nrm(ks[10], (N_ATTN_LAYERS, N_HEADS), 0.5),
        'lru_w_in': nrm(ks[11], (N_LRU_LAYERS, D_MODEL, 2 * D_RNN), D_MODEL ** -0.5),
        'lru_conv_w': nrm(ks[12], (N_LRU_LAYERS, CONV_W, D_RNN), CONV_W ** -0.5),
        'lru_conv_b': nrm(ks[13], (N_LRU_LAYERS, D_RNN), 0.02),
        'lru_wa': nrm(ks[14], (N_LRU_LAYERS, 2, LRU_BLOCKS, LRU_BLOCK_W, LRU_BLOCK_W), LRU_BLOCK_W ** -0.5),
        'lru_ba': nrm(ks[15], (N_LRU_LAYERS, 2, D_RNN), 0.02),
        'lru_wx': nrm(ks[16], (N_LRU_LAYERS, 2, LRU_BLOCKS, LRU_BLOCK_W, LRU_BLOCK_W), LRU_BLOCK_W ** -0.5),
        'lru_bx': nrm(ks[17], (N_LRU_LAYERS, 2, D_RNN), 0.02),
        'lru_lam': jnp.log(u) - jnp.log1p(-u),
        'lru_w_out': nrm(ks[19], (N_LRU_LAYERS, D_RNN, D_MODEL), D_RNN ** -0.5),
        'moe_router_w': nrm(ks[20], (DEPTH, D_MODEL, N_EXPERTS), D_MODEL ** -0.5),
        'moe_router_bias': nrm(ks[21], (DEPTH, N_EXPERTS), 0.01),
        'moe_w_gate': nrm(ks[22], (DEPTH, N_EXPERTS, D_MODEL, D_EXPERT), D_MODEL ** -0.5),
        'moe_w_up': nrm(ks[23], (DEPTH, N_EXPERTS, D_MODEL, D_EXPERT), D_MODEL ** -0.5),
        'moe_w_down': nrm(ks[24], (DEPTH, N_EXPERTS, D_EXPERT, D_MODEL), D_EXPERT ** -0.5),
        'shared_w_gate': nrm(ks[25], (DEPTH, D_MODEL, D_EXPERT), D_MODEL ** -0.5),
        'shared_w_up': nrm(ks[26], (DEPTH, D_MODEL, D_EXPERT), D_MODEL ** -0.5),
        'shared_w_down': nrm(ks[27], (DEPTH, D_EXPERT, D_MODEL), D_EXPERT ** -0.5),
        'final_g': 1.0 + nrm(ks[28], (D_MODEL,), 0.05),
    }


def reference(x, c, ctx, c_ctx, ada_w, ada_b, norm1_g, norm2_g, attn_w_qkv, attn_w_o, attn_sink,
              lru_w_in, lru_conv_w, lru_conv_b, lru_wa, lru_ba, lru_wx, lru_bx, lru_lam, lru_w_out,
              moe_router_w, moe_router_bias, moe_w_gate, moe_w_up, moe_w_down,
              shared_w_gate, shared_w_up, shared_w_down, final_g):
    B, S, D = x.shape
    C = ctx.shape[1]
    ang_row, ang_col = rope_angles(S)
    for i in range(DEPTH):
        mod = jax.nn.silu(c) @ ada_w[i] + ada_b[i]
        mod_c = jax.nn.silu(c_ctx) @ ada_w[i] + ada_b[i]
        sh1, sc1, g1, sh2, sc2, g2 = [m[:, None, :] for m in jnp.split(mod, 6, axis=-1)]
        csh1, csc1, cg1, csh2, csc2, cg2 = jnp.split(mod_c, 6, axis=-1)
        need_ctx = i < DEPTH - 1

        h = modulate(rms_norm(x, norm1_g[i]), sh1, sc1)
        hc = modulate(rms_norm(ctx, norm1_g[i]), csh1, csc1)
        j = i // N_MIXERS
        if i % N_MIXERS == 0:
            y, yc = window_gqa_mixer(h, hc, attn_w_qkv[j], attn_w_o[j], attn_sink[j], ang_row, ang_col, need_ctx)
        else:
            y, yc = rglru_mixer(h, hc, lru_w_in[j], lru_conv_w[j], lru_conv_b[j], lru_wa[j], lru_ba[j],
                                lru_wx[j], lru_bx[j], lru_lam[j], lru_w_out[j], need_ctx)
        x = x + g1 * y
        h2 = modulate(rms_norm(x, norm2_g[i]), sh2, sc2)
        moe_args = (moe_router_w[i], moe_router_bias[i], moe_w_gate[i], moe_w_up[i], moe_w_down[i],
                    shared_w_gate[i], shared_w_up[i], shared_w_down[i])
        if need_ctx:
            ctx = ctx + cg1 * yc
            h2c = modulate(rms_norm(ctx, norm2_g[i]), csh2, csc2)
            f = moe_ffn(jnp.concatenate([h2.reshape(B * S, D), h2c.reshape(B * C, D)], axis=0), *moe_args)
            x = x + g2 * f[:B * S].reshape(B, S, D)
            ctx = ctx + cg2 * f[B * S:].reshape(B, C, D)
        else:
            f = moe_ffn(h2.reshape(B * S, D), *moe_args)
            x = x + g2 * f.reshape(B, S, D)
    return rms_norm(x, final_g)
```

```cpp
#include <hip/hip_runtime.h>
#include <stdint.h>
#include <cstdio>

namespace {
typedef unsigned short bf16_t;
constexpr int D = 1024, NB = 4, S = 4096, C = 256, TL = NB * S, TC = NB * C, T0 = TL + TC;
constexpr int NH = 16, NKV = 4, HD = 64, KD = 256, QKVN = 1536;
constexpr int DR = 1280, NBLK = 16, BW = 80;
constexpr int NE = 64, TOPK = 8, DE = 256;
constexpr float RMS_EPS = 1e-6f;
constexpr float LOG2E = 1.4426950408889634f;
constexpr float QSCALE = 0.125f * LOG2E;
constexpr int NTHREADS = 256;
constexpr int REP_PREP = 1, REP_QKV = 1, REP_ATTN = 1, REP_GATEUP = 1, REP_INPROJ = 1, REP_LRU1 = 1, REP_NORM2 = 1;
constexpr int LDS_U = 0, LDS_A = 13312, LDS_B0 = LDS_A + 20480, LDS_B1 = LDS_B0 + 20480, LDS_LRU_END = LDS_B1 + 20480;

constexpr size_t MiB = 1u << 20;
constexpr size_t WS_CTL = 0, CTL_BYTES = 1 * MiB;
constexpr size_t CTL_BAR = 0;
constexpr size_t CTL_TICKET = 16384;
constexpr size_t CTL_CNT = 32768;
constexpr size_t CTL_MOD = 65536;
constexpr size_t WS_ROPE = 1 * MiB + 512 * 1024;
constexpr size_t WS_SUM = 2 * MiB;
constexpr size_t WS_AE = 8 * MiB;
constexpr size_t WS_AW = WS_AE + 640 * 1024;
constexpr size_t WS_APOS = WS_AW + 640 * 1024;
constexpr size_t WS_LIST = 10 * MiB;
constexpr size_t WS_XC = 15 * MiB;
constexpr size_t WS_WQKV = 19 * MiB, WS_WO = 22 * MiB, WS_WIN = 24 * MiB, WS_WOUT = 29 * MiB, WS_WGATES = 32 * MiB, WS_WROUTER = 33 * MiB, WS_WSH = 34 * MiB;
constexpr size_t WSH_LAYER = 1536 * 1024, WSH_D = 1024 * 1024;
constexpr size_t WMOE_D = 64 * MiB;
constexpr size_t WS_WMOE = 37 * MiB;
constexpr size_t WS_H = 138 * MiB;
constexpr size_t WS_ACT = 172 * MiB;
constexpr size_t WS_ACTS = 240 * MiB;
constexpr size_t WS_BIG = 249 * MiB;
constexpr size_t WS_Q = WS_BIG, WS_K = WS_BIG + 34 * MiB, WS_V = WS_K + 9 * MiB, WS_O = WS_V + 9 * MiB;
constexpr size_t WS_G = WS_BIG, WS_PU = WS_BIG + 40 * MiB, WS_AB = WS_BIG + 83 * MiB;
constexpr size_t WS_CARRY = WS_BIG + 84 * MiB;
constexpr size_t WS_LC8 = 1 * MiB + 640 * 1024;
constexpr size_t WS_END = 521 * MiB;

struct Params {
    const float* in[29];
    float* out;
    unsigned char* ws;
    int ph_lo, ph_hi;
};

__device__ __forceinline__ float bf2f(bf16_t h) { return __uint_as_float(((unsigned)h) << 16); }
__device__ __forceinline__ bf16_t f2bf(float f) { unsigned u = __float_as_uint(f); return (bf16_t)((u + 0x7fffu + ((u >> 16) & 1u)) >> 16); }
__device__ __forceinline__ float silu_f(float v) { return v * __builtin_amdgcn_rcpf(1.f + __builtin_amdgcn_exp2f(-LOG2E * v)); }
__device__ __forceinline__ float gelu_tanh(float v) { const float u = 0.7978845608028654f * (v + 0.044715f * v * v * v); return v * __builtin_amdgcn_rcpf(1.f + __builtin_amdgcn_exp2f(-2.f * LOG2E * u)); }
__device__ __forceinline__ float wave_sum(float v) {
#pragma unroll
    for (int o = 32; o > 0; o >>= 1) v += __shfl_xor(v, o);
    return v;
}
__device__ __forceinline__ int mod_row(int r) { return r < TL ? (r >> 12) : 4; }

#define XB_TMO      128
#define XB_XCNT(j)  (256  + 64 * (j))
#define XB_XSUB(j)  (1280 + 64 * (j))
#define XB_XGEN(j)  (2304 + 64 * (j))
#define XB_TOP      3328
#define XB_TOPGEN   3392
#define XCD_BAR_WORDS 3456
#define XB_SPIN_CAP (1u << 22)
#define LAS __attribute__((address_space(3)))
__device__ __forceinline__ unsigned xb_ld(unsigned* p)              { return __hip_atomic_load(p, __ATOMIC_RELAXED, __HIP_MEMORY_SCOPE_AGENT); }
__device__ __forceinline__ unsigned xb_add(unsigned* p, unsigned v) { return __hip_atomic_fetch_add(p, v, __ATOMIC_RELAXED, __HIP_MEMORY_SCOPE_AGENT); }
__device__ __forceinline__ unsigned xb_xcc_id() { return (unsigned)__builtin_amdgcn_s_getreg((3 << 11) | 20) & 0xFu; }
#define XB_SPIN(cond, bar) do { unsigned _sp = 0; while (cond) { __builtin_amdgcn_s_sleep(1); \
    if ((++_sp & 255u) == 0u) { if (xb_ld(&(bar)[XB_TMO])) break; if (_sp > XB_SPIN_CAP) { atomicAdd(&(bar)[XB_TMO], 1u); break; } } } } while (0)
struct XcdBarrier { unsigned* bar; unsigned x; volatile unsigned* st; };
__device__ __forceinline__ XcdBarrier xcd_barrier_post(unsigned* bar, volatile unsigned* st) {
    XcdBarrier b; b.bar = bar; b.x = xb_xcc_id(); b.st = st;
    if (threadIdx.x == 0) (void)xb_add(&bar[XB_XCNT(b.x)], 1u);
    return b;
}
__device__ __forceinline__ void xcd_barrier_complete(unsigned* bar, unsigned x, unsigned& nloc, unsigned& nx) {
    const unsigned G = gridDim.x * gridDim.y * gridDim.z;
    unsigned sum, cnt, mine, sp = 0u;
    for (;;) {
        sum = 0u; cnt = 0u; mine = 0u;
#pragma unroll
        for (unsigned j = 0; j < 16; ++j) { const unsigned c = xb_ld(&bar[XB_XCNT(j)]); sum += c; cnt += (c > 0u) ? 1u : 0u; mine = (j == x) ? c : mine; }
        if (sum == G) break;
        __builtin_amdgcn_s_sleep(1);
        if ((++sp & 255u) == 0u) { if (xb_ld(&bar[XB_TMO])) break; if (sp > XB_SPIN_CAP) { atomicAdd(&bar[XB_TMO], 1u); break; } }
    }
    nloc = mine > 0u ? mine : 1u; nx = cnt > 0u ? cnt : 1u;
}
__device__ __forceinline__ void xcd_barrier(const XcdBarrier& b) {
    asm volatile("s_waitcnt vmcnt(0)" ::: "memory");
    __syncthreads();
    if (threadIdx.x == 0) {
        unsigned* bar = b.bar;
        __builtin_amdgcn_s_waitcnt(0);
        unsigned nloc = b.st[0], nx = b.st[1];
        if (nloc == 0u) { xcd_barrier_complete(bar, b.x, nloc, nx); b.st[0] = nloc; b.st[1] = nx; }
        const unsigned old = xb_add(&bar[XB_XSUB(b.x)], 1u);
        const unsigned gen = old / nloc;
        if (old + 1u == (gen + 1u) * nloc) {
            __builtin_amdgcn_fence(__ATOMIC_RELEASE, "agent");
            asm volatile("s_waitcnt vmcnt(0)" ::: "memory");
            const unsigned og = xb_add(&bar[XB_TOP], 1u);
            const unsigned tg = og / nx;
            if (og + 1u == (tg + 1u) * nx) xb_add(&bar[XB_TOPGEN], 1u);
            else XB_SPIN(xb_ld(&bar[XB_TOPGEN]) == tg, bar);
            __builtin_amdgcn_fence(__ATOMIC_ACQUIRE, "agent");
            xb_add(&bar[XB_XGEN(b.x)], 1u);
            asm volatile("s_waitcnt vmcnt(0)" ::: "memory");
        } else {
            XB_SPIN(xb_ld(&bar[XB_XGEN(b.x)]) == gen, bar);
            __builtin_amdgcn_fence(__ATOMIC_ACQUIRE, "agent");
            asm volatile("s_waitcnt vmcnt(0)" ::: "memory");
        }
    }
    __syncthreads();
}


typedef short bf16x8 __attribute__((ext_vector_type(8)));
typedef float f32x4 __attribute__((ext_vector_type(4)));
typedef unsigned u32x4 __attribute__((ext_vector_type(4)));
typedef unsigned u32x2 __attribute__((ext_vector_type(2)));
typedef LAS unsigned char* ldsp_t;
constexpr int EP_WAVE = 17408;
constexpr int GT_STG = 24576;
template <class RowPtr, class Epi>
__device__ __forceinline__ void mfma_tile(ldsp_t lds, const RowPtr& rp, const bf16_t* Bt, int K, const Epi& ep, int row0, int col0) {
    const int tid = threadIdx.x, lane = tid & 63, wid = __builtin_amdgcn_readfirstlane(tid >> 6), wr = wid >> 1, wc = wid & 1, fr = lane & 15, fq = lane >> 4;
    const int sch = ((tid & 3) ^ ((-(tid >> 4)) & 3)) * 8;
    const bf16_t* ap0 = rp(row0 + (tid >> 2)) + sch;
    const bf16_t* ap1 = rp(row0 + 64 + (tid >> 2)) + sch;
    const bf16_t* bp = Bt + (size_t)(tid >> 2) * K + sch;
    const size_t bstep = (size_t)64 * K;
    const int cterm = ((fq ^ ((-(fr >> 2)) & 3)) << 4);
    const int aoff = (wr * 64 + fr) * 64 + cterm, boff = 8192 + (wc * 128 + fr) * 64 + cterm;
    f32x4 acc[4][8];
#pragma unroll
    for (int m = 0; m < 4; ++m)
#pragma unroll
        for (int n = 0; n < 8; ++n) acc[m][n] = (f32x4){0.f, 0.f, 0.f, 0.f};
#define GT_STAGE(sb, k0) do { const ldsp_t d_ = lds + (sb) + wid * 1024; \
        __builtin_amdgcn_global_load_lds((const unsigned*)(ap0 + (k0)), (LAS unsigned*)(d_), 16, 0, 0); \
        __builtin_amdgcn_global_load_lds((const unsigned*)(ap1 + (k0)), (LAS unsigned*)(d_ + 4096), 16, 0, 0); \
        _Pragma("unroll") for (int i_ = 0; i_ < 4; ++i_) \
            __builtin_amdgcn_global_load_lds((const unsigned*)(bp + i_ * bstep + (k0)), (LAS unsigned*)(d_ + 8192 + i_ * 4096), 16, 0, 0); } while (0)
    const int nt = K >> 5;
    asm volatile("s_waitcnt lgkmcnt(0)" ::: "memory");
    __builtin_amdgcn_s_barrier();
    asm volatile("" ::: "memory");
    GT_STAGE(0, 0);
    GT_STAGE(GT_STG, 32);
    int scur = 0, snx = 2 * GT_STG;
#pragma unroll 1
    for (int t = 0; t < nt; ++t) {
        if (t + 1 < nt) asm volatile("s_waitcnt vmcnt(6)" ::: "memory"); else asm volatile("s_waitcnt vmcnt(0)" ::: "memory");
        __builtin_amdgcn_s_barrier();
        asm volatile("" ::: "memory");
        if (t + 2 < nt) GT_STAGE(snx, (t + 2) * 32);
        const ldsp_t base = lds + scur;
        bf16x8 af[4], bfr[8];
#pragma unroll
        for (int m = 0; m < 4; ++m) af[m] = *(const LAS bf16x8*)(base + aoff + m * 1024);
#pragma unroll
        for (int n = 0; n < 8; ++n) bfr[n] = *(const LAS bf16x8*)(base + boff + n * 1024);
#pragma unroll
        for (int m = 0; m < 4; ++m)
#pragma unroll
            for (int n = 0; n < 8; ++n) acc[m][n] = __builtin_amdgcn_mfma_f32_16x16x32_bf16(bfr[n], af[m], acc[m][n], 0, 0, 0);
        scur = (scur == 2 * GT_STG) ? 0 : scur + GT_STG;
        snx = (snx == 2 * GT_STG) ? 0 : snx + GT_STG;
    }
#undef GT_STAGE
    __syncthreads();
    ep(acc, lds + wid * EP_WAVE, row0 + wr * 64, col0 + wc * 128, lane);
}
typedef float f32x2_t __attribute__((ext_vector_type(2))); typedef __bf16 bf16x2_t __attribute__((ext_vector_type(2)));
__device__ __forceinline__ unsigned pk2(float lo, float hi) { f32x2_t v = {lo, hi}; bf16x2_t b = __builtin_convertvector(v, bf16x2_t); return __builtin_bit_cast(unsigned, b); }
__device__ __forceinline__ void st_bf16x4(bf16_t* p, float a, float b, float c, float d) { uint2 o; o.x = pk2(a, b); o.y = pk2(c, d); *(uint2*)p = o; }

struct RowPlain { const bf16_t* A; int lda; __device__ __forceinline__ const bf16_t* operator()(int r) const { return A + (size_t)r * lda; } };

constexpr int EPB = 272;
constexpr int EPF = 528;
__device__ __forceinline__ void ep_put4(ldsp_t wl, int row, int col, float a, float b, float c, float d) { u32x2 o; o.x = pk2(a, b); o.y = pk2(c, d); *(LAS u32x2*)(wl + row * EPB + col * 2) = o; }
struct MEpiQKV {
    bf16_t *Q, *K, *V; const float* rope;
    __device__ __forceinline__ void operator()(f32x4 (&acc)[4][8], ldsp_t wl, int rbase, int cbase0, int lane) const {
        const int fr = lane & 15, fq = lane >> 4;
#pragma unroll
        for (int hh = 0; hh < 2; ++hh) {
            const int cbase = cbase0 + hh * 64;
            const bool isq = cbase < 1024, isk = (cbase >= 1024 && cbase < 1280);
#pragma unroll
            for (int m = 0; m < 4; ++m) {
                const int r = rbase + m * 16 + fr;
                f32x4 v0 = acc[m][hh * 4 + 0], v1 = acc[m][hh * 4 + 1], v2 = acc[m][hh * 4 + 2], v3 = acc[m][hh * 4 + 3];
                if ((isq || isk) && r < TL) {
                    const int s = r & (S - 1), prow = s >> 6, pcol = s & 63;
                    const f32x4 cr = *(const f32x4*)(rope + prow * 16 + fq * 4), sr = *(const f32x4*)(rope + 1024 + prow * 16 + fq * 4);
                    const f32x4 cc = *(const f32x4*)(rope + pcol * 16 + fq * 4), sc = *(const f32x4*)(rope + 1024 + pcol * 16 + fq * 4);
                    const f32x4 o0 = v0 * cr - v1 * sr, o1 = v1 * cr + v0 * sr, o2 = v2 * cc - v3 * sc, o3 = v3 * cc + v2 * sc;
                    v0 = o0; v1 = o1; v2 = o2; v3 = o3;
                }
                if (isq) { v0 *= QSCALE; v1 *= QSCALE; v2 *= QSCALE; v3 *= QSCALE; }
                const int rl = m * 16 + fr, cl = hh * 64 + fq * 4;
                ep_put4(wl, rl, cl, v0[0], v0[1], v0[2], v0[3]); ep_put4(wl, rl, cl + 16, v1[0], v1[1], v1[2], v1[3]);
                ep_put4(wl, rl, cl + 32, v2[0], v2[1], v2[2], v2[3]); ep_put4(wl, rl, cl + 48, v3[0], v3[1], v3[2], v3[3]);
            }
        }
        const bool isq = cbase0 < 1024, isk = (cbase0 >= 1024 && cbase0 < 1280);
        bf16_t* base = isq ? (Q + cbase0) : isk ? (K + (cbase0 - 1024)) : (V + (cbase0 - 1280));
        const size_t pitch = isq ? 1024 : 256;
#pragma unroll 2
        for (int i = 0; i < 16; ++i) {
            const int rl = 4 * i + (lane >> 4), ch = lane & 15;
            const u32x4 v = *(const LAS u32x4*)(wl + rl * EPB + ch * 16);
            *(u32x4*)(base + (size_t)(rbase + rl) * pitch + ch * 8) = v;
        }
    }
};
struct MEpiResid {
    const float* srcL; const float* srcC; float* dstL; float* dstC; const float* mod; int gchunk;
    __device__ __forceinline__ void operator()(f32x4 (&acc)[4][8], ldsp_t wl, int rbase, int cbase, int lane) const {
        const int fr = lane & 15, fq = lane >> 4, c4 = (lane & 31) * 4;
        const f32x4 gv = *(const f32x4*)(mod + mod_row(rbase) * 6144 + gchunk * 1024 + cbase + c4);
        const bool latent = rbase < TL;
        const float* sbase = (latent ? srcL + (size_t)rbase * D : srcC + (size_t)(rbase - TL) * D) + cbase + c4 + (size_t)(lane >> 5) * D;
        float* dbase = (latent ? dstL + (size_t)rbase * D : dstC + (size_t)(rbase - TL) * D) + cbase + c4 + (size_t)(lane >> 5) * D;
#pragma unroll
        for (int half = 0; half < 2; ++half) {
#pragma unroll
            for (int mm = 0; mm < 2; ++mm)
#pragma unroll
                for (int n = 0; n < 8; ++n) *(LAS f32x4*)(wl + (mm * 16 + fr) * EPF + (n * 16 + fq * 4) * 4) = acc[half * 2 + mm][n];
#pragma unroll
            for (int q = 0; q < 2; ++q) {
                f32x4 sv[8];
#pragma unroll
                for (int i = 0; i < 8; ++i) sv[i] = *(const f32x4*)(sbase + (size_t)(half * 32 + 16 * q + 2 * i) * D);
#pragma unroll
                for (int i = 0; i < 8; ++i) {
                    const int rl = 16 * q + 2 * i + (lane >> 5);
                    const f32x4 v = *(const LAS f32x4*)(wl + rl * EPF + c4 * 4);
                    *(f32x4*)(dbase + (size_t)(half * 32 + 16 * q + 2 * i) * D) = sv[i] + gv * v;
                }
            }
        }
    }
};
struct MEpiInProj {
    bf16_t* G; bf16_t* PU;
    __device__ __forceinline__ void operator()(f32x4 (&acc)[4][8], ldsp_t wl, int rbase, int cbase, int lane) const {
        const int fr = lane & 15, fq = lane >> 4;
        const bool isg = cbase < DR;
#pragma unroll
        for (int m = 0; m < 4; ++m)
#pragma unroll
            for (int n = 0; n < 8; ++n) {
                const f32x4 v = acc[m][n];
                if (isg) ep_put4(wl, m * 16 + fr, n * 16 + fq * 4, gelu_tanh(v[0]), gelu_tanh(v[1]), gelu_tanh(v[2]), gelu_tanh(v[3]));
                else ep_put4(wl, m * 16 + fr, n * 16 + fq * 4, v[0], v[1], v[2], v[3]);
            }
        bf16_t* base = isg ? (G + cbase) : (PU + (cbase - DR));
#pragma unroll 2
        for (int i = 0; i < 16; ++i) {
            const int rl = 4 * i + (lane >> 4), ch = lane & 15, r = rbase + rl;
            const u32x4 v = *(const LAS u32x4*)(wl + rl * EPB + ch * 16);
            if (!isg || r < TL) *(u32x4*)(base + (size_t)r * DR + ch * 8) = v;
        }
    }
};
#define vblock() (c.vb)

template <class RowMap>
__device__ __forceinline__ void tr_item64(const float* W, int ldw, int k0, int n0, bf16_t* dst, int ldd, const RowMap& rm, int lane) {
    const int nq = lane >> 2, kg = lane & 3;
    f32x4 v[16];
    const float* src = W + (size_t)(k0 + kg * 8) * ldw + n0 + 4 * nq;
#pragma unroll
    for (int h = 0; h < 2; ++h)
#pragma unroll
        for (int i = 0; i < 8; ++i) v[h * 8 + i] = *(const f32x4*)(src + (size_t)(h * 32 + i) * ldw);
#pragma unroll
    for (int cc = 0; cc < 4; ++cc) {
        bf16_t* drow = dst + (size_t)rm(n0 + 4 * nq + cc) * ldd + k0 + kg * 8;
#pragma unroll
        for (int h = 0; h < 2; ++h) {
            u32x4 o; o.x = pk2(v[h * 8 + 0][cc], v[h * 8 + 1][cc]); o.y = pk2(v[h * 8 + 2][cc], v[h * 8 + 3][cc]); o.z = pk2(v[h * 8 + 4][cc], v[h * 8 + 5][cc]); o.w = pk2(v[h * 8 + 6][cc], v[h * 8 + 7][cc]);
            *(u32x4*)(drow + h * 32) = o;
        }
    }
}
struct RMPlain { __device__ __forceinline__ int operator()(int n) const { return n; } };
struct RMGateUp { int mat; __device__ __forceinline__ int operator()(int h) const { return (h >> 7) * 256 + ((h >> 6) & 1) * 128 + (((h >> 4) & 3) * 2 + mat) * 16 + (h & 15); } };
__device__ __forceinline__ void tr_plain(const float* W, int K, int N, bf16_t* dst, int item, int lane) {
    const int nb = N / 64, kb = item / nb, n0 = (item % nb) * 64;
    tr_item64(W, N, kb * 64, n0, dst, K, RMPlain{}, lane);
}
__device__ __forceinline__ void tr_expert(const float* Wg, const float* Wu, const float* Wd, bf16_t* gu, bf16_t* dn, int item, int lane) {
    if (item < 128) {
        const int mat = item >> 6, it = item & 63, kb = it >> 2, n0 = (it & 3) * 64;
        tr_item64(Wg + (size_t)mat * (Wu - Wg), DE, kb * 64, n0, gu, D, RMGateUp{mat}, lane);
    } else {
        const int it = item - 128, kb = it >> 4, n0 = (it & 15) * 64;
        tr_item64(Wd, D, kb * 64, n0, dn, DE, RMPlain{}, lane);
    }
}
struct Ctx {
    const Params& p; float* lds; ldsp_t smem;
    int tid, lane, wid, vb;
    __device__ __forceinline__ Ctx(const Params& p_, float* l, ldsp_t sm) : p(p_), lds(l), smem(sm) { tid = threadIdx.x; lane = tid & 63; wid = tid >> 6; vb = blockIdx.x; }
#define WSF(name, type, off) __device__ __forceinline__ type* name() const { return (type*)(p.ws + (off)); }
    WSF(cnt, unsigned, CTL_CNT) WSF(mod, float, CTL_MOD) WSF(rope, float, WS_ROPE) WSF(sum, float, WS_SUM)
    WSF(AE, int, WS_AE) WSF(AW, float, WS_AW) WSF(APOS, int, WS_APOS) WSF(LIST, int, WS_LIST) WSF(XC, float, WS_XC)
    WSF(H, bf16_t, WS_H) WSF(ACT, bf16_t, WS_ACT) WSF(ACTS, bf16_t, WS_ACTS) WSF(Y, bf16_t, WS_BIG)
    WSF(Qb, bf16_t, WS_Q) WSF(Kb, bf16_t, WS_K) WSF(Vb, bf16_t, WS_V) WSF(Ob, bf16_t, WS_O)
    WSF(WQKV, bf16_t, WS_WQKV) WSF(WO, bf16_t, WS_WO) WSF(WIN, bf16_t, WS_WIN) WSF(WOUT, bf16_t, WS_WOUT) WSF(WSH, bf16_t, WS_WSH) WSF(WMOE, bf16_t, WS_WMOE)
    WSF(WGATES, bf16_t, WS_WGATES) WSF(WROUTER, bf16_t, WS_WROUTER) WSF(LC8, float, WS_LC8) WSF(CARRY, float, WS_CARRY)
    WSF(G, bf16_t, WS_G) WSF(PU, bf16_t, WS_PU) WSF(HG, bf16_t, WS_G) WSF(AB, float, WS_AB) WSF(HS, float, WS_WMOE)
#undef WSF
};

__device__ __forceinline__ void ph_prep(Ctx& c) {
    const float* cv = c.p.in[1]; const float* cctx = c.p.in[3]; const float* aw = c.p.in[4]; const float* ab = c.p.in[5];
    float* sil = c.lds;
    float* red = c.lds + 5120;
    __syncthreads();
    for (int i = c.tid; i < 5 * 1024; i += NTHREADS) { const int r = i >> 10, k = i & 1023; const float v = r < 4 ? cv[r * 1024 + k] : cctx[k]; sil[i] = silu_f(v); }
    __syncthreads();
    for (int item = blockIdx.x; item < 2 * 96; item += gridDim.x) {
        const int l = item / 96, jb = item % 96, kq = c.tid >> 4, cq = c.tid & 15;
        f32x4 a0 = {0, 0, 0, 0}, a1 = a0, a2 = a0, a3 = a0, a4 = a0;
        const float* w = aw + ((size_t)l * 1024 + kq * 64) * 6144 + jb * 64 + cq * 4;
        const float* sl = sil + kq * 64;
#pragma unroll 8
        for (int k = 0; k < 64; ++k) { const f32x4 wv = *(const f32x4*)(w + (size_t)k * 6144); a0 += sl[k] * wv; a1 += sl[1024 + k] * wv; a2 += sl[2048 + k] * wv; a3 += sl[3072 + k] * wv; a4 += sl[4096 + k] * wv; }
        float* rr = red + kq * 320 + cq * 4;
        *(f32x4*)(rr) = a0; *(f32x4*)(rr + 64) = a1; *(f32x4*)(rr + 128) = a2; *(f32x4*)(rr + 192) = a3; *(f32x4*)(rr + 256) = a4;
        __syncthreads();
        for (int i = c.tid; i < 320; i += NTHREADS) {
            const int r = i >> 6, jj = i & 63;
            float v = 0.f;
#pragma unroll
            for (int q = 0; q < 16; ++q) v += red[q * 320 + i];
            c.mod()[((size_t)l * 5 + r) * 6144 + jb * 64 + jj] = v + ab[l * 6144 + jb * 64 + jj];
        }
        __syncthreads();
    }
    if (blockIdx.x == gridDim.x - 1) {
        for (int i = c.tid; i < 1024; i += NTHREADS) {
            const int pos = i >> 4, f = i & 15;
            const float inv = expf(-logf(10000.0f) * (float)f / 16.0f);
            const float ang = (float)pos * inv;
            c.rope()[i] = cosf(ang); c.rope()[1024 + i] = sinf(ang);
        }
    }
}


__device__ __forceinline__ int find_expert(const int* tp, int rt) {
    int e = 0;
#pragma unroll 1
    for (int i = 1; i <= 64; ++i) if (tp[i] <= rt) e = i;
    return e;
}


__device__ __forceinline__ void ph_convert_small(Ctx& c) {
    const int wu = __builtin_amdgcn_readfirstlane(c.wid);
    const int gw = blockIdx.x * 4 + wu, NGW = gridDim.x * 4;
    constexpr int I_QKV = 16 * 24, I_O = 16 * 16, I_IN = 16 * 40, I_OUT = 20 * 16, I_SH = 192, I_R = 16;
    constexpr int NIT = I_QKV + I_O + I_IN + I_OUT + 2 * I_SH + 2 * I_R;
    for (int it = gw; it < NIT; it += NGW) {
        int r = it;
        if (r < I_QKV) { tr_plain(c.p.in[8], 1024, 1536, c.WQKV(), r, c.lane); continue; } r -= I_QKV;
        if (r < I_O) { tr_plain(c.p.in[9], 1024, 1024, c.WO(), r, c.lane); continue; } r -= I_O;
        if (r < I_IN) { tr_plain(c.p.in[11], 1024, 2560, c.WIN(), r, c.lane); continue; } r -= I_IN;
        if (r < I_OUT) { tr_plain(c.p.in[19], 1280, 1024, c.WOUT(), r, c.lane); continue; } r -= I_OUT;
        if (r < 2 * I_SH) {
            const int l = r / I_SH; r %= I_SH;
            bf16_t* base = c.WSH() + (size_t)l * (WSH_LAYER / 2);
            tr_expert(c.p.in[25] + (size_t)l * D * DE, c.p.in[26] + (size_t)l * D * DE, c.p.in[27] + (size_t)l * DE * D, base, base + WSH_D / 2, r, c.lane);
            continue;
        }
        r -= 2 * I_SH;
        { const int l = r / I_R; r %= I_R; tr_plain(c.p.in[20] + (size_t)l * D * NE, D, NE, c.WROUTER() + (size_t)l * 128 * D, r, c.lane); }
    }
    for (int i = blockIdx.x * NTHREADS + c.tid; i < 2 * 64 * D / 8; i += gridDim.x * NTHREADS) { const int l = i / (64 * D / 8), o = i % (64 * D / 8); *(u32x4*)(c.WROUTER() + (size_t)l * 128 * D + 64 * D + (size_t)o * 8) = (u32x4){0u, 0u, 0u, 0u}; }
}
__device__ __forceinline__ void ph_convert_moe(Ctx& c, int layer) {
    const int wu = __builtin_amdgcn_readfirstlane(c.wid);
    const int gw = vblock() * 4 + wu, NGW = gridDim.x * 4;
    for (int it = gw; it < NE * 192; it += NGW) {
        const int e = it / 192, r = it % 192; const size_t eo = ((size_t)layer * NE + e) * D * DE;
        tr_expert(c.p.in[22] + eo, c.p.in[23] + eo, c.p.in[24] + eo, c.WMOE() + (size_t)e * 512 * 1024, c.WMOE() + WMOE_D / 2 + (size_t)e * 1024 * 256, r, c.lane);
    }
}
template <class Epi>
__device__ __forceinline__ void dense_gemm(Ctx& c, const bf16_t* A, int lda, int mtiles, const bf16_t* Bt, int K, int ntiles, const Epi& ep) {
    const RowPlain rp{A, lda};
    const int nItems = mtiles * ntiles;
    for (int item = vblock(); item < nItems; item += gridDim.x) {
        const int mt = item / ntiles, nt = item % ntiles;
        mfma_tile(c.smem, rp, Bt + (size_t)nt * 256 * K, K, ep, mt * 128, nt * 256);
    }
}
__device__ __forceinline__ void ph_qkv_m(Ctx& c) { const MEpiQKV ep{c.Qb(), c.Kb(), c.Vb(), c.rope()}; dense_gemm(c, c.H(), D, T0 / 128, c.WQKV(), D, QKVN / 256, ep); }
__device__ __forceinline__ void ph_oproj_m(Ctx& c) { const MEpiResid ep{c.p.in[0], c.p.in[2], c.p.out, c.XC(), c.mod(), 2}; dense_gemm(c, c.Ob(), D, T0 / 128, c.WO(), D, D / 256, ep); }
__device__ __forceinline__ void ph_inproj_m(Ctx& c) { const MEpiInProj ep{c.G(), c.PU()}; dense_gemm(c, c.H(), D, T0 / 128, c.WIN(), D, 2 * DR / 256, ep); }
__device__ __forceinline__ void ph_outproj_m(Ctx& c) { const MEpiResid ep{c.p.out, c.XC(), c.p.out, c.XC(), c.mod() + 5 * 6144, 2}; dense_gemm(c, c.HG(), DR, TL / 128, c.WOUT(), DR, D / 256, ep); }


__device__ __forceinline__ void moe_tables128(Ctx& c, int layer, int T, int* tbl) {
    __syncthreads();
    if (c.tid < 64) tbl[136 + c.tid] = (int)c.cnt()[layer * 64 + c.tid];
    __syncthreads();
    if (c.tid == 0) {
        int o = 0, t = 0;
        for (int e = 0; e < NE; ++e) { const int n = tbl[136 + e]; tbl[e] = o; tbl[65 + e] = t; o += n; t += (n + 127) >> 7; }
        tbl[64] = o; tbl[65 + 64] = t; tbl[65 + 65] = t + ((T + 127) >> 7);
    }
    __syncthreads();
}
struct RowGather { const bf16_t* H; const int* list; int n; bool shared;
    __device__ __forceinline__ const bf16_t* operator()(int r) const { if (r >= n) return H; const int tok = shared ? r : (list[r] >> 3); return H + (size_t)tok * D; } };
struct MEpiAct { bf16_t* act; int n;
    __device__ __forceinline__ void operator()(f32x4 (&acc)[4][8], ldsp_t wl, int rbase, int cbase, int lane) const {
        const int fr = lane & 15, fq = lane >> 4;
#pragma unroll
        for (int m = 0; m < 4; ++m)
#pragma unroll
            for (int q = 0; q < 4; ++q) { const f32x4 g = acc[m][2 * q], u = acc[m][2 * q + 1];
                ep_put4(wl, m * 16 + fr, q * 16 + fq * 4, silu_f(g[0]) * u[0], silu_f(g[1]) * u[1], silu_f(g[2]) * u[2], silu_f(g[3]) * u[3]); }
        bf16_t* base = act + (cbase >> 1);
#pragma unroll 2
        for (int i = 0; i < 8; ++i) {
            const int rl = 8 * i + (lane >> 3), ch = lane & 7, r = rbase + rl;
            const u32x4 v = *(const LAS u32x4*)(wl + rl * EPB + ch * 16);
            if (r < n) *(u32x4*)(base + (size_t)r * DE + ch * 8) = v;
        }
    }
};
__device__ __forceinline__ void ph_moe_gateup_m(Ctx& c, int layer, int T) {
    int* tbl = (int*)(c.smem + LDS_LRU_END + 16);
    moe_tables128(c, layer, T, tbl);
    const int* tp = tbl + 65; const int ntile = tp[65];
#pragma unroll 1
    for (int item = vblock(); item < ntile * 2; item += gridDim.x) {
        const int rt = item >> 1, nt = item & 1, e = find_expert(tp, rt), mt = rt - tp[e];
        const bool sh = e >= NE;
        const int n = sh ? T : tbl[136 + e];
        const RowGather rp{c.H(), c.LIST() + (size_t)(sh ? 0 : e) * T0, n, sh};
        const bf16_t* Bt = (sh ? c.WSH() + (size_t)layer * (WSH_LAYER / 2) : c.WMOE() + (size_t)e * 512 * 1024) + (size_t)nt * 256 * D;
        const MEpiAct ep{sh ? c.ACTS() : c.ACT() + (size_t)tbl[e] * DE, n};
        mfma_tile(c.smem, rp, Bt, D, ep, mt * 128, nt * 256);
    }
}
struct MEpiDown { bf16_t* Y; const int* list; const float* aw; int n; bool shared; float* xl; float* xc; const float* mod; int a_reg; float w_reg;
    __device__ __forceinline__ void operator()(f32x4 (&acc)[4][8], ldsp_t wl, int rbase, int cbase, int lane) const {
        const int fr = lane & 15, fq = lane >> 4;
        if (!shared) {
#pragma unroll
            for (int m = 0; m < 4; ++m) {
                const float w = __shfl(w_reg, m * 16 + fr);
#pragma unroll
                for (int nn = 0; nn < 8; ++nn) ep_put4(wl, m * 16 + fr, nn * 16 + fq * 4, w * acc[m][nn][0], w * acc[m][nn][1], w * acc[m][nn][2], w * acc[m][nn][3]);
            }
#pragma unroll 2
            for (int i = 0; i < 16; ++i) {
                const int rl = 4 * i + (lane >> 4), ch = lane & 15, r = rbase + rl;
                const u32x4 v = *(const LAS u32x4*)(wl + rl * EPB + ch * 16);
                const int a = __shfl(a_reg, rl);
                if (r < n) *(u32x4*)(Y + (size_t)a * D + cbase + ch * 8) = v;
            }
        } else {
#pragma unroll
            for (int half = 0; half < 2; ++half) {
#pragma unroll
                for (int mm = 0; mm < 2; ++mm)
#pragma unroll
                    for (int nn = 0; nn < 8; ++nn) *(LAS f32x4*)(wl + (mm * 16 + fr) * EPF + (nn * 16 + fq * 4) * 4) = acc[half * 2 + mm][nn];
#pragma unroll 2
                for (int i = 0; i < 16; ++i) {
                    const int rl = 2 * i + (lane >> 5), c4 = (lane & 31) * 4, r = rbase + half * 32 + rl;
                    const f32x4 v = *(const LAS f32x4*)(wl + rl * EPF + c4 * 4);
                    if (r < n) {
                        const f32x4 gv = *(const f32x4*)(mod + mod_row(r) * 6144 + 5 * 1024 + cbase + c4);
                        float* d = (r < TL ? xl + (size_t)r * D : xc + (size_t)(r - TL) * D) + cbase + c4;
                        *(f32x4*)d += gv * v;
                    }
                }
            }
        }
    }
};
__device__ __forceinline__ void ph_moe_down_m(Ctx& c, int layer, int T) {
    int* tbl = (int*)(c.smem + LDS_LRU_END + 16);
    moe_tables128(c, layer, T, tbl);
    const int* tp = tbl + 65; const int ntile = tp[65];
    const float* modl = c.mod() + (size_t)layer * 5 * 6144;
#pragma unroll 1
    for (int item = vblock(); item < ntile * 4; item += gridDim.x) {
        const int rt = item >> 2, nt = item & 3, e = find_expert(tp, rt), mt = rt - tp[e];
        const bool sh = e >= NE;
        const int n = sh ? T : tbl[136 + e];
        const RowPlain rp{sh ? c.ACTS() : c.ACT() + (size_t)tbl[e] * DE, DE};
        const bf16_t* Bt = (sh ? c.WSH() + (size_t)layer * (WSH_LAYER / 2) + WSH_D / 2 : c.WMOE() + WMOE_D / 2 + (size_t)e * 1024 * 256) + (size_t)nt * 256 * DE;
        int a_reg = 0; float w_reg = 0.f;
        if (!sh) { const int rr = mt * 128 + (__builtin_amdgcn_readfirstlane(c.tid >> 6) >> 1) * 64 + c.lane; if (rr < n) { a_reg = c.LIST()[(size_t)e * T0 + rr]; w_reg = c.AW()[a_reg]; } }
        const MEpiDown ep{c.Y(), c.LIST() + (size_t)(sh ? 0 : e) * T0, c.AW(), n, sh, c.p.out, c.XC(), modl, a_reg, w_reg};
        mfma_tile(c.smem, rp, Bt, DE, ep, mt * 128, nt * 256);
    }
}


constexpr int NCH = 68;
constexpr int LU_PITCH = 104;
__device__ __forceinline__ float fast_sigmoid(float x) { return __builtin_amdgcn_rcpf(1.f + __builtin_amdgcn_exp2f(-LOG2E * x)); }
__device__ __forceinline__ void ph_convert_gates(Ctx& c) {
    const int NT = gridDim.x * NTHREADS, g0 = blockIdx.x * NTHREADS + c.tid;
    for (int i = g0; i < 2 * 2 * NBLK * BW * 96; i += NT) {
        const int k = i % 96, col = (i / 96) % BW, n = (i / (96 * BW)) % NBLK, mat = (i / (96 * BW * NBLK)) & 1, d = i / (96 * BW * NBLK * 2);
        const float* w = (mat ? c.p.in[16] : c.p.in[14]) + (((size_t)d * NBLK + n) * BW) * BW;
        c.WGATES()[i] = k < BW ? f2bf(w[(size_t)k * BW + col]) : (bf16_t)0;
    }
    for (int i = g0; i < 2 * DR; i += NT) c.LC8()[i] = 8.0f * LOG2E * log1pf(expf(-c.p.in[18][i]));
}
constexpr int L2_U = 0, L2_RAW = 13312, L2_OUT = L2_RAW + 10752, L2_END = L2_OUT + 2 * 64 * BW * 4;
template <bool REV, int PASS>
__device__ __forceinline__ void lru_scan16(const float (&a)[4][4], const float (&b)[4][4], float& cm, float& ptot, float (&h)[4][4], int lane, int fq) {
    const int l16 = REV ? ((lane + 16) & 63) : ((lane - 16) & 63), l32 = REV ? ((lane + 32) & 63) : ((lane - 32) & 63);
    const int ltot = (lane & 15) + (REV ? 0 : 48);
#pragma unroll
    for (int mm = 0; mm < 4; ++mm) {
        const int m = REV ? 3 - mm : mm;
        float P = 1.f, H = 0.f;
#pragma unroll
        for (int jj = 0; jj < 4; ++jj) { const int j = REV ? 3 - jj : jj; H = a[m][j] * H + b[m][j]; P *= a[m][j]; }
        float Pp = __shfl(P, l16), Hp = __shfl(H, l16);
        if (REV ? (fq <= 2) : (fq >= 1)) { H = P * Hp + H; P = P * Pp; }
        Pp = __shfl(P, l32); Hp = __shfl(H, l32);
        if (REV ? (fq <= 1) : (fq >= 2)) { H = P * Hp + H; P = P * Pp; }
        float Pe = __shfl(P, l16), He = __shfl(H, l16);
        if (REV ? (fq == 3) : (fq == 0)) { Pe = 1.f; He = 0.f; }
        const float hin = Pe * cm + He;
        const float Pt = __shfl(P, ltot), Ht = __shfl(H, ltot);
        cm = Pt * cm + Ht; ptot *= Pt;
        if (PASS == 2) {
            float hh = hin;
#pragma unroll
            for (int jj = 0; jj < 4; ++jj) { const int j = REV ? 3 - jj : jj; hh = a[m][j] * hh + b[m][j]; h[m][j] = hh; }
        }
    }
}
template <int PASS>
__device__ __forceinline__ void ph_lru_pass(Ctx& c) {
    const int wu = __builtin_amdgcn_readfirstlane(c.wid), lane = c.lane, fr = lane & 15, fq = lane >> 4;
    const int dir = wu >> 1, nt0 = (wu & 1) ? 3 : 0, nnt = (wu & 1) ? 2 : 3;
    constexpr int NC = PASS == 1 ? NCH : 64;
    const float* cw = c.p.in[12]; const float* cb = c.p.in[13];
#pragma unroll 1
    for (int unit = vblock(); unit < NB * NC * NBLK; unit += gridDim.x) {
        const int n = unit % NBLK, cidx = (unit / NBLK) % NC + (PASS == 1 ? 0 : 4), b = unit / (NBLK * NC);
        int r0, seq0, seqn;
        if (cidx < 4) { seq0 = TL + b * C; seqn = C; r0 = seq0 + cidx * 64; } else { seq0 = b * S; seqn = S; r0 = seq0 + (cidx - 4) * 64; }
        __syncthreads();
        for (int idx = c.tid; idx < 67 * 10; idx += NTHREADS) {
            const int row = idx / 10, c8i = idx % 10, rr = r0 - 2 + row;
            u32x4 v = (u32x4){0u, 0u, 0u, 0u};
            if (rr >= seq0 && rr < seq0 + seqn) v = *(const u32x4*)(c.PU() + (size_t)rr * DR + n * BW + c8i * 8);
            *(LAS u32x4*)(c.smem + L2_RAW + row * 160 + c8i * 16) = v;
        }
        __syncthreads();
        for (int idx = c.tid; idx < 64 * 20; idx += NTHREADS) {
            const int t = idx / 20, c4 = (idx % 20) * 4, ch = n * BW + c4;
            float u0 = cb[ch], u1 = cb[ch + 1], u2 = cb[ch + 2], u3 = cb[ch + 3];
#pragma unroll
            for (int j = 0; j < 4; ++j) {
                const u32x2 raw = *(const LAS u32x2*)(c.smem + L2_RAW + (t + j) * 160 + c4 * 2);
                const float4 w = *(const float4*)(cw + j * DR + ch);
                u0 += w.x * __uint_as_float(raw.x << 16); u1 += w.y * __uint_as_float(raw.x & 0xffff0000u);
                u2 += w.z * __uint_as_float(raw.y << 16); u3 += w.w * __uint_as_float(raw.y & 0xffff0000u);
            }
            u32x2 o; o.x = pk2(u0, u1); o.y = pk2(u2, u3);
            *(LAS u32x2*)(c.smem + L2_U + (t * LU_PITCH + c4) * 2) = o;
        }
        for (int idx = c.tid; idx < 64 * 3; idx += NTHREADS) { const int t = idx / 3, q = idx % 3; *(LAS u32x4*)(c.smem + L2_U + (t * LU_PITCH + 80 + q * 8) * 2) = (u32x4){0u, 0u, 0u, 0u}; }
        __syncthreads();
        bf16x8 af[4][3];
#pragma unroll
        for (int m = 0; m < 4; ++m)
#pragma unroll
            for (int ks = 0; ks < 3; ++ks) af[m][ks] = *(const LAS bf16x8*)(c.smem + L2_U + (16 * m + fr) * (LU_PITCH * 2) + (ks * 32 + fq * 8) * 2);
        const bf16_t* wbase = c.WGATES() + ((((size_t)dir * 2) * NBLK + n) * BW + fr) * 96 + fq * 8;
        bf16x8 bcur[2][3];
#pragma unroll
        for (int mat = 0; mat < 2; ++mat)
#pragma unroll
            for (int ks = 0; ks < 3; ++ks) bcur[mat][ks] = *(const bf16x8*)(wbase + (size_t)mat * NBLK * BW * 96 + nt0 * 16 * 96 + ks * 32);
#pragma unroll 1
        for (int i = 0; i < nnt; ++i) {
            const int nt = nt0 + i, cl = nt * 16 + fr, ch = n * BW + cl;
            const float bav = c.p.in[15][dir * DR + ch], bxv = c.p.in[17][dir * DR + ch], c8v = c.LC8()[dir * DR + ch];
            float cm = PASS == 1 ? 0.f : c.CARRY()[((size_t)(b * 2 + dir) * NCH + cidx) * DR + ch], ptot = 1.f;
            f32x4 acc[2][4];
#pragma unroll
            for (int mat = 0; mat < 2; ++mat)
#pragma unroll
                for (int m = 0; m < 4; ++m) {
                    acc[mat][m] = (f32x4){0.f, 0.f, 0.f, 0.f};
#pragma unroll
                    for (int ks = 0; ks < 3; ++ks) acc[mat][m] = __builtin_amdgcn_mfma_f32_16x16x32_bf16(af[m][ks], bcur[mat][ks], acc[mat][m], 0, 0, 0);
                }
            if (i + 1 < nnt) {
#pragma unroll
                for (int mat = 0; mat < 2; ++mat)
#pragma unroll
                    for (int ks = 0; ks < 3; ++ks) bcur[mat][ks] = *(const bf16x8*)(wbase + (size_t)mat * NBLK * BW * 96 + (nt + 1) * 16 * 96 + ks * 32);
            }
            float av[4][4], bv[4][4], hv[4][4];
#pragma unroll
            for (int m = 0; m < 4; ++m)
#pragma unroll
                for (int j = 0; j < 4; ++j) {
                    const int t = 16 * m + fq * 4 + j;
                    const float r = fast_sigmoid(acc[0][m][j] + bav), ig = fast_sigmoid(acc[1][m][j] + bxv);
                    const float a = __builtin_amdgcn_exp2f(-c8v * r);
                    const float uv = bf2f(*(const LAS bf16_t*)(c.smem + L2_U + (t * LU_PITCH + cl) * 2));
                    av[m][j] = a; bv[m][j] = __builtin_amdgcn_sqrtf(fmaxf(1.f - a * a, 0.f)) * (ig * uv);
                }
            if (dir == 0) lru_scan16<false, PASS>(av, bv, cm, ptot, hv, lane, fq); else lru_scan16<true, PASS>(av, bv, cm, ptot, hv, lane, fq);
            if (PASS == 1) {
                if (fq == 0) { float* sp = c.sum() + (((size_t)(b * 2 + dir) * NCH + cidx) * 2) * DR + ch; sp[0] = ptot; sp[DR] = cm; }
            } else {
#pragma unroll
                for (int m = 0; m < 4; ++m)
#pragma unroll
                    for (int j = 0; j < 4; ++j) *(LAS float*)(c.smem + L2_OUT + ((dir * 64 + 16 * m + fq * 4 + j) * BW + cl) * 4) = hv[m][j];
            }
        }
        if (PASS == 2) {
            __syncthreads();
            for (int idx = c.tid; idx < 64 * 20; idx += NTHREADS) {
                const int t = idx / 20, c4 = (idx % 20) * 4;
                const f32x4 h0 = *(const LAS f32x4*)(c.smem + L2_OUT + (t * BW + c4) * 4), h1 = *(const LAS f32x4*)(c.smem + L2_OUT + ((64 + t) * BW + c4) * 4);
                bf16_t* gp = c.G() + (size_t)(r0 + t) * DR + n * BW + c4;
                const uint2 g = *(const uint2*)gp;
                st_bf16x4(gp, (h0[0] + h1[0]) * __uint_as_float(g.x << 16), (h0[1] + h1[1]) * __uint_as_float(g.x & 0xffff0000u),
                          (h0[2] + h1[2]) * __uint_as_float(g.y << 16), (h0[3] + h1[3]) * __uint_as_float(g.y & 0xffff0000u));
            }
        }
    }
}
__device__ __forceinline__ void ph_lru_carry(Ctx& c) {
    for (int i = blockIdx.x * NTHREADS + c.tid; i < NB * 2 * DR; i += gridDim.x * NTHREADS) {
        const int ch = i % DR, d = (i / DR) & 1, b = i / (2 * DR);
        const float* sp = c.sum() + ((size_t)(b * 2 + d) * NCH * 2) * DR + ch; float* cp = c.CARRY() + ((size_t)(b * 2 + d) * NCH) * DR + ch;
        float h = 0.f;
        if (d == 0) {
#pragma unroll 4
            for (int k = 0; k < NCH; ++k) { cp[(size_t)k * DR] = h; h = sp[(size_t)k * 2 * DR] * h + sp[(size_t)k * 2 * DR + DR]; }
        } else {
#pragma unroll 4
            for (int k = 3; k >= 0; --k) { cp[(size_t)k * DR] = h; h = sp[(size_t)k * 2 * DR] * h + sp[(size_t)k * 2 * DR + DR]; }
#pragma unroll 4
            for (int k = NCH - 1; k >= 4; --k) { cp[(size_t)k * DR] = h; h = sp[(size_t)k * 2 * DR] * h + sp[(size_t)k * 2 * DR + DR]; }
        }
    }
}


typedef float f32x16 __attribute__((ext_vector_type(16)));
typedef short s16x4 __attribute__((ext_vector_type(4)));
__device__ __forceinline__ s16x4 vtr(const LAS unsigned char* p) { return __builtin_bit_cast(s16x4, __builtin_amdgcn_ds_read_tr16_b64_v4i16((LAS s16x4*)p)); }
constexpr int AT_BUF = 16384;
__device__ __forceinline__ void ph_attn_m(Ctx& c) {
    const int tid = c.tid, lane = c.lane, wu = __builtin_amdgcn_readfirstlane(c.wid), r32 = lane & 31, hi = lane >> 5;
    const float* sinkp = c.p.in[10];
    const int NU = NB * 32 * NH + NB * 2 * NH;
#pragma unroll 1
    for (int unit = vblock(); unit < NU; unit += gridDim.x) {
        int b, qb, h, q0, nt, ilo;
        bool lat = unit < NB * 32 * NH;
        if (lat) { h = unit & 15; qb = (unit >> 4) & 31; b = unit >> 9; q0 = b * S + qb * 128; ilo = (qb == 0) ? 2 : 0; const int ihi = (qb == 31) ? 3 : 5; nt = 4 + (ihi - ilo + 1); }
        else { const int u2 = unit - NB * 32 * NH; h = u2 & 15; qb = (u2 >> 4) & 1; b = u2 >> 5; q0 = TL + b * C + qb * 128; ilo = 0; nt = 4; }
        const int g = h >> 2;
        const bf16_t* kbase = c.Kb() + (size_t)lane * KD + g * 64 + (2 * wu) * 8;
        const bf16_t* vbase = c.Vb() + (size_t)(16 * wu + (lane >> 2)) * KD + g * 64 + (lane & 3) * 8;
#define AT_STAGE(buf, kr0) do { \
        __builtin_amdgcn_global_load_lds((const unsigned*)(kbase + (size_t)(kr0) * KD), (LAS unsigned*)(c.smem + (buf) * AT_BUF + (2 * wu) * 1024), 16, 0, 0); \
        __builtin_amdgcn_global_load_lds((const unsigned*)(kbase + (size_t)(kr0) * KD + 8), (LAS unsigned*)(c.smem + (buf) * AT_BUF + (2 * wu + 1) * 1024), 16, 0, 0); \
        __builtin_amdgcn_global_load_lds((const unsigned*)(vbase + (size_t)(kr0) * KD), (LAS unsigned*)(c.smem + (buf) * AT_BUF + 8192 + wu * 1024), 16, 0, 0); \
        __builtin_amdgcn_global_load_lds((const unsigned*)(vbase + (size_t)(kr0) * KD + 32), (LAS unsigned*)(c.smem + (buf) * AT_BUF + 8192 + 4096 + wu * 1024), 16, 0, 0); } while (0)
#define AT_KR0(j) ((j) < 4 ? (TL + b * C + (j) * 64) : (b * S + qb * 128 - 128 + 64 * (ilo + (j) - 4)))
        bf16x8 qr[4];
        { const bf16_t* qp = c.Qb() + (size_t)(q0 + 32 * wu + r32) * 1024 + h * 64 + hi * 8;
#pragma unroll
          for (int ds = 0; ds < 4; ++ds) qr[ds] = *(const bf16x8*)(qp + ds * 16); }
        float m = sinkp[h] * LOG2E, l = hi == 0 ? 1.f : 0.f;
        f32x16 o0, o1;
#pragma unroll
        for (int r = 0; r < 16; ++r) { o0[r] = 0.f; o1[r] = 0.f; }
        const int qi = 32 * wu + r32;
        const int vaddr = ((lane >> 4) & 1) * 32 + (lane & 3) * 8 + (4 * hi + ((lane & 15) >> 2)) * 64;
        __syncthreads();
        AT_STAGE(0, AT_KR0(0));
        AT_STAGE(1, AT_KR0(1));
        AT_STAGE(2, AT_KR0(2));
#pragma unroll 1
        for (int j = 0; j < nt; ++j) {
            if (j + 2 < nt) asm volatile("s_waitcnt vmcnt(8)" ::: "memory");
            else if (j + 1 < nt) asm volatile("s_waitcnt vmcnt(4)" ::: "memory");
            else asm volatile("s_waitcnt vmcnt(0)" ::: "memory");
            __builtin_amdgcn_s_barrier();
            asm volatile("" ::: "memory");
            if (j + 3 < nt) { const int kr1 = AT_KR0(j + 3); AT_STAGE((j + 3) & 3, kr1); }
            const ldsp_t kb = c.smem + (j & 3) * AT_BUF, vb = kb + 8192;
            f32x16 p0, p1;
#pragma unroll
            for (int r = 0; r < 16; ++r) { p0[r] = 0.f; p1[r] = 0.f; }
#pragma unroll
            for (int ds = 0; ds < 4; ++ds) {
                const bf16x8 k0 = *(const LAS bf16x8*)(kb + (ds * 2 + hi) * 1024 + r32 * 16);
                const bf16x8 k1 = *(const LAS bf16x8*)(kb + (ds * 2 + hi) * 1024 + (32 + r32) * 16);
                p0 = __builtin_amdgcn_mfma_f32_32x32x16_bf16(k0, qr[ds], p0, 0, 0, 0);
                p1 = __builtin_amdgcn_mfma_f32_32x32x16_bf16(k1, qr[ds], p1, 0, 0, 0);
            }
            if (lat && j >= 4) {
                const int i = ilo + j - 4;
                if (i < 2 || i > 3) {
                    const int kj0 = 64 * i + 4 * hi;
#pragma unroll
                    for (int r = 0; r < 16; ++r) {
                        const int kj = kj0 + (r & 3) + 8 * (r >> 2);
                        if (kj < qi || kj > qi + 256) p0[r] = -INFINITY;
                        if (kj + 32 < qi || kj + 32 > qi + 256) p1[r] = -INFINITY;
                    }
                }
            }
            float mx = fmaxf(p0[0], p1[0]);
#pragma unroll
            for (int r = 1; r < 16; ++r) mx = fmaxf(mx, fmaxf(p0[r], p1[r]));
            mx = fmaxf(mx, __shfl_xor(mx, 32));
            const float mn = fmaxf(m, mx);
            const float alpha = __builtin_amdgcn_exp2f(m - mn);
            m = mn;
            float ls = 0.f;
#pragma unroll
            for (int r = 0; r < 16; ++r) { p0[r] = __builtin_amdgcn_exp2f(p0[r] - mn); p1[r] = __builtin_amdgcn_exp2f(p1[r] - mn); ls += p0[r] + p1[r]; }
            l = l * alpha + ls;
            if (__any(alpha != 1.f)) {
#pragma unroll
                for (int r = 0; r < 16; ++r) { o0[r] *= alpha; o1[r] *= alpha; }
            }
#pragma unroll
            for (int sub = 0; sub < 2; ++sub)
#pragma unroll
                for (int sk = 0; sk < 2; ++sk) {
                    u32x4 pw;
                    if (sub == 0) { pw.x = pk2(p0[8 * sk + 0], p0[8 * sk + 1]); pw.y = pk2(p0[8 * sk + 2], p0[8 * sk + 3]); pw.z = pk2(p0[8 * sk + 4], p0[8 * sk + 5]); pw.w = pk2(p0[8 * sk + 6], p0[8 * sk + 7]); }
                    else { pw.x = pk2(p1[8 * sk + 0], p1[8 * sk + 1]); pw.y = pk2(p1[8 * sk + 2], p1[8 * sk + 3]); pw.z = pk2(p1[8 * sk + 4], p1[8 * sk + 5]); pw.w = pk2(p1[8 * sk + 6], p1[8 * sk + 7]); }
                    const bf16x8 pf = __builtin_bit_cast(bf16x8, pw);
                    const int ko = (sub * 32 + sk * 16) * 64;
                    const s16x4 a0 = vtr(vb + vaddr + ko), a1 = vtr(vb + vaddr + ko + 512);
                    const s16x4 b0 = vtr(vb + 4096 + vaddr + ko), b1 = vtr(vb + 4096 + vaddr + ko + 512);
                    const bf16x8 vf0 = (bf16x8){a0[0], a0[1], a0[2], a0[3], a1[0], a1[1], a1[2], a1[3]};
                    const bf16x8 vf1 = (bf16x8){b0[0], b0[1], b0[2], b0[3], b1[0], b1[1], b1[2], b1[3]};
                    o0 = __builtin_amdgcn_mfma_f32_32x32x16_bf16(vf0, pf, o0, 0, 0, 0);
                    o1 = __builtin_amdgcn_mfma_f32_32x32x16_bf16(vf1, pf, o1, 0, 0, 0);
                }
        }
#undef AT_STAGE
#undef AT_KR0
        l += __shfl_xor(l, 32);
        const float rl = 1.f / l;
        bf16_t* op = c.Ob() + (size_t)(q0 + qi) * 1024 + h * 64 + 4 * hi;
#pragma unroll
        for (int g4 = 0; g4 < 4; ++g4) {
            st_bf16x4(op + 8 * g4, o0[4 * g4] * rl, o0[4 * g4 + 1] * rl, o0[4 * g4 + 2] * rl, o0[4 * g4 + 3] * rl);
            st_bf16x4(op + 32 + 8 * g4, o1[4 * g4] * rl, o1[4 * g4 + 1] * rl, o1[4 * g4 + 2] * rl, o1[4 * g4 + 3] * rl);
        }
    }
}


struct Row16 { float v[2][8]; };
__device__ __forceinline__ void row_load(Row16& x, const float* src, int lane) {
#pragma unroll
    for (int j = 0; j < 2; ++j) { const f32x4 a = *(const f32x4*)(src + j * 512 + lane * 8), b = *(const f32x4*)(src + j * 512 + lane * 8 + 4);
        x.v[j][0] = a[0]; x.v[j][1] = a[1]; x.v[j][2] = a[2]; x.v[j][3] = a[3]; x.v[j][4] = b[0]; x.v[j][5] = b[1]; x.v[j][6] = b[2]; x.v[j][7] = b[3]; }
}
__device__ __forceinline__ void row_store(const Row16& x, float* dst, int lane) {
#pragma unroll
    for (int j = 0; j < 2; ++j) { *(f32x4*)(dst + j * 512 + lane * 8) = (f32x4){x.v[j][0], x.v[j][1], x.v[j][2], x.v[j][3]}; *(f32x4*)(dst + j * 512 + lane * 8 + 4) = (f32x4){x.v[j][4], x.v[j][5], x.v[j][6], x.v[j][7]}; }
}
__device__ __forceinline__ float row_rinv(const Row16& x) {
    float ss = 0.f;
#pragma unroll
    for (int j = 0; j < 2; ++j)
#pragma unroll
        for (int e = 0; e < 8; ++e) ss += x.v[j][e] * x.v[j][e];
    return rsqrtf(wave_sum(ss) * (1.0f / D) + RMS_EPS);
}
__device__ __forceinline__ void row_normmod_store(const Row16& x, float rinv, const float* g, const float* shift, const float* scale, bf16_t* dst, int lane) {
#pragma unroll
    for (int j = 0; j < 2; ++j) {
        const int k = j * 512 + lane * 8; float h[8];
#pragma unroll
        for (int q = 0; q < 2; ++q) { const f32x4 gv = *(const f32x4*)(g + k + 4 * q), sh = *(const f32x4*)(shift + k + 4 * q), sc = *(const f32x4*)(scale + k + 4 * q);
#pragma unroll
            for (int e = 0; e < 4; ++e) h[4 * q + e] = (x.v[j][4 * q + e] * rinv * gv[e]) * (1.f + sc[e]) + sh[e]; }
        u32x4 o; o.x = pk2(h[0], h[1]); o.y = pk2(h[2], h[3]); o.z = pk2(h[4], h[5]); o.w = pk2(h[6], h[7]);
        *(u32x4*)(dst + k) = o;
    }
}
__device__ __forceinline__ void row_combine(Row16& x, const bf16_t* Y, int r, const float* g2, int lane) {
#pragma unroll
    for (int j = 0; j < 2; ++j) {
        const int k = j * 512 + lane * 8; float s[8];
#pragma unroll
        for (int e = 0; e < 8; ++e) s[e] = 0.f;
#pragma unroll
        for (int kk = 0; kk < TOPK; ++kk) { const u32x4 y = *(const u32x4*)(Y + ((size_t)r * 8 + kk) * D + k);
            s[0] += __uint_as_float(y.x << 16); s[1] += __uint_as_float(y.x & 0xffff0000u); s[2] += __uint_as_float(y.y << 16); s[3] += __uint_as_float(y.y & 0xffff0000u);
            s[4] += __uint_as_float(y.z << 16); s[5] += __uint_as_float(y.z & 0xffff0000u); s[6] += __uint_as_float(y.w << 16); s[7] += __uint_as_float(y.w & 0xffff0000u); }
        const f32x4 ga = *(const f32x4*)(g2 + k), gb = *(const f32x4*)(g2 + k + 4);
#pragma unroll
        for (int e = 0; e < 4; ++e) { x.v[j][e] += ga[e] * s[e]; x.v[j][4 + e] += gb[e] * s[4 + e]; }
    }
}
__device__ __forceinline__ float* xrow_ptr(Ctx& c, int r) { return r < TL ? c.p.out + (size_t)r * D : c.XC() + (size_t)(r - TL) * D; }
__device__ __forceinline__ void ph_norm1_l0_w(Ctx& c) {
    const float* g = c.p.in[6]; constexpr int RB = 2;
    for (int r0 = (blockIdx.x * 4 + c.wid) * RB; r0 < T0; r0 += gridDim.x * 4 * RB) {
        Row16 x[RB];
#pragma unroll
        for (int i = 0; i < RB; ++i) { const int r = r0 + i; row_load(x[i], r < TL ? c.p.in[0] + (size_t)r * D : c.p.in[2] + (size_t)(r - TL) * D, c.lane); }
#pragma unroll
        for (int i = 0; i < RB; ++i) { const int r = r0 + i; const float* m = c.mod() + mod_row(r) * 6144;
            row_normmod_store(x[i], row_rinv(x[i]), g, m, m + 1024, c.H() + (size_t)r * D, c.lane); }
    }
}
__device__ __forceinline__ void ph_norm2_w(Ctx& c, int layer) {
    const int T = layer == 0 ? T0 : TL; const float* g = c.p.in[7] + layer * D; constexpr int RB = 2;
    for (int r0 = (blockIdx.x * 4 + c.wid) * RB; r0 < T; r0 += gridDim.x * 4 * RB) {
        Row16 x[RB];
#pragma unroll
        for (int i = 0; i < RB; ++i) row_load(x[i], xrow_ptr(c, r0 + i), c.lane);
#pragma unroll
        for (int i = 0; i < RB; ++i) { const int r = r0 + i; const float* m = c.mod() + ((size_t)layer * 5 + mod_row(r)) * 6144;
            row_normmod_store(x[i], row_rinv(x[i]), g, m + 3 * 1024, m + 4 * 1024, c.H() + (size_t)r * D, c.lane); }
    }
}
__device__ __forceinline__ void ph_combine_norm1_w(Ctx& c) {
    const float* g = c.p.in[6] + D; constexpr int RB = 1;
    for (int r0 = (blockIdx.x * 4 + c.wid) * RB; r0 < T0; r0 += gridDim.x * 4 * RB) {
        Row16 x[RB];
#pragma unroll
        for (int i = 0; i < RB; ++i) row_load(x[i], xrow_ptr(c, r0 + i), c.lane);
#pragma unroll
        for (int i = 0; i < RB; ++i) row_combine(x[i], c.Y(), r0 + i, c.mod() + (size_t)mod_row(r0 + i) * 6144 + 5 * 1024, c.lane);
#pragma unroll
        for (int i = 0; i < RB; ++i) { const int r = r0 + i; row_store(x[i], xrow_ptr(c, r), c.lane);
            const float* m = c.mod() + ((size_t)5 + mod_row(r)) * 6144;
            row_normmod_store(x[i], row_rinv(x[i]), g, m, m + 1024, c.H() + (size_t)r * D, c.lane); }
    }
}
__device__ __forceinline__ void ph_final_w(Ctx& c) {
    const float* g = c.p.in[28]; constexpr int RB = 1;
    for (int r0 = (blockIdx.x * 4 + c.wid) * RB; r0 < TL; r0 += gridDim.x * 4 * RB) {
        Row16 x[RB];
#pragma unroll
        for (int i = 0; i < RB; ++i) row_load(x[i], c.p.out + (size_t)(r0 + i) * D, c.lane);
#pragma unroll
        for (int i = 0; i < RB; ++i) row_combine(x[i], c.Y(), r0 + i, c.mod() + ((size_t)5 + mod_row(r0 + i)) * 6144 + 5 * 1024, c.lane);
#pragma unroll
        for (int i = 0; i < RB; ++i) {
            const float rinv = row_rinv(x[i]);
#pragma unroll
            for (int j = 0; j < 2; ++j) { const int k = j * 512 + c.lane * 8; const f32x4 ga = *(const f32x4*)(g + k), gb = *(const f32x4*)(g + k + 4);
#pragma unroll
                for (int e = 0; e < 4; ++e) { x[i].v[j][e] = x[i].v[j][e] * rinv * ga[e]; x[i].v[j][4 + e] = x[i].v[j][4 + e] * rinv * gb[e]; } }
            row_store(x[i], c.p.out + (size_t)(r0 + i) * D, c.lane);
        }
    }
}
struct MEpiRouter { ldsp_t lg;
    __device__ __forceinline__ void operator()(f32x4 (&acc)[4][8], ldsp_t wl, int rbase, int cbase, int lane) const {
        const int fr = lane & 15, fq = lane >> 4;
        if ((cbase & 255) == 0) {
            const int rl = (rbase & 127);
#pragma unroll
            for (int m = 0; m < 4; ++m)
#pragma unroll
                for (int n = 0; n < 4; ++n)
#pragma unroll
                    for (int j = 0; j < 4; ++j) *(LAS float*)(lg + ((rl + m * 16 + fr) * 65 + n * 16 + fq * 4 + j) * 4) = acc[m][n][j];
        }
        __syncthreads();
    }
};
__device__ __forceinline__ void ph_route_m(Ctx& c, int layer) {
    const int T = layer == 0 ? T0 : TL;
    const RowPlain rp{c.H(), D};
    const MEpiRouter ep{c.smem};
    LAS float* bias = (LAS float*)(c.smem + 128 * 65 * 4);
    for (int mt = vblock(); mt < T / 128; mt += gridDim.x) {
        mfma_tile(c.smem, rp, c.WROUTER() + (size_t)layer * 128 * D, D, ep, mt * 128, 0);
        if (c.tid < NE) bias[c.tid] = c.p.in[21][layer * NE + c.tid];
        __syncthreads();
        if (c.tid < 128) {
            LAS float* sc = (LAS float*)c.smem + c.tid * 65;
            for (int e = 0; e < NE; ++e) sc[e] = fast_sigmoid(sc[e]);
            unsigned gmask = 0; float gs[8];
#pragma unroll
            for (int g = 0; g < 8; ++g) {
                float m1 = -INFINITY, m2 = -INFINITY;
#pragma unroll
                for (int i = 0; i < 8; ++i) { const float v = sc[g * 8 + i] + bias[g * 8 + i]; if (v > m1) { m2 = m1; m1 = v; } else if (v > m2) m2 = v; }
                gs[g] = m1 + m2;
            }
#pragma unroll
            for (int it = 0; it < 4; ++it) {
                float best = -INFINITY; int bi = 0;
#pragma unroll
                for (int g = 0; g < 8; ++g) { const bool used = (gmask >> g) & 1u; if (!used && gs[g] > best) { best = gs[g]; bi = g; } }
                gmask |= 1u << bi;
            }
            unsigned long long used = 0ull; float wsum = 0.f; int se[TOPK]; float ss[TOPK];
#pragma unroll
            for (int it = 0; it < TOPK; ++it) {
                float best = -INFINITY; int bi = -1;
#pragma unroll 1
                for (int e = 0; e < NE; ++e) {
                    if (!((gmask >> (e >> 3)) & 1u)) continue;
                    if ((used >> e) & 1ull) continue;
                    const float v = sc[e] + bias[e];
                    if (bi < 0 || v > best) { best = v; bi = e; }
                }
                used |= 1ull << bi; se[it] = bi; ss[it] = sc[bi]; wsum += ss[it];
            }
            const float norm = 2.5f / wsum; const int t = mt * 128 + c.tid;
#pragma unroll
            for (int k = 0; k < TOPK; ++k) {
                const int e = se[k]; const int pos = (int)atomicAdd(&c.cnt()[layer * 64 + e], 1u); const int a = t * 8 + k;
                c.AE()[a] = e; c.APOS()[a] = pos; c.AW()[a] = ss[k] * norm; c.LIST()[(size_t)e * T0 + pos] = a;
            }
        }
    }
}

__global__ void __launch_bounds__(NTHREADS, 2) mega(const Params p) {
    __shared__ __attribute__((aligned(16))) unsigned char smem[LDS_LRU_END + 16 + 1024];
    float* lds = (float*)smem;
    Ctx c(p, lds, (ldsp_t)smem);
    volatile unsigned* st = (volatile unsigned*)(smem + LDS_LRU_END);
    if (c.tid < 4) st[c.tid] = 0u;
    __syncthreads();
    const XcdBarrier bar = xcd_barrier_post((unsigned*)(p.ws + CTL_BAR), st);
#define GB() xcd_barrier(bar)
#define REPEAT(n, stmt) do { for (int rep_ = 0; rep_ < (n); ++rep_) { stmt; if (rep_ + 1 < (n)) GB(); } } while (0)
    REPEAT(REP_PREP, (ph_prep(c), ph_convert_small(c), ph_convert_gates(c), ph_convert_moe(c, 0))); GB();
    {
        if (c.tid == 0) {
            unsigned* ctl = (unsigned*)(p.ws + CTL_BAR);
            const unsigned tk = xb_add((unsigned*)(p.ws + CTL_TICKET) + 64 * bar.x, 1u);
            unsigned base = 0u;
            for (unsigned j = 0; j < 16; ++j) { const unsigned n = xb_ld(&ctl[XB_XCNT(j)]); base += (j < bar.x) ? n : 0u; }
            st[2] = base + tk;
        }
        __syncthreads();
        c.vb = __builtin_amdgcn_readfirstlane((int)st[2]);
    }
    ph_norm1_l0_w(c); GB();
    REPEAT(REP_QKV, ph_qkv_m(c)); GB();
    REPEAT(REP_ATTN, ph_attn_m(c)); GB();
    ph_oproj_m(c); GB();
    REPEAT(REP_NORM2, ph_norm2_w(c, 0)); GB();
    ph_route_m(c, 0); GB();
    REPEAT(REP_GATEUP, ph_moe_gateup_m(c, 0, T0)); GB();
    ph_moe_down_m(c, 0, T0); GB();
    ph_combine_norm1_w(c); ph_convert_moe(c, 1); GB();
    REPEAT(REP_INPROJ, ph_inproj_m(c)); GB();
    REPEAT(REP_LRU1, ph_lru_pass<1>(c)); GB();
    ph_lru_carry(c); GB();
    ph_lru_pass<2>(c); GB();
    ph_outproj_m(c); GB();
    ph_norm2_w(c, 1); GB();
    ph_route_m(c, 1); GB();
    ph_moe_gateup_m(c, 1, TL); GB();
    ph_moe_down_m(c, 1, TL); GB();
    ph_final_w(c);
#undef GB
}
}

extern "C" void kernel_launch(void* const* d_in, const int* in_sizes, int n_in, void* d_out, int out_size, void* d_ws, size_t ws_size, hipStream_t stream) {
    if (n_in != 29 || ws_size < WS_END) { fprintf(stderr, "kernel_launch: unexpected n_in %d or ws_size %zu (< %zu)\n", n_in, ws_size, (size_t)WS_END); return; }
    static int grid = 0;
    if (grid == 0) {
        int dev = 0, cus = 0, per_cu = 0;
        hipGetDevice(&dev);
        hipDeviceGetAttribute(&cus, hipDeviceAttributeMultiprocessorCount, dev);
        hipOccupancyMaxActiveBlocksPerMultiprocessor(&per_cu, (const void*)mega, NTHREADS, 0);
        if (per_cu > 2) per_cu = 2;
        if (per_cu < 1) per_cu = 1;
        grid = cus * per_cu;
    }
    hipMemsetAsync((char*)d_ws + WS_CTL, 0, CTL_BYTES, stream);
    Params p{};
    for (int i = 0; i < 29; ++i) p.in[i] = (const float*)d_in[i];
    p.out = (float*)d_out; p.ws = (unsigned char*)d_ws;
    p.ph_lo = 0; p.ph_hi = 20;
    void* args[] = {&p};
    hipError_t e = hipLaunchCooperativeKernel((const void*)mega, dim3(grid), dim3(NTHREADS), args, 0, stream);
    if (e != hipSuccess) fprintf(stderr, "cooperative launch failed: %s (grid %d)\n", hipGetErrorString(e), grid);
}
```

```cpp
#include <hip/hip_runtime.h>
#include <stdint.h>
#include <cstdio>

namespace {
typedef unsigned short bf16_t;
constexpr int D = 1024, NB = 4, S = 4096, C = 256, TL = NB * S, TC = NB * C, T0 = TL + TC;
constexpr int NH = 16, NKV = 4, HD = 64, KD = 256, QKVN = 1536;
constexpr int DR = 1280, NBLK = 16, BW = 80;
constexpr int NE = 64, TOPK = 8, DE = 256;
constexpr float RMS_EPS = 1e-6f;
constexpr float LOG2E = 1.4426950408889634f;
constexpr float QSCALE = 0.125f * LOG2E;
constexpr int NTHREADS = 256;
constexpr int REP_PREP = 1, REP_QKV = 1, REP_ATTN = 1, REP_GATEUP = 1, REP_INPROJ = 1, REP_LRU1 = 1, REP_NORM2 = 1;
constexpr int LDS_U = 0, LDS_A = 13312, LDS_B0 = LDS_A + 20480, LDS_B1 = LDS_B0 + 20480, LDS_LRU_END = LDS_B1 + 20480;

constexpr size_t MiB = 1u << 20;
constexpr size_t WS_CTL = 0, CTL_BYTES = 1 * MiB;
constexpr size_t CTL_BAR = 0;
constexpr size_t CTL_TICKET = 16384;
constexpr size_t CTL_CNT = 32768;
constexpr size_t CTL_MOD = 65536;
constexpr size_t WS_ROPE = 1 * MiB + 512 * 1024;
constexpr size_t WS_SUM = 2 * MiB;
constexpr size_t WS_AE = 8 * MiB;
constexpr size_t WS_AW = WS_AE + 640 * 1024;
constexpr size_t WS_APOS = WS_AW + 640 * 1024;
constexpr size_t WS_LIST = 10 * MiB;
constexpr size_t WS_XC = 15 * MiB;
constexpr size_t WS_WQKV = 19 * MiB, WS_WO = 22 * MiB, WS_WIN = 24 * MiB, WS_WOUT = 29 * MiB, WS_WGATES = 32 * MiB, WS_WROUTER = 33 * MiB, WS_WSH = 34 * MiB;
constexpr size_t WSH_LAYER = 1536 * 1024, WSH_D = 1024 * 1024;
constexpr size_t WMOE_D = 64 * MiB;
constexpr size_t WS_WMOE = 37 * MiB;
constexpr size_t WS_H = 138 * MiB;
constexpr size_t WS_ACT = 172 * MiB;
constexpr size_t WS_ACTS = 240 * MiB;
constexpr size_t WS_BIG = 249 * MiB;
constexpr size_t WS_Q = WS_BIG, WS_K = WS_BIG + 34 * MiB, WS_V = WS_K + 9 * MiB, WS_O = WS_V + 9 * MiB;
constexpr size_t WS_G = WS_BIG, WS_PU = WS_BIG + 40 * MiB, WS_AB = WS_BIG + 83 * MiB;
constexpr size_t WS_CARRY = WS_BIG + 84 * MiB;
constexpr size_t WS_LC8 = 1 * MiB + 640 * 1024;
constexpr size_t WS_END = 521 * MiB;

struct Params {
    const float* in[29];
    float* out;
    unsigned char* ws;
    int ph_lo, ph_hi;
};

__device__ __forceinline__ float bf2f(bf16_t h) { return __uint_as_float(((unsigned)h) << 16); }
__device__ __forceinline__ bf16_t f2bf(float f) { unsigned u = __float_as_uint(f); return (bf16_t)((u + 0x7fffu + ((u >> 16) & 1u)) >> 16); }
__device__ __forceinline__ float silu_f(float v) { return v * __builtin_amdgcn_rcpf(1.f + __builtin_amdgcn_exp2f(-LOG2E * v)); }
__device__ __forceinline__ float gelu_tanh(float v) { const float u = 0.7978845608028654f * (v + 0.044715f * v * v * v); return v * __builtin_amdgcn_rcpf(1.f + __builtin_amdgcn_exp2f(-2.f * LOG2E * u)); }
__device__ __forceinline__ float wave_sum(float v) {
#pragma unroll
    for (int o = 32; o > 0; o >>= 1) v += __shfl_xor(v, o);
    return v;
}
__device__ __forceinline__ int mod_row(int r) { return r < TL ? (r >> 12) : 4; }

#define XB_TMO      128
#define XB_XCNT(j)  (256  + 64 * (j))
#define XB_XSUB(j)  (1280 + 64 * (j))
#define XB_XGEN(j)  (2304 + 64 * (j))
#define XB_TOP      3328
#define XB_TOPGEN   3392
#define XCD_BAR_WORDS 3456
#define XB_SPIN_CAP (1u << 22)
#define LAS __attribute__((address_space(3)))
__device__ __forceinline__ unsigned xb_ld(unsigned* p)              { return __hip_atomic_load(p, __ATOMIC_RELAXED, __HIP_MEMORY_SCOPE_AGENT); }
__device__ __forceinline__ unsigned xb_add(unsigned* p, unsigned v) { return __hip_atomic_fetch_add(p, v, __ATOMIC_RELAXED, __HIP_MEMORY_SCOPE_AGENT); }
__device__ __forceinline__ unsigned xb_xcc_id() { return (unsigned)__builtin_amdgcn_s_getreg((3 << 11) | 20) & 0xFu; }
#define XB_SPIN(cond, bar) do { unsigned _sp = 0; while (cond) { __builtin_amdgcn_s_sleep(1); \
    if ((++_sp & 255u) == 0u) { if (xb_ld(&(bar)[XB_TMO])) break; if (_sp > XB_SPIN_CAP) { atomicAdd(&(bar)[XB_TMO], 1u); break; } } } } while (0)
struct XcdBarrier { unsigned* bar; unsigned x; volatile unsigned* st; };
__device__ __forceinline__ XcdBarrier xcd_barrier_post(unsigned* bar, volatile unsigned* st) {
    XcdBarrier b; b.bar = bar; b.x = xb_xcc_id(); b.st = st;
    if (threadIdx.x == 0) (void)xb_add(&bar[XB_XCNT(b.x)], 1u);
    return b;
}
__device__ __forceinline__ void xcd_barrier_complete(unsigned* bar, unsigned x, unsigned& nloc, unsigned& nx) {
    const unsigned G = gridDim.x * gridDim.y * gridDim.z;
    unsigned sum, cnt, mine, sp = 0u;
    for (;;) {
        sum = 0u; cnt = 0u; mine = 0u;
#pragma unroll
        for (unsigned j = 0; j < 16; ++j) { const unsigned c = xb_ld(&bar[XB_XCNT(j)]); sum += c; cnt += (c > 0u) ? 1u : 0u; mine = (j == x) ? c : mine; }
        if (sum == G) break;
        __builtin_amdgcn_s_sleep(1);
        if ((++sp & 255u) == 0u) { if (xb_ld(&bar[XB_TMO])) break; if (sp > XB_SPIN_CAP) { atomicAdd(&bar[XB_TMO], 1u); break; } }
    }
    nloc = mine > 0u ? mine : 1u; nx = cnt > 0u ? cnt : 1u;
}
__device__ __forceinline__ void xcd_barrier(const XcdBarrier& b) {
    asm volatile("s_waitcnt vmcnt(0)" ::: "memory");
    __syncthreads();
    if (threadIdx.x == 0) {
        unsigned* bar = b.bar;
        __builtin_amdgcn_s_waitcnt(0);
        unsigned nloc = b.st[0], nx = b.st[1];
        if (nloc == 0u) { xcd_barrier_complete(bar, b.x, nloc, nx); b.st[0] = nloc; b.st[1] = nx; }
        const unsigned old = xb_add(&bar[XB_XSUB(b.x)], 1u);
        const unsigned gen = old / nloc;
        if (old + 1u == (gen + 1u) * nloc) {
            __builtin_amdgcn_fence(__ATOMIC_RELEASE, "agent");
            asm volatile("s_waitcnt vmcnt(0)" ::: "memory");
            const unsigned og = xb_add(&bar[XB_TOP], 1u);
            const unsigned tg = og / nx;
            if (og + 1u == (tg + 1u) * nx) xb_add(&bar[XB_TOPGEN], 1u);
            else XB_SPIN(xb_ld(&bar[XB_TOPGEN]) == tg, bar);
            __builtin_amdgcn_fence(__ATOMIC_ACQUIRE, "agent");
            xb_add(&bar[XB_XGEN(b.x)], 1u);
            asm volatile("s_waitcnt vmcnt(0)" ::: "memory");
        } else {
            XB_SPIN(xb_ld(&bar[XB_XGEN(b.x)]) == gen, bar);
            __builtin_amdgcn_fence(__ATOMIC_ACQUIRE, "agent");
            asm volatile("s_waitcnt vmcnt(0)" ::: "memory");
        }
    }
    __syncthreads();
}


typedef short bf16x8 __attribute__((ext_vector_type(8)));
typedef float f32x4 __attribute__((ext_vector_type(4)));
typedef unsigned u32x4 __attribute__((ext_vector_type(4)));
typedef unsigned u32x2 __attribute__((ext_vector_type(2)));
typedef LAS unsigned char* ldsp_t;
constexpr int EP_WAVE = 17408;
constexpr int GT_STG = 24576;
template <class RowPtr, class Epi>
__device__ __forceinline__ void mfma_tile(ldsp_t lds, const RowPtr& rp, const bf16_t* Bt, int K, const Epi& ep, int row0, int col0) {
    const int tid = threadIdx.x, lane = tid & 63, wid = __builtin_amdgcn_readfirstlane(tid >> 6), wr = wid >> 1, wc = wid & 1, fr = lane & 15, fq = lane >> 4;
    const int sch = ((tid & 3) ^ ((-(tid >> 4)) & 3)) * 8;
    const bf16_t* ap0 = rp(row0 + (tid >> 2)) + sch;
    const bf16_t* ap1 = rp(row0 + 64 + (tid >> 2)) + sch;
    const bf16_t* bp = Bt + (size_t)(tid >> 2) * K + sch;
    const size_t bstep = (size_t)64 * K;
    const int cterm = ((fq ^ ((-(fr >> 2)) & 3)) << 4);
    const int aoff = (wr * 64 + fr) * 64 + cterm, boff = 8192 + (wc * 128 + fr) * 64 + cterm;
    f32x4 acc[4][8];
#pragma unroll
    for (int m = 0; m < 4; ++m)
#pragma unroll
        for (int n = 0; n < 8; ++n) acc[m][n] = (f32x4){0.f, 0.f, 0.f, 0.f};
#define GT_STAGE(sb, k0) do { const ldsp_t d_ = lds + (sb) + wid * 1024; \
        __builtin_amdgcn_global_load_lds((const unsigned*)(ap0 + (k0)), (LAS unsigned*)(d_), 16, 0, 0); \
        __builtin_amdgcn_global_load_lds((const unsigned*)(ap1 + (k0)), (LAS unsigned*)(d_ + 4096), 16, 0, 0); \
        _Pragma("unroll") for (int i_ = 0; i_ < 4; ++i_) \
            __builtin_amdgcn_global_load_lds((const unsigned*)(bp + i_ * bstep + (k0)), (LAS unsigned*)(d_ + 8192 + i_ * 4096), 16, 0, 0); } while (0)
    const int nt = K >> 5;
    asm volatile("s_waitcnt lgkmcnt(0)" ::: "memory");
    __builtin_amdgcn_s_barrier();
    asm volatile("" ::: "memory");
    GT_STAGE(0, 0);
    GT_STAGE(GT_STG, 32);
    int scur = 0, snx = 2 * GT_STG;
#pragma unroll 1
    for (int t = 0; t < nt; ++t) {
        if (t + 1 < nt) asm volatile("s_waitcnt vmcnt(6)" ::: "memory"); else asm volatile("s_waitcnt vmcnt(0)" ::: "memory");
        __builtin_amdgcn_s_barrier();
        asm volatile("" ::: "memory");
        if (t + 2 < nt) GT_STAGE(snx, (t + 2) * 32);
        const ldsp_t base = lds + scur;
        bf16x8 af[4], bfr[8];
#pragma unroll
        for (int m = 0; m < 4; ++m) af[m] = *(const LAS bf16x8*)(base + aoff + m * 1024);
#pragma unroll
        for (int n = 0; n < 8; ++n) bfr[n] = *(const LAS bf16x8*)(base + boff + n * 1024);
#pragma unroll
        for (int m = 0; m < 4; ++m)
#pragma unroll
            for (int n = 0; n < 8; ++n) acc[m][n] = __builtin_amdgcn_mfma_f32_16x16x32_bf16(bfr[n], af[m], acc[m][n], 0, 0, 0);
        scur = (scur == 2 * GT_STG) ? 0 : scur + GT_STG;
        snx = (snx == 2 * GT_STG) ? 0 : snx + GT_STG;
    }
#undef GT_STAGE
    __syncthreads();
    ep(acc, lds + wid * EP_WAVE, row0 + wr * 64, col0 + wc * 128, lane);
}
typedef float f32x2_t __attribute__((ext_vector_type(2))); typedef __bf16 bf16x2_t __attribute__((ext_vector_type(2)));
__device__ __forceinline__ unsigned pk2(float lo, float hi) { f32x2_t v = {lo, hi}; bf16x2_t b = __builtin_convertvector(v, bf16x2_t); return __builtin_bit_cast(unsigned, b); }
__device__ __forceinline__ void st_bf16x4(bf16_t* p, float a, float b, float c, float d) { uint2 o; o.x = pk2(a, b); o.y = pk2(c, d); *(uint2*)p = o; }

struct RowPlain { const bf16_t* A; int lda; __device__ __forceinline__ const bf16_t* operator()(int r) const { return A + (size_t)r * lda; } };

constexpr int EPB = 272;
constexpr int EPF = 528;
__device__ __forceinline__ void ep_put4(ldsp_t wl, int row, int col, float a, float b, float c, float d) { u32x2 o; o.x = pk2(a, b); o.y = pk2(c, d); *(LAS u32x2*)(wl + row * EPB + col * 2) = o; }
struct MEpiQKV {
    bf16_t *Q, *K, *V; const float* rope;
    __device__ __forceinline__ void operator()(f32x4 (&acc)[4][8], ldsp_t wl, int rbase, int cbase0, int lane) const {
        const int fr = lane & 15, fq = lane >> 4;
#pragma unroll
        for (int hh = 0; hh < 2; ++hh) {
            const int cbase = cbase0 + hh * 64;
            const bool isq = cbase < 1024, isk = (cbase >= 1024 && cbase < 1280);
#pragma unroll
            for (int m = 0; m < 4; ++m) {
                const int r = rbase + m * 16 + fr;
                f32x4 v0 = acc[m][hh * 4 + 0], v1 = acc[m][hh * 4 + 1], v2 = acc[m][hh * 4 + 2], v3 = acc[m][hh * 4 + 3];
                if ((isq || isk) && r < TL) {
                    const int s = r & (S - 1), prow = s >> 6, pcol = s & 63;
                    const f32x4 cr = *(const f32x4*)(rope + prow * 16 + fq * 4), sr = *(const f32x4*)(rope + 1024 + prow * 16 + fq * 4);
                    const f32x4 cc = *(const f32x4*)(rope + pcol * 16 + fq * 4), sc = *(const f32x4*)(rope + 1024 + pcol * 16 + fq * 4);
                    const f32x4 o0 = v0 * cr - v1 * sr, o1 = v1 * cr + v0 * sr, o2 = v2 * cc - v3 * sc, o3 = v3 * cc + v2 * sc;
                    v0 = o0; v1 = o1; v2 = o2; v3 = o3;
                }
                if (isq) { v0 *= QSCALE; v1 *= QSCALE; v2 *= QSCALE; v3 *= QSCALE; }
                const int rl = m * 16 + fr, cl = hh * 64 + fq * 4;
                ep_put4(wl, rl, cl, v0[0], v0[1], v0[2], v0[3]); ep_put4(wl, rl, cl + 16, v1[0], v1[1], v1[2], v1[3]);
                ep_put4(wl, rl, cl + 32, v2[0], v2[1], v2[2], v2[3]); ep_put4(wl, rl, cl + 48, v3[0], v3[1], v3[2], v3[3]);
            }
        }
        const bool isq = cbase0 < 1024, isk = (cbase0 >= 1024 && cbase0 < 1280);
        bf16_t* base = isq ? (Q + cbase0) : isk ? (K + (cbase0 - 1024)) : (V + (cbase0 - 1280));
        const size_t pitch = isq ? 1024 : 256;
#pragma unroll 2
        for (int i = 0; i < 16; ++i) {
            const int rl = 4 * i + (lane >> 4), ch = lane & 15;
            const u32x4 v = *(const LAS u32x4*)(wl + rl * EPB + ch * 16);
            *(u32x4*)(base + (size_t)(rbase + rl) * pitch + ch * 8) = v;
        }
    }
};
struct MEpiResid {
    const float* srcL; const float* srcC; float* dstL; float* dstC; const float* mod; int gchunk;
    __device__ __forceinline__ void operator()(f32x4 (&acc)[4][8], ldsp_t wl, int rbase, int cbase, int lane) const {
        const int fr = lane & 15, fq = lane >> 4, c4 = (lane & 31) * 4;
        const f32x4 gv = *(const f32x4*)(mod + mod_row(rbase) * 6144 + gchunk * 1024 + cbase + c4);
        const bool latent = rbase < TL;
        const float* sbase = (latent ? srcL + (size_t)rbase * D : srcC + (size_t)(rbase - TL) * D) + cbase + c4 + (size_t)(lane >> 5) * D;
        float* dbase = (latent ? dstL + (size_t)rbase * D : dstC + (size_t)(rbase - TL) * D) + cbase + c4 + (size_t)(lane >> 5) * D;
#pragma unroll
        for (int half = 0; half < 2; ++half) {
#pragma unroll
            for (int mm = 0; mm < 2; ++mm)
#pragma unroll
                for (int n = 0; n < 8; ++n) *(LAS f32x4*)(wl + (mm * 16 + fr) * EPF + (n * 16 + fq * 4) * 4) = acc[half * 2 + mm][n];
#pragma unroll
            for (int q = 0; q < 2; ++q) {
                f32x4 sv[8];
#pragma unroll
                for (int i = 0; i < 8; ++i) sv[i] = *(const f32x4*)(sbase + (size_t)(half * 32 + 16 * q + 2 * i) * D);
#pragma unroll
                for (int i = 0; i < 8; ++i) {
                    const int rl = 16 * q + 2 * i + (lane >> 5);
                    const f32x4 v = *(const LAS f32x4*)(wl + rl * EPF + c4 * 4);
                    *(f32x4*)(dbase + (size_t)(half * 32 + 16 * q + 2 * i) * D) = sv[i] + gv * v;
                }
            }
        }
    }
};
struct MEpiInProj {
    bf16_t* G; bf16_t* PU;
    __device__ __forceinline__ void operator()(f32x4 (&acc)[4][8], ldsp_t wl, int rbase, int cbase, int lane) const {
        const int fr = lane & 15, fq = lane >> 4;
        const bool isg = cbase < DR;
#pragma unroll
        for (int m = 0; m < 4; ++m)
#pragma unroll
            for (int n = 0; n < 8; ++n) {
                const f32x4 v = acc[m][n];
                if (isg) ep_put4(wl, m * 16 + fr, n * 16 + fq * 4, gelu_tanh(v[0]), gelu_tanh(v[1]), gelu_tanh(v[2]), gelu_tanh(v[3]));
                else ep_put4(wl, m * 16 + fr, n * 16 + fq * 4, v[0], v[1], v[2], v[3]);
            }
        bf16_t* base = isg ? (G + cbase) : (PU + (cbase - DR));
#pragma unroll 2
        for (int i = 0; i < 16; ++i) {
            const int rl = 4 * i + (lane >> 4), ch = lane & 15, r = rbase + rl;
            const u32x4 v = *(const LAS u32x4*)(wl + rl * EPB + ch * 16);
            if (!isg || r < TL) *(u32x4*)(base + (size_t)r * DR + ch * 8) = v;
        }
    }
};
#define vblock() (c.vb)

template <class RowMap>
__device__ __forceinline__ void tr_item64(const float* W, int ldw, int k0, int n0, bf16_t* dst, int ldd, const RowMap& rm, int lane) {
    const int nq = lane >> 2, kg = lane & 3;
    f32x4 v[16];
    const float* src = W + (size_t)(k0 + kg * 8) * ldw + n0 + 4 * nq;
#pragma unroll
    for (int h = 0; h < 2; ++h)
#pragma unroll
        for (int i = 0; i < 8; ++i) v[h * 8 + i] = *(const f32x4*)(src + (size_t)(h * 32 + i) * ldw);
#pragma unroll
    for (int cc = 0; cc < 4; ++cc) {
        bf16_t* drow = dst + (size_t)rm(n0 + 4 * nq + cc) * ldd + k0 + kg * 8;
#pragma unroll
        for (int h = 0; h < 2; ++h) {
            u32x4 o; o.x = pk2(v[h * 8 + 0][cc], v[h * 8 + 1][cc]); o.y = pk2(v[h * 8 + 2][cc], v[h * 8 + 3][cc]); o.z = pk2(v[h * 8 + 4][cc], v[h * 8 + 5][cc]); o.w = pk2(v[h * 8 + 6][cc], v[h * 8 + 7][cc]);
            *(u32x4*)(drow + h * 32) = o;
        }
    }
}
struct RMPlain { __device__ __forceinline__ int operator()(int n) const { return n; } };
struct RMGateUp { int mat; __device__ __forceinline__ int operator()(int h) const { return (h >> 7) * 256 + ((h >> 6) & 1) * 128 + (((h >> 4) & 3) * 2 + mat) * 16 + (h & 15); } };
__device__ __forceinline__ void tr_plain(const float* W, int K, int N, bf16_t* dst, int item, int lane) {
    const int nb = N / 64, kb = item / nb, n0 = (item % nb) * 64;
    tr_item64(W, N, kb * 64, n0, dst, K, RMPlain{}, lane);
}
__device__ __forceinline__ void tr_expert(const float* Wg, const float* Wu, const float* Wd, bf16_t* gu, bf16_t* dn, int item, int lane) {
    if (item < 128) {
        const int mat = item >> 6, it = item & 63, kb = it >> 2, n0 = (it & 3) * 64;
        tr_item64(Wg + (size_t)mat * (Wu - Wg), DE, kb * 64, n0, gu, D, RMGateUp{mat}, lane);
    } else {
        const int it = item - 128, kb = it >> 4, n0 = (it & 15) * 64;
        tr_item64(Wd, D, kb * 64, n0, dn, DE, RMPlain{}, lane);
    }
}
struct Ctx {
    const Params& p; float* lds; ldsp_t smem;
    int tid, lane, wid, vb;
    __device__ __forceinline__ Ctx(const Params& p_, float* l, ldsp_t sm) : p(p_), lds(l), smem(sm) { tid = threadIdx.x; lane = tid & 63; wid = tid >> 6; vb = blockIdx.x; }
#define WSF(name, type, off) __device__ __forceinline__ type* name() const { return (type*)(p.ws + (off)); }
    WSF(cnt, unsigned, CTL_CNT) WSF(mod, float, CTL_MOD) WSF(rope, float, WS_ROPE) WSF(sum, float, WS_SUM)
    WSF(AE, int, WS_AE) WSF(AW, float, WS_AW) WSF(APOS, int, WS_APOS) WSF(LIST, int, WS_LIST) WSF(XC, float, WS_XC)
    WSF(H, bf16_t, WS_H) WSF(ACT, bf16_t, WS_ACT) WSF(ACTS, bf16_t, WS_ACTS) WSF(Y, bf16_t, WS_BIG)
    WSF(Qb, bf16_t, WS_Q) WSF(Kb, bf16_t, WS_K) WSF(Vb, bf16_t, WS_V) WSF(Ob, bf16_t, WS_O)
    WSF(WQKV, bf16_t, WS_WQKV) WSF(WO, bf16_t, WS_WO) WSF(WIN, bf16_t, WS_WIN) WSF(WOUT, bf16_t, WS_WOUT) WSF(WSH, bf16_t, WS_WSH) WSF(WMOE, bf16_t, WS_WMOE)
    WSF(WGATES, bf16_t, WS_WGATES) WSF(WROUTER, bf16_t, WS_WROUTER) WSF(LC8, float, WS_LC8) WSF(CARRY, float, WS_CARRY)
    WSF(G, bf16_t, WS_G) WSF(PU, bf16_t, WS_PU) WSF(HG, bf16_t, WS_G) WSF(AB, float, WS_AB) WSF(HS, float, WS_WMOE)
#undef WSF
};

__device__ __forceinline__ void ph_prep(Ctx& c) {
    const float* cv = c.p.in[1]; const float* cctx = c.p.in[3]; const float* aw = c.p.in[4]; const float* ab = c.p.in[5];
    float* sil = c.lds;
    float* red = c.lds + 5120;
    __syncthreads();
    for (int i = c.tid; i < 5 * 1024; i += NTHREADS) { const int r = i >> 10, k = i & 1023; const float v = r < 4 ? cv[r * 1024 + k] : cctx[k]; sil[i] = silu_f(v); }
    __syncthreads();
    for (int item = blockIdx.x; item < 2 * 96; item += gridDim.x) {
        const int l = item / 96, jb = item % 96, kq = c.tid >> 4, cq = c.tid & 15;
        f32x4 a0 = {0, 0, 0, 0}, a1 = a0, a2 = a0, a3 = a0, a4 = a0;
        const float* w = aw + ((size_t)l * 1024 + kq * 64) * 6144 + jb * 64 + cq * 4;
        const float* sl = sil + kq * 64;
#pragma unroll 8
        for (int k = 0; k < 64; ++k) { const f32x4 wv = *(const f32x4*)(w + (size_t)k * 6144); a0 += sl[k] * wv; a1 += sl[1024 + k] * wv; a2 += sl[2048 + k] * wv; a3 += sl[3072 + k] * wv; a4 += sl[4096 + k] * wv; }
        float* rr = red + kq * 320 + cq * 4;
        *(f32x4*)(rr) = a0; *(f32x4*)(rr + 64) = a1; *(f32x4*)(rr + 128) = a2; *(f32x4*)(rr + 192) = a3; *(f32x4*)(rr + 256) = a4;
        __syncthreads();
        for (int i = c.tid; i < 320; i += NTHREADS) {
            const int r = i >> 6, jj = i & 63;
            float v = 0.f;
#pragma unroll
            for (int q = 0; q < 16; ++q) v += red[q * 320 + i];
            c.mod()[((size_t)l * 5 + r) * 6144 + jb * 64 + jj] = v + ab[l * 6144 + jb * 64 + jj];
        }
        __syncthreads();
    }
    if (blockIdx.x == gridDim.x - 1) {
        for (int i = c.tid; i < 1024; i += NTHREADS) {
            const int pos = i >> 4, f = i & 15;
            const float inv = expf(-logf(10000.0f) * (float)f / 16.0f);
            const float ang = (float)pos * inv;
            c.rope()[i] = cosf(ang); c.rope()[1024 + i] = sinf(ang);
        }
    }
}


__device__ __forceinline__ int find_expert(const int* tp, int rt) {
    int e = 0;
#pragma unroll 1
    for (int i = 1; i <= 64; ++i) if (tp[i] <= rt) e = i;
    return e;
}


__device__ __forceinline__ void ph_convert_small(Ctx& c) {
    const int wu = __builtin_amdgcn_readfirstlane(c.wid);
    const int gw = blockIdx.x * 4 + wu, NGW = gridDim.x * 4;
    constexpr int I_QKV = 16 * 24, I_O = 16 * 16, I_IN = 16 * 40, I_OUT = 20 * 16, I_SH = 192, I_R = 16;
    constexpr int NIT = I_QKV + I_O + I_IN + I_OUT + 2 * I_SH + 2 * I_R;
    for (int it = gw; it < NIT; it += NGW) {
        int r = it;
        if (r < I_QKV) { tr_plain(c.p.in[8], 1024, 1536, c.WQKV(), r, c.lane); continue; } r -= I_QKV;
        if (r < I_O) { tr_plain(c.p.in[9], 1024, 1024, c.WO(), r, c.lane); continue; } r -= I_O;
        if (r < I_IN) { tr_plain(c.p.in[11], 1024, 2560, c.WIN(), r, c.lane); continue; } r -= I_IN;
        if (r < I_OUT) { tr_plain(c.p.in[19], 1280, 1024, c.WOUT(), r, c.lane); continue; } r -= I_OUT;
        if (r < 2 * I_SH) {
            const int l = r / I_SH; r %= I_SH;
            bf16_t* base = c.WSH() + (size_t)l * (WSH_LAYER / 2);
            tr_expert(c.p.in[25] + (size_t)l * D * DE, c.p.in[26] + (size_t)l * D * DE, c.p.in[27] + (size_t)l * DE * D, base, base + WSH_D / 2, r, c.lane);
            continue;
        }
        r -= 2 * I_SH;
        { const int l = r / I_R; r %= I_R; tr_plain(c.p.in[20] + (size_t)l * D * NE, D, NE, c.WROUTER() + (size_t)l * 128 * D, r, c.lane); }
    }
    for (int i = blockIdx.x * NTHREADS + c.tid; i < 2 * 64 * D / 8; i += gridDim.x * NTHREADS) { const int l = i / (64 * D / 8), o = i % (64 * D / 8); *(u32x4*)(c.WROUTER() + (size_t)l * 128 * D + 64 * D + (size_t)o * 8) = (u32x4){0u, 0u, 0u, 0u}; }
}
__device__ __forceinline__ void ph_convert_moe(Ctx& c, int layer) {
    const int wu = __builtin_amdgcn_readfirstlane(c.wid);
    const int gw = vblock() * 4 + wu, NGW = gridDim.x * 4;
    for (int it = gw; it < NE * 192; it += NGW) {
        const int e = it / 192, r = it % 192; const size_t eo = ((size_t)layer * NE + e) * D * DE;
        tr_expert(c.p.in[22] + eo, c.p.in[23] + eo, c.p.in[24] + eo, c.WMOE() + (size_t)e * 512 * 1024, c.WMOE() + WMOE_D / 2 + (size_t)e * 1024 * 256, r, c.lane);
    }
}
template <class Epi>
__device__ __forceinline__ void dense_gemm(Ctx& c, const bf16_t* A, int lda, int mtiles, const bf16_t* Bt, int K, int ntiles, const Epi& ep) {
    const RowPlain rp{A, lda};
    const int nItems = mtiles * ntiles;
    for (int item = vblock(); item < nItems; item += gridDim.x) {
        const int mt = item / ntiles, nt = item % ntiles;
        mfma_tile(c.smem, rp, Bt + (size_t)nt * 256 * K, K, ep, mt * 128, nt * 256);
    }
}
__device__ __forceinline__ void ph_qkv_m(Ctx& c) { const MEpiQKV ep{c.Qb(), c.Kb(), c.Vb(), c.rope()}; dense_gemm(c, c.H(), D, T0 / 128, c.WQKV(), D, QKVN / 256, ep); }
__device__ __forceinline__ void ph_oproj_m(Ctx& c) { const MEpiResid ep{c.p.in[0], c.p.in[2], c.p.out, c.XC(), c.mod(), 2}; dense_gemm(c, c.Ob(), D, T0 / 128, c.WO(), D, D / 256, ep); }
__device__ __forceinline__ void ph_inproj_m(Ctx& c) { const MEpiInProj ep{c.G(), c.PU()}; dense_gemm(c, c.H(), D, T0 / 128, c.WIN(), D, 2 * DR / 256, ep); }
__device__ __forceinline__ void ph_outproj_m(Ctx& c) { const MEpiResid ep{c.p.out, c.XC(), c.p.out, c.XC(), c.mod() + 5 * 6144, 2}; dense_gemm(c, c.HG(), DR, TL / 128, c.WOUT(), DR, D / 256, ep); }


__device__ __forceinline__ void moe_tables128(Ctx& c, int layer, int T, int* tbl) {
    __syncthreads();
    if (c.tid < 64) tbl[136 + c.tid] = (int)c.cnt()[layer * 64 + c.tid];
    __syncthreads();
    if (c.tid == 0) {
        int o = 0, t = 0;
        for (int e = 0; e < NE; ++e) { const int n = tbl[136 + e]; tbl[e] = o; tbl[65 + e] = t; o += n; t += (n + 127) >> 7; }
        tbl[64] = o; tbl[65 + 64] = t; tbl[65 + 65] = t + ((T + 127) >> 7);
    }
    __syncthreads();
}
struct RowGather { const bf16_t* H; const int* list; int n; bool shared;
    __device__ __forceinline__ const bf16_t* operator()(int r) const { if (r >= n) return H; const int tok = shared ? r : (list[r] >> 3); return H + (size_t)tok * D; } };
struct MEpiAct { bf16_t* act; int n;
    __device__ __forceinline__ void operator()(f32x4 (&acc)[4][8], ldsp_t wl, int rbase, int cbase, int lane) const {
        const int fr = lane & 15, fq = lane >> 4;
#pragma unroll
        for (int m = 0; m < 4; ++m)
#pragma unroll
            for (int q = 0; q < 4; ++q) { const f32x4 g = acc[m][2 * q], u = acc[m][2 * q + 1];
                ep_put4(wl, m * 16 + fr, q * 16 + fq * 4, silu_f(g[0]) * u[0], silu_f(g[1]) * u[1], silu_f(g[2]) * u[2], silu_f(g[3]) * u[3]); }
        bf16_t* base = act + (cbase >> 1);
#pragma unroll 2
        for (int i = 0; i < 8; ++i) {
            const int rl = 8 * i + (lane >> 3), ch = lane & 7, r = rbase + rl;
            const u32x4 v = *(const LAS u32x4*)(wl + rl * EPB + ch * 16);
            if (r < n) *(u32x4*)(base + (size_t)r * DE + ch * 8) = v;
        }
    }
};
__device__ __forceinline__ void ph_moe_gateup_m(Ctx& c, int layer, int T) {
    int* tbl = (int*)(c.smem + LDS_LRU_END + 16);
    moe_tables128(c, layer, T, tbl);
    const int* tp = tbl + 65; const int ntile = tp[65];
#pragma unroll 1
    for (int item = vblock(); item < ntile * 2; item += gridDim.x) {
        const int rt = item >> 1, nt = item & 1, e = find_expert(tp, rt), mt = rt - tp[e];
        const bool sh = e >= NE;
        const int n = sh ? T : tbl[136 + e];
        const RowGather rp{c.H(), c.LIST() + (size_t)(sh ? 0 : e) * T0, n, sh};
        const bf16_t* Bt = (sh ? c.WSH() + (size_t)layer * (WSH_LAYER / 2) : c.WMOE() + (size_t)e * 512 * 1024) + (size_t)nt * 256 * D;
        const MEpiAct ep{sh ? c.ACTS() : c.ACT() + (size_t)tbl[e] * DE, n};
        mfma_tile(c.smem, rp, Bt, D, ep, mt * 128, nt * 256);
    }
}
struct MEpiDown { bf16_t* Y; const int* list; const float* aw; int n; bool shared; float* xl; float* xc; const float* mod; int a_reg; float w_reg;
    __device__ __forceinline__ void operator()(f32x4 (&acc)[4][8], ldsp_t wl, int rbase, int cbase, int lane) const {
        const int fr = lane & 15, fq = lane >> 4;
        if (!shared) {
#pragma unroll
            for (int m = 0; m < 4; ++m) {
                const float w = __shfl(w_reg, m * 16 + fr);
#pragma unroll
                for (int nn = 0; nn < 8; ++nn) ep_put4(wl, m * 16 + fr, nn * 16 + fq * 4, w * acc[m][nn][0], w * acc[m][nn][1], w * acc[m][nn][2], w * acc[m][nn][3]);
            }
#pragma unroll 2
            for (int i = 0; i < 16; ++i) {
                const int rl = 4 * i + (lane >> 4), ch = lane & 15, r = rbase + rl;
                const u32x4 v = *(const LAS u32x4*)(wl + rl * EPB + ch * 16);
                const int a = __shfl(a_reg, rl);
                if (r < n) *(u32x4*)(Y + (size_t)a * D + cbase + ch * 8) = v;
            }
        } else {
#pragma unroll
            for (int half = 0; half < 2; ++half) {
#pragma unroll
                for (int mm = 0; mm < 2; ++mm)
#pragma unroll
                    for (int nn = 0; nn < 8; ++nn) *(LAS f32x4*)(wl + (mm * 16 + fr) * EPF + (nn * 16 + fq * 4) * 4) = acc[half * 2 + mm][nn];
#pragma unroll 2
                for (int i = 0; i < 16; ++i) {
                    const int rl = 2 * i + (lane >> 5), c4 = (lane & 31) * 4, r = rbase + half * 32 + rl;
                    const f32x4 v = *(const LAS f32x4*)(wl + rl * EPF + c4 * 4);
                    if (r < n) {
                        const f32x4 gv = *(const f32x4*)(mod + mod_row(r) * 6144 + 5 * 1024 + cbase + c4);
                        float* d = (r < TL ? xl + (size_t)r * D : xc + (size_t)(r - TL) * D) + cbase + c4;
                        *(f32x4*)d += gv * v;
                    }
                }
            }
        }
    }
};
__device__ __forceinline__ void ph_moe_down_m(Ctx& c, int layer, int T) {
    int* tbl = (int*)(c.smem + LDS_LRU_END + 16);
    moe_tables128(c, layer, T, tbl);
    const int* tp = tbl + 65; const int ntile = tp[65];
    const float* modl = c.mod() + (size_t)layer * 5 * 6144;
#pragma unroll 1
    for (int item = vblock(); item < ntile * 4; item += gridDim.x) {
        const int rt = item >> 2, nt = item & 3, e = find_expert(tp, rt), mt = rt - tp[e];
        const bool sh = e >= NE;
        const int n = sh ? T : tbl[136 + e];
        const RowPlain rp{sh ? c.ACTS() : c.ACT() + (size_t)tbl[e] * DE, DE};
        const bf16_t* Bt = (sh ? c.WSH() + (size_t)layer * (WSH_LAYER / 2) + WSH_D / 2 : c.WMOE() + WMOE_D / 2 + (size_t)e * 1024 * 256) + (size_t)nt * 256 * DE;
        int a_reg = 0; float w_reg = 0.f;
        if (!sh) { const int rr = mt * 128 + (__builtin_amdgcn_readfirstlane(c.tid >> 6) >> 1) * 64 + c.lane; if (rr < n) { a_reg = c.LIST()[(size_t)e * T0 + rr]; w_reg = c.AW()[a_reg]; } }
        const MEpiDown ep{c.Y(), c.LIST() + (size_t)(sh ? 0 : e) * T0, c.AW(), n, sh, c.p.out, c.XC(), modl, a_reg, w_reg};
        mfma_tile(c.smem, rp, Bt, DE, ep, mt * 128, nt * 256);
    }
}


constexpr int NCH = 68;
constexpr int LU_PITCH = 104;
__device__ __forceinline__ float fast_sigmoid(float x) { return __builtin_amdgcn_rcpf(1.f + __builtin_amdgcn_exp2f(-LOG2E * x)); }
__device__ __forceinline__ void ph_convert_gates(Ctx& c) {
    const int NT = gridDim.x * NTHREADS, g0 = blockIdx.x * NTHREADS + c.tid;
    for (int i = g0; i < 2 * 2 * NBLK * BW * 96; i += NT) {
        const int k = i % 96, col = (i / 96) % BW, n = (i / (96 * BW)) % NBLK, mat = (i / (96 * BW * NBLK)) & 1, d = i / (96 * BW * NBLK * 2);
        const float* w = (mat ? c.p.in[16] : c.p.in[14]) + (((size_t)d * NBLK + n) * BW) * BW;
        c.WGATES()[i] = k < BW ? f2bf(w[(size_t)k * BW + col]) : (bf16_t)0;
    }
    for (int i = g0; i < 2 * DR; i += NT) c.LC8()[i] = 8.0f * LOG2E * log1pf(expf(-c.p.in[18][i]));
}
constexpr int L2_U = 0, L2_RAW = 13312, L2_OUT = L2_RAW + 10752, L2_END = L2_OUT + 2 * 64 * BW * 4;
template <bool REV, int PASS>
__device__ __forceinline__ void lru_scan16(const float (&a)[4][4], const float (&b)[4][4], float& cm, float& ptot, float (&h)[4][4], int lane, int fq) {
    const int l16 = REV ? ((lane + 16) & 63) : ((lane - 16) & 63), l32 = REV ? ((lane + 32) & 63) : ((lane - 32) & 63);
    const int ltot = (lane & 15) + (REV ? 0 : 48);
    float P[4], H[4], Pe[4], He[4], Pt[4], Ht[4];
#pragma unroll
    for (int m = 0; m < 4; ++m) {
        P[m] = 1.f; H[m] = 0.f;
#pragma unroll
        for (int jj = 0; jj < 4; ++jj) { const int j = REV ? 3 - jj : jj; H[m] = a[m][j] * H[m] + b[m][j]; P[m] *= a[m][j]; }
    }
    {   float Pp[4], Hp[4];
#pragma unroll
        for (int m = 0; m < 4; ++m) { Pp[m] = __shfl(P[m], l16); Hp[m] = __shfl(H[m], l16); }
#pragma unroll
        for (int m = 0; m < 4; ++m) if (REV ? (fq <= 2) : (fq >= 1)) { H[m] = P[m] * Hp[m] + H[m]; P[m] = P[m] * Pp[m]; }
#pragma unroll
        for (int m = 0; m < 4; ++m) { Pp[m] = __shfl(P[m], l32); Hp[m] = __shfl(H[m], l32); }
#pragma unroll
        for (int m = 0; m < 4; ++m) if (REV ? (fq <= 1) : (fq >= 2)) { H[m] = P[m] * Hp[m] + H[m]; P[m] = P[m] * Pp[m]; }
    }
#pragma unroll
    for (int m = 0; m < 4; ++m) { Pe[m] = __shfl(P[m], l16); He[m] = __shfl(H[m], l16); Pt[m] = __shfl(P[m], ltot); Ht[m] = __shfl(H[m], ltot); }
#pragma unroll
    for (int m = 0; m < 4; ++m) if (REV ? (fq == 3) : (fq == 0)) { Pe[m] = 1.f; He[m] = 0.f; }
#pragma unroll
    for (int mm = 0; mm < 4; ++mm) {
        const int m = REV ? 3 - mm : mm;
        const float hin = Pe[m] * cm + He[m];
        cm = Pt[m] * cm + Ht[m]; ptot *= Pt[m];
        if (PASS == 2) {
            float hh = hin;
#pragma unroll
            for (int jj = 0; jj < 4; ++jj) { const int j = REV ? 3 - jj : jj; hh = a[m][j] * hh + b[m][j]; h[m][j] = hh; }
        }
    }
}
template <int PASS>
__device__ __forceinline__ void ph_lru_pass(Ctx& c) {
    const int wu = __builtin_amdgcn_readfirstlane(c.wid), lane = c.lane, fr = lane & 15, fq = lane >> 4;
    const int dir = wu >> 1, nt0 = (wu & 1) ? 3 : 0, nnt = (wu & 1) ? 2 : 3;
    constexpr int NC = PASS == 1 ? NCH : 64;
    const float* cw = c.p.in[12]; const float* cb = c.p.in[13];
#pragma unroll 1
    for (int unit = vblock(); unit < NB * NC * NBLK; unit += gridDim.x) {
        const int n = unit % NBLK, cidx = (unit / NBLK) % NC + (PASS == 1 ? 0 : 4), b = unit / (NBLK * NC);
        int r0, seq0, seqn;
        if (cidx < 4) { seq0 = TL + b * C; seqn = C; r0 = seq0 + cidx * 64; } else { seq0 = b * S; seqn = S; r0 = seq0 + (cidx - 4) * 64; }
        __syncthreads();
        for (int idx = c.tid; idx < 67 * 10; idx += NTHREADS) {
            const int row = idx / 10, c8i = idx % 10, rr = r0 - 2 + row;
            u32x4 v = (u32x4){0u, 0u, 0u, 0u};
            if (rr >= seq0 && rr < seq0 + seqn) v = *(const u32x4*)(c.PU() + (size_t)rr * DR + n * BW + c8i * 8);
            *(LAS u32x4*)(c.smem + L2_RAW + row * 160 + c8i * 16) = v;
        }
        __syncthreads();
        for (int idx = c.tid; idx < 64 * 20; idx += NTHREADS) {
            const int t = idx / 20, c4 = (idx % 20) * 4, ch = n * BW + c4;
            float u0 = cb[ch], u1 = cb[ch + 1], u2 = cb[ch + 2], u3 = cb[ch + 3];
#pragma unroll
            for (int j = 0; j < 4; ++j) {
                const u32x2 raw = *(const LAS u32x2*)(c.smem + L2_RAW + (t + j) * 160 + c4 * 2);
                const float4 w = *(const float4*)(cw + j * DR + ch);
                u0 += w.x * __uint_as_float(raw.x << 16); u1 += w.y * __uint_as_float(raw.x & 0xffff0000u);
                u2 += w.z * __uint_as_float(raw.y << 16); u3 += w.w * __uint_as_float(raw.y & 0xffff0000u);
            }
            u32x2 o; o.x = pk2(u0, u1); o.y = pk2(u2, u3);
            *(LAS u32x2*)(c.smem + L2_U + (t * LU_PITCH + c4) * 2) = o;
        }
        for (int idx = c.tid; idx < 64 * 3; idx += NTHREADS) { const int t = idx / 3, q = idx % 3; *(LAS u32x4*)(c.smem + L2_U + (t * LU_PITCH + 80 + q * 8) * 2) = (u32x4){0u, 0u, 0u, 0u}; }
        __syncthreads();
        bf16x8 af[4][3];
#pragma unroll
        for (int m = 0; m < 4; ++m)
#pragma unroll
            for (int ks = 0; ks < 3; ++ks) af[m][ks] = *(const LAS bf16x8*)(c.smem + L2_U + (16 * m + fr) * (LU_PITCH * 2) + (ks * 32 + fq * 8) * 2);
        const bf16_t* wbase = c.WGATES() + ((((size_t)dir * 2) * NBLK + n) * BW + fr) * 96 + fq * 8;
        bf16x8 bcur[2][3];
#pragma unroll
        for (int mat = 0; mat < 2; ++mat)
#pragma unroll
            for (int ks = 0; ks < 3; ++ks) bcur[mat][ks] = *(const bf16x8*)(wbase + (size_t)mat * NBLK * BW * 96 + nt0 * 16 * 96 + ks * 32);
#pragma unroll 1
        for (int i = 0; i < nnt; ++i) {
            const int nt = nt0 + i, cl = nt * 16 + fr, ch = n * BW + cl;
            const float bav = c.p.in[15][dir * DR + ch], bxv = c.p.in[17][dir * DR + ch], c8v = c.LC8()[dir * DR + ch];
            float cm = PASS == 1 ? 0.f : c.CARRY()[((size_t)(b * 2 + dir) * NCH + cidx) * DR + ch], ptot = 1.f;
            f32x4 acc[2][4];
#pragma unroll
            for (int mat = 0; mat < 2; ++mat)
#pragma unroll
                for (int m = 0; m < 4; ++m) {
                    acc[mat][m] = (f32x4){0.f, 0.f, 0.f, 0.f};
#pragma unroll
                    for (int ks = 0; ks < 3; ++ks) acc[mat][m] = __builtin_amdgcn_mfma_f32_16x16x32_bf16(af[m][ks], bcur[mat][ks], acc[mat][m], 0, 0, 0);
                }
            if (i + 1 < nnt) {
#pragma unroll
                for (int mat = 0; mat < 2; ++mat)
#pragma unroll
                    for (int ks = 0; ks < 3; ++ks) bcur[mat][ks] = *(const bf16x8*)(wbase + (size_t)mat * NBLK * BW * 96 + (nt + 1) * 16 * 96 + ks * 32);
            }
            float av[4][4], bv[4][4], hv[4][4];
#pragma unroll
            for (int m = 0; m < 4; ++m)
#pragma unroll
                for (int j = 0; j < 4; ++j) {
                    const int t = 16 * m + fq * 4 + j;
                    const float r = fast_sigmoid(acc[0][m][j] + bav), ig = fast_sigmoid(acc[1][m][j] + bxv);
                    const float a = __builtin_amdgcn_exp2f(-c8v * r);
                    const float uv = bf2f(*(const LAS bf16_t*)(c.smem + L2_U + (t * LU_PITCH + cl) * 2));
                    av[m][j] = a; bv[m][j] = __builtin_amdgcn_sqrtf(fmaxf(1.f - a * a, 0.f)) * (ig * uv);
                }
            if (dir == 0) lru_scan16<false, PASS>(av, bv, cm, ptot, hv, lane, fq); else lru_scan16<true, PASS>(av, bv, cm, ptot, hv, lane, fq);
            if (PASS == 1) {
                if (fq == 0) { float* sp = c.sum() + (((size_t)(b * 2 + dir) * NCH + cidx) * 2) * DR + ch; sp[0] = ptot; sp[DR] = cm; }
            } else {
#pragma unroll
                for (int m = 0; m < 4; ++m)
#pragma unroll
                    for (int j = 0; j < 4; ++j) *(LAS float*)(c.smem + L2_OUT + ((dir * 64 + 16 * m + fq * 4 + j) * BW + cl) * 4) = hv[m][j];
            }
        }
        if (PASS == 2) {
            __syncthreads();
            for (int idx = c.tid; idx < 64 * 20; idx += NTHREADS) {
                const int t = idx / 20, c4 = (idx % 20) * 4;
                const f32x4 h0 = *(const LAS f32x4*)(c.smem + L2_OUT + (t * BW + c4) * 4), h1 = *(const LAS f32x4*)(c.smem + L2_OUT + ((64 + t) * BW + c4) * 4);
                bf16_t* gp = c.G() + (size_t)(r0 + t) * DR + n * BW + c4;
                const uint2 g = *(const uint2*)gp;
                st_bf16x4(gp, (h0[0] + h1[0]) * __uint_as_float(g.x << 16), (h0[1] + h1[1]) * __uint_as_float(g.x & 0xffff0000u),
                          (h0[2] + h1[2]) * __uint_as_float(g.y << 16), (h0[3] + h1[3]) * __uint_as_float(g.y & 0xffff0000u));
            }
        }
    }
}
__device__ __forceinline__ void ph_lru_carry(Ctx& c) {
    for (int i = blockIdx.x * NTHREADS + c.tid; i < NB * 2 * DR; i += gridDim.x * NTHREADS) {
        const int ch = i % DR, d = (i / DR) & 1, b = i / (2 * DR);
        const float* sp = c.sum() + ((size_t)(b * 2 + d) * NCH * 2) * DR + ch; float* cp = c.CARRY() + ((size_t)(b * 2 + d) * NCH) * DR + ch;
        float h = 0.f;
        if (d == 0) {
#pragma unroll 4
            for (int k = 0; k < NCH; ++k) { cp[(size_t)k * DR] = h; h = sp[(size_t)k * 2 * DR] * h + sp[(size_t)k * 2 * DR + DR]; }
        } else {
#pragma unroll 4
            for (int k = 3; k >= 0; --k) { cp[(size_t)k * DR] = h; h = sp[(size_t)k * 2 * DR] * h + sp[(size_t)k * 2 * DR + DR]; }
#pragma unroll 4
            for (int k = NCH - 1; k >= 4; --k) { cp[(size_t)k * DR] = h; h = sp[(size_t)k * 2 * DR] * h + sp[(size_t)k * 2 * DR + DR]; }
        }
    }
}


typedef float f32x16 __attribute__((ext_vector_type(16)));
typedef short s16x4 __attribute__((ext_vector_type(4)));
__device__ __forceinline__ s16x4 vtr(const LAS unsigned char* p) { return __builtin_bit_cast(s16x4, __builtin_amdgcn_ds_read_tr16_b64_v4i16((LAS s16x4*)p)); }
constexpr int AT_BUF = 16384;
__device__ __forceinline__ void ph_attn_m(Ctx& c) {
    const int tid = c.tid, lane = c.lane, wu = __builtin_amdgcn_readfirstlane(c.wid), r32 = lane & 31, hi = lane >> 5;
    const float* sinkp = c.p.in[10];
    const int NU = NB * 32 * NH + NB * 2 * NH;
#pragma unroll 1
    for (int unit = vblock(); unit < NU; unit += gridDim.x) {
        int b, qb, h, q0, nt, ilo;
        bool lat = unit < NB * 32 * NH;
        if (lat) { h = unit & 15; qb = (unit >> 4) & 31; b = unit >> 9; q0 = b * S + qb * 128; ilo = (qb == 0) ? 2 : 0; const int ihi = (qb == 31) ? 3 : 5; nt = 4 + (ihi - ilo + 1); }
        else { const int u2 = unit - NB * 32 * NH; h = u2 & 15; qb = (u2 >> 4) & 1; b = u2 >> 5; q0 = TL + b * C + qb * 128; ilo = 0; nt = 4; }
        const int g = h >> 2;
        const bf16_t* kbase = c.Kb() + (size_t)lane * KD + g * 64 + (2 * wu) * 8;
        const bf16_t* vbase = c.Vb() + (size_t)(16 * wu + (lane >> 2)) * KD + g * 64 + (lane & 3) * 8;
#define AT_STAGE(buf, kr0) do { \
        __builtin_amdgcn_global_load_lds((const unsigned*)(kbase + (size_t)(kr0) * KD), (LAS unsigned*)(c.smem + (buf) * AT_BUF + (2 * wu) * 1024), 16, 0, 0); \
        __builtin_amdgcn_global_load_lds((const unsigned*)(kbase + (size_t)(kr0) * KD + 8), (LAS unsigned*)(c.smem + (buf) * AT_BUF + (2 * wu + 1) * 1024), 16, 0, 0); \
        __builtin_amdgcn_global_load_lds((const unsigned*)(vbase + (size_t)(kr0) * KD), (LAS unsigned*)(c.smem + (buf) * AT_BUF + 8192 + wu * 1024), 16, 0, 0); \
        __builtin_amdgcn_global_load_lds((const unsigned*)(vbase + (size_t)(kr0) * KD + 32), (LAS unsigned*)(c.smem + (buf) * AT_BUF + 8192 + 4096 + wu * 1024), 16, 0, 0); } while (0)
#define AT_KR0(j) ((j) < 4 ? (TL + b * C + (j) * 64) : (b * S + qb * 128 - 128 + 64 * (ilo + (j) - 4)))
        bf16x8 qr[4];
        { const bf16_t* qp = c.Qb() + (size_t)(q0 + 32 * wu + r32) * 1024 + h * 64 + hi * 8;
#pragma unroll
          for (int ds = 0; ds < 4; ++ds) qr[ds] = *(const bf16x8*)(qp + ds * 16); }
        float m = sinkp[h] * LOG2E, l = hi == 0 ? 1.f : 0.f;
        f32x16 o0, o1;
#pragma unroll
        for (int r = 0; r < 16; ++r) { o0[r] = 0.f; o1[r] = 0.f; }
        const int qi = 32 * wu + r32;
        const int vaddr = ((lane >> 4) & 1) * 32 + (lane & 3) * 8 + (4 * hi + ((lane & 15) >> 2)) * 64;
        __syncthreads();
        AT_STAGE(0, AT_KR0(0));
        AT_STAGE(1, AT_KR0(1));
        AT_STAGE(2, AT_KR0(2));
#pragma unroll 1
        for (int j = 0; j < nt; ++j) {
            if (j + 2 < nt) asm volatile("s_waitcnt vmcnt(8)" ::: "memory");
            else if (j + 1 < nt) asm volatile("s_waitcnt vmcnt(4)" ::: "memory");
            else asm volatile("s_waitcnt vmcnt(0)" ::: "memory");
            __builtin_amdgcn_s_barrier();
            asm volatile("" ::: "memory");
            if (j + 3 < nt) { const int kr1 = AT_KR0(j + 3); AT_STAGE((j + 3) & 3, kr1); }
            const ldsp_t kb = c.smem + (j & 3) * AT_BUF, vb = kb + 8192;
            f32x16 p0, p1;
#pragma unroll
            for (int r = 0; r < 16; ++r) { p0[r] = 0.f; p1[r] = 0.f; }
#pragma unroll
            for (int ds = 0; ds < 4; ++ds) {
                const bf16x8 k0 = *(const LAS bf16x8*)(kb + (ds * 2 + hi) * 1024 + r32 * 16);
                const bf16x8 k1 = *(const LAS bf16x8*)(kb + (ds * 2 + hi) * 1024 + (32 + r32) * 16);
                p0 = __builtin_amdgcn_mfma_f32_32x32x16_bf16(k0, qr[ds], p0, 0, 0, 0);
                p1 = __builtin_amdgcn_mfma_f32_32x32x16_bf16(k1, qr[ds], p1, 0, 0, 0);
            }
            if (lat && j >= 4) {
                const int i = ilo + j - 4;
                if (i < 2 || i > 3) {
                    const int kj0 = 64 * i + 4 * hi;
#pragma unroll
                    for (int r = 0; r < 16; ++r) {
                        const int kj = kj0 + (r & 3) + 8 * (r >> 2);
                        if (kj < qi || kj > qi + 256) p0[r] = -INFINITY;
                        if (kj + 32 < qi || kj + 32 > qi + 256) p1[r] = -INFINITY;
                    }
                }
            }
            float mx = fmaxf(p0[0], p1[0]);
#pragma unroll
            for (int r = 1; r < 16; ++r) mx = fmaxf(mx, fmaxf(p0[r], p1[r]));
            mx = fmaxf(mx, __shfl_xor(mx, 32));
            const float mn = fmaxf(m, mx);
            const float alpha = __builtin_amdgcn_exp2f(m - mn);
            m = mn;
            float ls = 0.f;
#pragma unroll
            for (int r = 0; r < 16; ++r) { p0[r] = __builtin_amdgcn_exp2f(p0[r] - mn); p1[r] = __builtin_amdgcn_exp2f(p1[r] - mn); ls += p0[r] + p1[r]; }
            l = l * alpha + ls;
            if (__any(alpha != 1.f)) {
#pragma unroll
                for (int r = 0; r < 16; ++r) { o0[r] *= alpha; o1[r] *= alpha; }
            }
#pragma unroll
            for (int sub = 0; sub < 2; ++sub)
#pragma unroll
                for (int sk = 0; sk < 2; ++sk) {
                    u32x4 pw;
                    if (sub == 0) { pw.x = pk2(p0[8 * sk + 0], p0[8 * sk + 1]); pw.y = pk2(p0[8 * sk + 2], p0[8 * sk + 3]); pw.z = pk2(p0[8 * sk + 4], p0[8 * sk + 5]); pw.w = pk2(p0[8 * sk + 6], p0[8 * sk + 7]); }
                    else { pw.x = pk2(p1[8 * sk + 0], p1[8 * sk + 1]); pw.y = pk2(p1[8 * sk + 2], p1[8 * sk + 3]); pw.z = pk2(p1[8 * sk + 4], p1[8 * sk + 5]); pw.w = pk2(p1[8 * sk + 6], p1[8 * sk + 7]); }
                    const bf16x8 pf = __builtin_bit_cast(bf16x8, pw);
                    const int ko = (sub * 32 + sk * 16) * 64;
                    const s16x4 a0 = vtr(vb + vaddr + ko), a1 = vtr(vb + vaddr + ko + 512);
                    const s16x4 b0 = vtr(vb + 4096 + vaddr + ko), b1 = vtr(vb + 4096 + vaddr + ko + 512);
                    const bf16x8 vf0 = (bf16x8){a0[0], a0[1], a0[2], a0[3], a1[0], a1[1], a1[2], a1[3]};
                    const bf16x8 vf1 = (bf16x8){b0[0], b0[1], b0[2], b0[3], b1[0], b1[1], b1[2], b1[3]};
                    o0 = __builtin_amdgcn_mfma_f32_32x32x16_bf16(vf0, pf, o0, 0, 0, 0);
                    o1 = __builtin_amdgcn_mfma_f32_32x32x16_bf16(vf1, pf, o1, 0, 0, 0);
                }
        }
#undef AT_STAGE
#undef AT_KR0
        l += __shfl_xor(l, 32);
        const float rl = 1.f / l;
        bf16_t* op = c.Ob() + (size_t)(q0 + qi) * 1024 + h * 64 + 4 * hi;
#pragma unroll
        for (int g4 = 0; g4 < 4; ++g4) {
            st_bf16x4(op + 8 * g4, o0[4 * g4] * rl, o0[4 * g4 + 1] * rl, o0[4 * g4 + 2] * rl, o0[4 * g4 + 3] * rl);
            st_bf16x4(op + 32 + 8 * g4, o1[4 * g4] * rl, o1[4 * g4 + 1] * rl, o1[4 * g4 + 2] * rl, o1[4 * g4 + 3] * rl);
        }
    }
}


struct Row16 { float v[2][8]; };
__device__ __forceinline__ void row_load(Row16& x, const float* src, int lane) {
#pragma unroll
    for (int j = 0; j < 2; ++j) { const f32x4 a = *(const f32x4*)(src + j * 512 + lane * 8), b = *(const f32x4*)(src + j * 512 + lane * 8 + 4);
        x.v[j][0] = a[0]; x.v[j][1] = a[1]; x.v[j][2] = a[2]; x.v[j][3] = a[3]; x.v[j][4] = b[0]; x.v[j][5] = b[1]; x.v[j][6] = b[2]; x.v[j][7] = b[3]; }
}
__device__ __forceinline__ void row_store(const Row16& x, float* dst, int lane) {
#pragma unroll
    for (int j = 0; j < 2; ++j) { *(f32x4*)(dst + j * 512 + lane * 8) = (f32x4){x.v[j][0], x.v[j][1], x.v[j][2], x.v[j][3]}; *(f32x4*)(dst + j * 512 + lane * 8 + 4) = (f32x4){x.v[j][4], x.v[j][5], x.v[j][6], x.v[j][7]}; }
}
__device__ __forceinline__ float row_rinv(const Row16& x) {
    float ss = 0.f;
#pragma unroll
    for (int j = 0; j < 2; ++j)
#pragma unroll
        for (int e = 0; e < 8; ++e) ss += x.v[j][e] * x.v[j][e];
    return rsqrtf(wave_sum(ss) * (1.0f / D) + RMS_EPS);
}
__device__ __forceinline__ void row_normmod_store(const Row16& x, float rinv, const float* g, const float* shift, const float* scale, bf16_t* dst, int lane) {
#pragma unroll
    for (int j = 0; j < 2; ++j) {
        const int k = j * 512 + lane * 8; float h[8];
#pragma unroll
        for (int q = 0; q < 2; ++q) { const f32x4 gv = *(const f32x4*)(g + k + 4 * q), sh = *(const f32x4*)(shift + k + 4 * q), sc = *(const f32x4*)(scale + k + 4 * q);
#pragma unroll
            for (int e = 0; e < 4; ++e) h[4 * q + e] = (x.v[j][4 * q + e] * rinv * gv[e]) * (1.f + sc[e]) + sh[e]; }
        u32x4 o; o.x = pk2(h[0], h[1]); o.y = pk2(h[2], h[3]); o.z = pk2(h[4], h[5]); o.w = pk2(h[6], h[7]);
        *(u32x4*)(dst + k) = o;
    }
}
__device__ __forceinline__ void row_combine(Row16& x, const bf16_t* Y, int r, const float* g2, int lane) {
#pragma unroll
    for (int j = 0; j < 2; ++j) {
        const int k = j * 512 + lane * 8; float s[8];
#pragma unroll
        for (int e = 0; e < 8; ++e) s[e] = 0.f;
#pragma unroll
        for (int kk = 0; kk < TOPK; ++kk) { const u32x4 y = *(const u32x4*)(Y + ((size_t)r * 8 + kk) * D + k);
            s[0] += __uint_as_float(y.x << 16); s[1] += __uint_as_float(y.x & 0xffff0000u); s[2] += __uint_as_float(y.y << 16); s[3] += __uint_as_float(y.y & 0xffff0000u);
            s[4] += __uint_as_float(y.z << 16); s[5] += __uint_as_float(y.z & 0xffff0000u); s[6] += __uint_as_float(y.w << 16); s[7] += __uint_as_float(y.w & 0xffff0000u); }
        const f32x4 ga = *(const f32x4*)(g2 + k), gb = *(const f32x4*)(g2 + k + 4);
#pragma unroll
        for (int e = 0; e < 4; ++e) { x.v[j][e] += ga[e] * s[e]; x.v[j][4 + e] += gb[e] * s[4 + e]; }
    }
}
__device__ __forceinline__ float* xrow_ptr(Ctx& c, int r) { return r < TL ? c.p.out + (size_t)r * D : c.XC() + (size_t)(r - TL) * D; }
__device__ __forceinline__ void ph_norm1_l0_w(Ctx& c) {
    const float* g = c.p.in[6]; constexpr int RB = 2;
    for (int r0 = (blockIdx.x * 4 + c.wid) * RB; r0 < T0; r0 += gridDim.x * 4 * RB) {
        Row16 x[RB];
#pragma unroll
        for (int i = 0; i < RB; ++i) { const int r = r0 + i; row_load(x[i], r < TL ? c.p.in[0] + (size_t)r * D : c.p.in[2] + (size_t)(r - TL) * D, c.lane); }
#pragma unroll
        for (int i = 0; i < RB; ++i) { const int r = r0 + i; const float* m = c.mod() + mod_row(r) * 6144;
            row_normmod_store(x[i], row_rinv(x[i]), g, m, m + 1024, c.H() + (size_t)r * D, c.lane); }
    }
}
__device__ __forceinline__ void ph_norm2_w(Ctx& c, int layer) {
    const int T = layer == 0 ? T0 : TL; const float* g = c.p.in[7] + layer * D; constexpr int RB = 2;
    for (int r0 = (blockIdx.x * 4 + c.wid) * RB; r0 < T; r0 += gridDim.x * 4 * RB) {
        Row16 x[RB];
#pragma unroll
        for (int i = 0; i < RB; ++i) row_load(x[i], xrow_ptr(c, r0 + i), c.lane);
#pragma unroll
        for (int i = 0; i < RB; ++i) { const int r = r0 + i; const float* m = c.mod() + ((size_t)layer * 5 + mod_row(r)) * 6144;
            row_normmod_store(x[i], row_rinv(x[i]), g, m + 3 * 1024, m + 4 * 1024, c.H() + (size_t)r * D, c.lane); }
    }
}
__device__ __forceinline__ void ph_combine_norm1_w(Ctx& c) {
    const float* g = c.p.in[6] + D; constexpr int RB = 1;
    for (int r0 = (blockIdx.x * 4 + c.wid) * RB; r0 < T0; r0 += gridDim.x * 4 * RB) {
        Row16 x[RB];
#pragma unroll
        for (int i = 0; i < RB; ++i) row_load(x[i], xrow_ptr(c, r0 + i), c.lane);
#pragma unroll
        for (int i = 0; i < RB; ++i) row_combine(x[i], c.Y(), r0 + i, c.mod() + (size_t)mod_row(r0 + i) * 6144 + 5 * 1024, c.lane);
#pragma unroll
        for (int i = 0; i < RB; ++i) { const int r = r0 + i; row_store(x[i], xrow_ptr(c, r), c.lane);
            const float* m = c.mod() + ((size_t)5 + mod_row(r)) * 6144;
            row_normmod_store(x[i], row_rinv(x[i]), g, m, m + 1024, c.H() + (size_t)r * D, c.lane); }
    }
}
__device__ __forceinline__ void ph_final_w(Ctx& c) {
    const float* g = c.p.in[28]; constexpr int RB = 1;
    for (int r0 = (blockIdx.x * 4 + c.wid) * RB; r0 < TL; r0 += gridDim.x * 4 * RB) {
        Row16 x[RB];
#pragma unroll
        for (int i = 0; i < RB; ++i) row_load(x[i], c.p.out + (size_t)(r0 + i) * D, c.lane);
#pragma unroll
        for (int i = 0; i < RB; ++i) row_combine(x[i], c.Y(), r0 + i, c.mod() + ((size_t)5 + mod_row(r0 + i)) * 6144 + 5 * 1024, c.lane);
#pragma unroll
        for (int i = 0; i < RB; ++i) {
            const float rinv = row_rinv(x[i]);
#pragma unroll
            for (int j = 0; j < 2; ++j) { const int k = j * 512 + c.lane * 8; const f32x4 ga = *(const f32x4*)(g + k), gb = *(const f32x4*)(g + k + 4);
#pragma unroll
                for (int e = 0; e < 4; ++e) { x[i].v[j][e] = x[i].v[j][e] * rinv * ga[e]; x[i].v[j][4 + e] = x[i].v[j][4 + e] * rinv * gb[e]; } }
            row_store(x[i], c.p.out + (size_t)(r0 + i) * D, c.lane);
        }
    }
}
struct MEpiRouter { ldsp_t lg;
    __device__ __forceinline__ void operator()(f32x4 (&acc)[4][8], ldsp_t wl, int rbase, int cbase, int lane) const {
        const int fr = lane & 15, fq = lane >> 4;
        if ((cbase & 255) == 0) {
            const int rl = (rbase & 127);
#pragma unroll
            for (int m = 0; m < 4; ++m)
#pragma unroll
                for (int n = 0; n < 4; ++n)
#pragma unroll
                    for (int j = 0; j < 4; ++j) *(LAS float*)(lg + ((rl + m * 16 + fr) * 65 + n * 16 + fq * 4 + j) * 4) = acc[m][n][j];
        }
        __syncthreads();
    }
};
__device__ __forceinline__ void ph_route_m(Ctx& c, int layer) {
    const int T = layer == 0 ? T0 : TL;
    const RowPlain rp{c.H(), D};
    const MEpiRouter ep{c.smem};
    LAS float* bias = (LAS float*)(c.smem + 128 * 65 * 4);
    for (int mt = vblock(); mt < T / 128; mt += gridDim.x) {
        mfma_tile(c.smem, rp, c.WROUTER() + (size_t)layer * 128 * D, D, ep, mt * 128, 0);
        if (c.tid < NE) bias[c.tid] = c.p.in[21][layer * NE + c.tid];
        __syncthreads();
        if (c.tid < 128) {
            LAS float* sc = (LAS float*)c.smem + c.tid * 65;
            for (int e = 0; e < NE; ++e) sc[e] = fast_sigmoid(sc[e]);
            unsigned gmask = 0; float gs[8];
#pragma unroll
            for (int g = 0; g < 8; ++g) {
                float m1 = -INFINITY, m2 = -INFINITY;
#pragma unroll
                for (int i = 0; i < 8; ++i) { const float v = sc[g * 8 + i] + bias[g * 8 + i]; if (v > m1) { m2 = m1; m1 = v; } else if (v > m2) m2 = v; }
                gs[g] = m1 + m2;
            }
#pragma unroll
            for (int it = 0; it < 4; ++it) {
                float best = -INFINITY; int bi = 0;
#pragma unroll
                for (int g = 0; g < 8; ++g) { const bool used = (gmask >> g) & 1u; if (!used && gs[g] > best) { best = gs[g]; bi = g; } }
                gmask |= 1u << bi;
            }
            unsigned long long used = 0ull; float wsum = 0.f; int se[TOPK]; float ss[TOPK];
#pragma unroll
            for (int it = 0; it < TOPK; ++it) {
                float best = -INFINITY; int bi = -1;
#pragma unroll 1
                for (int e = 0; e < NE; ++e) {
                    if (!((gmask >> (e >> 3)) & 1u)) continue;
                    if ((used >> e) & 1ull) continue;
                    const float v = sc[e] + bias[e];
                    if (bi < 0 || v > best) { best = v; bi = e; }
                }
                used |= 1ull << bi; se[it] = bi; ss[it] = sc[bi]; wsum += ss[it];
            }
            const float norm = 2.5f / wsum; const int t = mt * 128 + c.tid;
#pragma unroll
            for (int k = 0; k < TOPK; ++k) {
                const int e = se[k]; const int pos = (int)atomicAdd(&c.cnt()[layer * 64 + e], 1u); const int a = t * 8 + k;
                c.AE()[a] = e; c.APOS()[a] = pos; c.AW()[a] = ss[k] * norm; c.LIST()[(size_t)e * T0 + pos] = a;
            }
        }
    }
}

__global__ void __launch_bounds__(NTHREADS, 2) mega(const Params p) {
    __shared__ __attribute__((aligned(16))) unsigned char smem[LDS_LRU_END + 16 + 1024];
    float* lds = (float*)smem;
    Ctx c(p, lds, (ldsp_t)smem);
    volatile unsigned* st = (volatile unsigned*)(smem + LDS_LRU_END);
    if (c.tid < 4) st[c.tid] = 0u;
    __syncthreads();
    const XcdBarrier bar = xcd_barrier_post((unsigned*)(p.ws + CTL_BAR), st);
#define GB() xcd_barrier(bar)
#define REPEAT(n, stmt) do { for (int rep_ = 0; rep_ < (n); ++rep_) { stmt; if (rep_ + 1 < (n)) GB(); } } while (0)
    REPEAT(REP_PREP, (ph_prep(c), ph_convert_small(c), ph_convert_gates(c), ph_convert_moe(c, 0))); GB();
    {
        if (c.tid == 0) {
            unsigned* ctl = (unsigned*)(p.ws + CTL_BAR);
            const unsigned tk = xb_add((unsigned*)(p.ws + CTL_TICKET) + 64 * bar.x, 1u);
            unsigned base = 0u;
            for (unsigned j = 0; j < 16; ++j) { const unsigned n = xb_ld(&ctl[XB_XCNT(j)]); base += (j < bar.x) ? n : 0u; }
            st[2] = base + tk;
        }
        __syncthreads();
        c.vb = __builtin_amdgcn_readfirstlane((int)st[2]);
    }
    ph_norm1_l0_w(c); GB();
    REPEAT(REP_QKV, ph_qkv_m(c)); GB();
    REPEAT(REP_ATTN, ph_attn_m(c)); GB();
    ph_oproj_m(c); GB();
    REPEAT(REP_NORM2, ph_norm2_w(c, 0)); GB();
    ph_route_m(c, 0); GB();
    REPEAT(REP_GATEUP, ph_moe_gateup_m(c, 0, T0)); GB();
    ph_moe_down_m(c, 0, T0); GB();
    ph_combine_norm1_w(c); ph_convert_moe(c, 1); GB();
    REPEAT(REP_INPROJ, ph_inproj_m(c)); GB();
    REPEAT(REP_LRU1, ph_lru_pass<1>(c)); GB();
    ph_lru_carry(c); GB();
    ph_lru_pass<2>(c); GB();
    ph_outproj_m(c); GB();
    ph_norm2_w(c, 1); GB();
    ph_route_m(c, 1); GB();
    ph_moe_gateup_m(c, 1, TL); GB();
    ph_moe_down_m(c, 1, TL); GB();
    ph_final_w(c);
#undef GB
}
}

extern "C" void kernel_launch(void* const* d_in, const int* in_sizes, int n_in, void* d_out, int out_size, void* d_ws, size_t ws_size, hipStream_t stream) {
    if (n_in != 29 || ws_size < WS_END) { fprintf(stderr, "kernel_launch: unexpected n_in %d or ws_size %zu (< %zu)\n", n_in, ws_size, (size_t)WS_END); return; }
    static int grid = 0;
    if (grid == 0) {
        int dev = 0, cus = 0, per_cu = 0;
        hipGetDevice(&dev);
        hipDeviceGetAttribute(&cus, hipDeviceAttributeMultiprocessorCount, dev);
        hipOccupancyMaxActiveBlocksPerMultiprocessor(&per_cu, (const void*)mega, NTHREADS, 0);
        if (per_cu > 2) per_cu = 2;
        if (per_cu < 1) per_cu = 1;
        grid = cus * per_cu;
    }
    hipMemsetAsync((char*)d_ws + WS_CTL, 0, CTL_BYTES, stream);
    Params p{};
    for (int i = 0; i < 29; ++i) p.in[i] = (const float*)d_in[i];
    p.out = (float*)d_out; p.ws = (unsigned char*)d_ws;
    p.ph_lo = 0; p.ph_hi = 20;
    void* args[] = {&p};
    hipError_t e = hipLaunchCooperativeKernel((const void*)mega, dim3(grid), dim3(NTHREADS), args, 0, stream);
    if (e != hipSuccess) fprintf(stderr, "cooperative launch failed: %s (grid %d)\n", hipGetErrorString(e), grid);
}
```

```cpp
#include <hip/hip_runtime.h>
#include <stdint.h>
#include <cstdio>

namespace {
typedef unsigned short bf16_t;
constexpr int D = 1024, NB = 4, S = 4096, C = 256, TL = NB * S, TC = NB * C, T0 = TL + TC;
constexpr int NH = 16, NKV = 4, HD = 64, KD = 256, QKVN = 1536;
constexpr int DR = 1280, NBLK = 16, BW = 80;
constexpr int NE = 64, TOPK = 8, DE = 256;
constexpr float RMS_EPS = 1e-6f;
constexpr float LOG2E = 1.4426950408889634f;
constexpr float QSCALE = 0.125f * LOG2E;
constexpr int NTHREADS = 256;
constexpr int REP_PREP = 1, REP_QKV = 1, REP_ATTN = 1, REP_GATEUP = 1, REP_INPROJ = 1, REP_LRU1 = 1, REP_NORM2 = 1;
constexpr int LDS_U = 0, LDS_A = 13312, LDS_B0 = LDS_A + 20480, LDS_B1 = LDS_B0 + 20480, LDS_LRU_END = LDS_B1 + 20480;

constexpr size_t MiB = 1u << 20;
constexpr size_t WS_CTL = 0, CTL_BYTES = 1 * MiB;
constexpr size_t CTL_BAR = 0;
constexpr size_t CTL_TICKET = 16384;
constexpr size_t CTL_CNT = 32768;
constexpr size_t CTL_MOD = 65536;
constexpr size_t WS_ROPE = 1 * MiB + 512 * 1024;
constexpr size_t WS_SUM = 2 * MiB;
constexpr size_t WS_AE = 8 * MiB;
constexpr size_t WS_AW = WS_AE + 640 * 1024;
constexpr size_t WS_APOS = WS_AW + 640 * 1024;
constexpr size_t WS_LIST = 10 * MiB;
constexpr size_t WS_XC = 15 * MiB;
constexpr size_t WS_WQKV = 19 * MiB, WS_WO = 22 * MiB, WS_WIN = 24 * MiB, WS_WOUT = 29 * MiB, WS_WGATES = 32 * MiB, WS_WROUTER = 33 * MiB, WS_WSH = 34 * MiB;
constexpr size_t WSH_LAYER = 1536 * 1024, WSH_D = 1024 * 1024;
constexpr size_t WMOE_D = 64 * MiB;
constexpr size_t WS_WMOE = 37 * MiB;
constexpr size_t WS_H = 138 * MiB;
constexpr size_t WS_ACT = 172 * MiB;
constexpr size_t WS_ACTS = 240 * MiB;
constexpr size_t WS_BIG = 249 * MiB;
constexpr size_t WS_Q = WS_BIG, WS_K = WS_BIG + 34 * MiB, WS_V = WS_K + 9 * MiB, WS_O = WS_V + 9 * MiB;
constexpr size_t WS_G = WS_BIG, WS_PU = WS_BIG + 40 * MiB, WS_AB = WS_BIG + 83 * MiB;
constexpr size_t WS_CARRY = WS_BIG + 84 * MiB;
constexpr size_t WS_LC8 = 1 * MiB + 640 * 1024;
constexpr size_t WS_END = 521 * MiB;

struct Params {
    const float* in[29];
    float* out;
    unsigned char* ws;
    int ph_lo, ph_hi;
};

__device__ __forceinline__ float bf2f(bf16_t h) { return __uint_as_float(((unsigned)h) << 16); }
__device__ __forceinline__ bf16_t f2bf(float f) { unsigned u = __float_as_uint(f); return (bf16_t)((u + 0x7fffu + ((u >> 16) & 1u)) >> 16); }
__device__ __forceinline__ float silu_f(float v) { return v * __builtin_amdgcn_rcpf(1.f + __builtin_amdgcn_exp2f(-LOG2E * v)); }
__device__ __forceinline__ float gelu_tanh(float v) { const float u = 0.7978845608028654f * (v + 0.044715f * v * v * v); return v * __builtin_amdgcn_rcpf(1.f + __builtin_amdgcn_exp2f(-2.f * LOG2E * u)); }
__device__ __forceinline__ float wave_sum(float v) {
#pragma unroll
    for (int o = 32; o > 0; o >>= 1) v += __shfl_xor(v, o);
    return v;
}
__device__ __forceinline__ int mod_row(int r) { return r < TL ? (r >> 12) : 4; }

#define XB_TMO      128
#define XB_XCNT(j)  (256  + 64 * (j))
#define XB_XSUB(j)  (1280 + 64 * (j))
#define XB_XGEN(j)  (2304 + 64 * (j))
#define XB_TOP      3328
#define XB_TOPGEN   3392
#define XCD_BAR_WORDS 3456
#define XB_SPIN_CAP (1u << 22)
#define LAS __attribute__((address_space(3)))
__device__ __forceinline__ unsigned xb_ld(unsigned* p)              { return __hip_atomic_load(p, __ATOMIC_RELAXED, __HIP_MEMORY_SCOPE_AGENT); }
__device__ __forceinline__ unsigned xb_add(unsigned* p, unsigned v) { return __hip_atomic_fetch_add(p, v, __ATOMIC_RELAXED, __HIP_MEMORY_SCOPE_AGENT); }
__device__ __forceinline__ unsigned xb_xcc_id() { return (unsigned)__builtin_amdgcn_s_getreg((3 << 11) | 20) & 0xFu; }
#define XB_SPIN(cond, bar) do { unsigned _sp = 0; while (cond) { __builtin_amdgcn_s_sleep(1); \
    if ((++_sp & 255u) == 0u) { if (xb_ld(&(bar)[XB_TMO])) break; if (_sp > XB_SPIN_CAP) { atomicAdd(&(bar)[XB_TMO], 1u); break; } } } } while (0)
struct XcdBarrier { unsigned* bar; unsigned x; volatile unsigned* st; };
__device__ __forceinline__ XcdBarrier xcd_barrier_post(unsigned* bar, volatile unsigned* st) {
    XcdBarrier b; b.bar = bar; b.x = xb_xcc_id(); b.st = st;
    if (threadIdx.x == 0) (void)xb_add(&bar[XB_XCNT(b.x)], 1u);
    return b;
}
__device__ __forceinline__ void xcd_barrier_complete(unsigned* bar, unsigned x, unsigned& nloc, unsigned& nx) {
    const unsigned G = gridDim.x * gridDim.y * gridDim.z;
    unsigned sum, cnt, mine, sp = 0u;
    for (;;) {
        sum = 0u; cnt = 0u; mine = 0u;
#pragma unroll
        for (unsigned j = 0; j < 16; ++j) { const unsigned c = xb_ld(&bar[XB_XCNT(j)]); sum += c; cnt += (c > 0u) ? 1u : 0u; mine = (j == x) ? c : mine; }
        if (sum == G) break;
        __builtin_amdgcn_s_sleep(1);
        if ((++sp & 255u) == 0u) { if (xb_ld(&bar[XB_TMO])) break; if (sp > XB_SPIN_CAP) { atomicAdd(&bar[XB_TMO], 1u); break; } }
    }
    nloc = mine > 0u ? mine : 1u; nx = cnt > 0u ? cnt : 1u;
}
__device__ __forceinline__ void xcd_barrier(const XcdBarrier& b) {
    asm volatile("s_waitcnt vmcnt(0)" ::: "memory");
    __syncthreads();
    if (threadIdx.x == 0) {
        unsigned* bar = b.bar;
        __builtin_amdgcn_s_waitcnt(0);
        unsigned nloc = b.st[0], nx = b.st[1];
        if (nloc == 0u) { xcd_barrier_complete(bar, b.x, nloc, nx); b.st[0] = nloc; b.st[1] = nx; }
        const unsigned old = xb_add(&bar[XB_XSUB(b.x)], 1u);
        const unsigned gen = old / nloc;
        if (old + 1u == (gen + 1u) * nloc) {
            __builtin_amdgcn_fence(__ATOMIC_RELEASE, "agent");
            asm volatile("s_waitcnt vmcnt(0)" ::: "memory");
            const unsigned og = xb_add(&bar[XB_TOP], 1u);
            const unsigned tg = og / nx;
            if (og + 1u == (tg + 1u) * nx) xb_add(&bar[XB_TOPGEN], 1u);
            else XB_SPIN(xb_ld(&bar[XB_TOPGEN]) == tg, bar);
            __builtin_amdgcn_fence(__ATOMIC_ACQUIRE, "agent");
            xb_add(&bar[XB_XGEN(b.x)], 1u);
            asm volatile("s_waitcnt vmcnt(0)" ::: "memory");
        } else {
            XB_SPIN(xb_ld(&bar[XB_XGEN(b.x)]) == gen, bar);
            __builtin_amdgcn_fence(__ATOMIC_ACQUIRE, "agent");
            asm volatile("s_waitcnt vmcnt(0)" ::: "memory");
        }
    }
    __syncthreads();
}


typedef short bf16x8 __attribute__((ext_vector_type(8)));
typedef float f32x4 __attribute__((ext_vector_type(4)));
typedef unsigned u32x4 __attribute__((ext_vector_type(4)));
typedef unsigned u32x2 __attribute__((ext_vector_type(2)));
typedef LAS unsigned char* ldsp_t;
constexpr int EP_WAVE = 17408;
constexpr int GT_STG = 24576;
template <class RowPtr, class Epi>
__device__ __forceinline__ void mfma_tile(ldsp_t lds, const RowPtr& rp, const bf16_t* Bt, int K, const Epi& ep, int row0, int col0) {
    const int tid = threadIdx.x, lane = tid & 63, wid = __builtin_amdgcn_readfirstlane(tid >> 6), wr = wid >> 1, wc = wid & 1, fr = lane & 15, fq = lane >> 4;
    const int sch = ((tid & 3) ^ ((-(tid >> 4)) & 3)) * 8;
    const bf16_t* ap0 = rp(row0 + (tid >> 2)) + sch;
    const bf16_t* ap1 = rp(row0 + 64 + (tid >> 2)) + sch;
    const bf16_t* bp = Bt + (size_t)(tid >> 2) * K + sch;
    const size_t bstep = (size_t)64 * K;
    const int cterm = ((fq ^ ((-(fr >> 2)) & 3)) << 4);
    const int aoff = (wr * 64 + fr) * 64 + cterm, boff = 8192 + (wc * 128 + fr) * 64 + cterm;
    f32x4 acc[4][8];
#pragma unroll
    for (int m = 0; m < 4; ++m)
#pragma unroll
        for (int n = 0; n < 8; ++n) acc[m][n] = (f32x4){0.f, 0.f, 0.f, 0.f};
#define GT_STAGE(sb, k0) do { const ldsp_t d_ = lds + (sb) + wid * 1024; \
        __builtin_amdgcn_global_load_lds((const unsigned*)(ap0 + (k0)), (LAS unsigned*)(d_), 16, 0, 0); \
        __builtin_amdgcn_global_load_lds((const unsigned*)(ap1 + (k0)), (LAS unsigned*)(d_ + 4096), 16, 0, 0); \
        _Pragma("unroll") for (int i_ = 0; i_ < 4; ++i_) \
            __builtin_amdgcn_global_load_lds((const unsigned*)(bp + i_ * bstep + (k0)), (LAS unsigned*)(d_ + 8192 + i_ * 4096), 16, 0, 0); } while (0)
    const int nt = K >> 5;
    asm volatile("s_waitcnt lgkmcnt(0)" ::: "memory");
    __builtin_amdgcn_s_barrier();
    asm volatile("" ::: "memory");
    GT_STAGE(0, 0);
    GT_STAGE(GT_STG, 32);
    int scur = 0, snx = 2 * GT_STG;
#pragma unroll 1
    for (int t = 0; t < nt; ++t) {
        if (t + 1 < nt) asm volatile("s_waitcnt vmcnt(6)" ::: "memory"); else asm volatile("s_waitcnt vmcnt(0)" ::: "memory");
        __builtin_amdgcn_s_barrier();
        asm volatile("" ::: "memory");
        if (t + 2 < nt) GT_STAGE(snx, (t + 2) * 32);
        const ldsp_t base = lds + scur;
        bf16x8 af[4], bfr[8];
#pragma unroll
        for (int m = 0; m < 4; ++m) af[m] = *(const LAS bf16x8*)(base + aoff + m * 1024);
#pragma unroll
        for (int n = 0; n < 8; ++n) bfr[n] = *(const LAS bf16x8*)(base + boff + n * 1024);
#pragma unroll
        for (int m = 0; m < 4; ++m)
#pragma unroll
            for (int n = 0; n < 8; ++n) acc[m][n] = __builtin_amdgcn_mfma_f32_16x16x32_bf16(bfr[n], af[m], acc[m][n], 0, 0, 0);
        scur = (scur == 2 * GT_STG) ? 0 : scur + GT_STG;
        snx = (snx == 2 * GT_STG) ? 0 : snx + GT_STG;
    }
#undef GT_STAGE
    __syncthreads();
    ep(acc, lds + wid * EP_WAVE, row0 + wr * 64, col0 + wc * 128, lane);
}
constexpr int RT_STG = 12288, RT_NS = 6;
template <class Epi>
__device__ __forceinline__ void router_tile(ldsp_t lds, const bf16_t* A, const bf16_t* Bt, int K, const Epi& ep, int row0) {
    const int tid = threadIdx.x, lane = tid & 63, wid = __builtin_amdgcn_readfirstlane(tid >> 6), wr = wid >> 1, wc = wid & 1, fr = lane & 15, fq = lane >> 4;
    const int sch = ((tid & 3) ^ ((-(tid >> 4)) & 3)) * 8;
    const bf16_t* ap0 = A + (size_t)(row0 + (tid >> 2)) * K + sch;
    const bf16_t* ap1 = ap0 + (size_t)64 * K;
    const bf16_t* bp = Bt + (size_t)(tid >> 2) * K + sch;
    const int cterm = ((fq ^ ((-(fr >> 2)) & 3)) << 4);
    const int aoff = (wr * 64 + fr) * 64 + cterm, boff = 8192 + (wc * 32 + fr) * 64 + cterm;
    f32x4 acc[4][8];
#pragma unroll
    for (int m = 0; m < 4; ++m)
#pragma unroll
        for (int n = 0; n < 8; ++n) acc[m][n] = (f32x4){0.f, 0.f, 0.f, 0.f};
#define RT_STAGE(sb, k0) do { const ldsp_t d_ = lds + (sb) + wid * 1024; \
        __builtin_amdgcn_global_load_lds((const unsigned*)(ap0 + (k0)), (LAS unsigned*)(d_), 16, 0, 0); \
        __builtin_amdgcn_global_load_lds((const unsigned*)(ap1 + (k0)), (LAS unsigned*)(d_ + 4096), 16, 0, 0); \
        __builtin_amdgcn_global_load_lds((const unsigned*)(bp + (k0)), (LAS unsigned*)(d_ + 8192), 16, 0, 0); } while (0)
    const int nt = K >> 5;
    asm volatile("s_waitcnt lgkmcnt(0)" ::: "memory");
    __builtin_amdgcn_s_barrier();
    asm volatile("" ::: "memory");
#pragma unroll
    for (int q = 0; q < RT_NS - 1; ++q) RT_STAGE(q * RT_STG, q * 32);
    int scur = 0, snx = (RT_NS - 1) * RT_STG;
#pragma unroll 1
    for (int t = 0; t < nt; ++t) {
        if (t + RT_NS - 1 <= nt) asm volatile("s_waitcnt vmcnt(12)" ::: "memory");
        else asm volatile("s_waitcnt vmcnt(0)" ::: "memory");
        __builtin_amdgcn_s_barrier();
        asm volatile("" ::: "memory");
        if (t + RT_NS - 1 < nt) RT_STAGE(snx, (t + RT_NS - 1) * 32);
        const ldsp_t base = lds + scur;
        bf16x8 af[4], bfr[2];
#pragma unroll
        for (int m = 0; m < 4; ++m) af[m] = *(const LAS bf16x8*)(base + aoff + m * 1024);
#pragma unroll
        for (int n = 0; n < 2; ++n) bfr[n] = *(const LAS bf16x8*)(base + boff + n * 1024);
#pragma unroll
        for (int m = 0; m < 4; ++m)
#pragma unroll
            for (int n = 0; n < 2; ++n) acc[m][n] = __builtin_amdgcn_mfma_f32_16x16x32_bf16(bfr[n], af[m], acc[m][n], 0, 0, 0);
        scur = (scur == (RT_NS - 1) * RT_STG) ? 0 : scur + RT_STG;
        snx = (snx == (RT_NS - 1) * RT_STG) ? 0 : snx + RT_STG;
    }
#undef RT_STAGE
    __syncthreads();
    ep(acc, lds, row0 + wr * 64, wc * 32, lane);
}
typedef float f32x2_t __attribute__((ext_vector_type(2))); typedef __bf16 bf16x2_t __attribute__((ext_vector_type(2)));
__device__ __forceinline__ unsigned pk2(float lo, float hi) { f32x2_t v = {lo, hi}; bf16x2_t b = __builtin_convertvector(v, bf16x2_t); return __builtin_bit_cast(unsigned, b); }
__device__ __forceinline__ void st_bf16x4(bf16_t* p, float a, float b, float c, float d) { uint2 o; o.x = pk2(a, b); o.y = pk2(c, d); *(uint2*)p = o; }

struct RowPlain { const bf16_t* A; int lda; __device__ __forceinline__ const bf16_t* operator()(int r) const { return A + (size_t)r * lda; } };

constexpr int EPB = 272;
constexpr int EPF = 528;
__device__ __forceinline__ void ep_put4(ldsp_t wl, int row, int col, float a, float b, float c, float d) { u32x2 o; o.x = pk2(a, b); o.y = pk2(c, d); *(LAS u32x2*)(wl + row * EPB + col * 2) = o; }
struct MEpiQKV {
    bf16_t *Q, *K, *V; const float* rope;
    __device__ __forceinline__ void operator()(f32x4 (&acc)[4][8], ldsp_t wl, int rbase, int cbase0, int lane) const {
        const int fr = lane & 15, fq = lane >> 4;
#pragma unroll
        for (int hh = 0; hh < 2; ++hh) {
            const int cbase = cbase0 + hh * 64;
            const bool isq = cbase < 1024, isk = (cbase >= 1024 && cbase < 1280);
#pragma unroll
            for (int m = 0; m < 4; ++m) {
                const int r = rbase + m * 16 + fr;
                f32x4 v0 = acc[m][hh * 4 + 0], v1 = acc[m][hh * 4 + 1], v2 = acc[m][hh * 4 + 2], v3 = acc[m][hh * 4 + 3];
                if ((isq || isk) && r < TL) {
                    const int s = r & (S - 1), prow = s >> 6, pcol = s & 63;
                    const f32x4 cr = *(const f32x4*)(rope + prow * 16 + fq * 4), sr = *(const f32x4*)(rope + 1024 + prow * 16 + fq * 4);
                    const f32x4 cc = *(const f32x4*)(rope + pcol * 16 + fq * 4), sc = *(const f32x4*)(rope + 1024 + pcol * 16 + fq * 4);
                    const f32x4 o0 = v0 * cr - v1 * sr, o1 = v1 * cr + v0 * sr, o2 = v2 * cc - v3 * sc, o3 = v3 * cc + v2 * sc;
                    v0 = o0; v1 = o1; v2 = o2; v3 = o3;
                }
                if (isq) { v0 *= QSCALE; v1 *= QSCALE; v2 *= QSCALE; v3 *= QSCALE; }
                const int rl = m * 16 + fr, cl = hh * 64 + fq * 4;
                ep_put4(wl, rl, cl, v0[0], v0[1], v0[2], v0[3]); ep_put4(wl, rl, cl + 16, v1[0], v1[1], v1[2], v1[3]);
                ep_put4(wl, rl, cl + 32, v2[0], v2[1], v2[2], v2[3]); ep_put4(wl, rl, cl + 48, v3[0], v3[1], v3[2], v3[3]);
            }
        }
        const bool isq = cbase0 < 1024, isk = (cbase0 >= 1024 && cbase0 < 1280);
        bf16_t* base = isq ? (Q + cbase0) : isk ? (K + (cbase0 - 1024)) : (V + (cbase0 - 1280));
        const size_t pitch = isq ? 1024 : 256;
#pragma unroll 2
        for (int i = 0; i < 16; ++i) {
            const int rl = 4 * i + (lane >> 4), ch = lane & 15;
            const u32x4 v = *(const LAS u32x4*)(wl + rl * EPB + ch * 16);
            *(u32x4*)(base + (size_t)(rbase + rl) * pitch + ch * 8) = v;
        }
    }
};
struct MEpiResid {
    const float* srcL; const float* srcC; float* dstL; float* dstC; const float* mod; int gchunk;
    __device__ __forceinline__ void operator()(f32x4 (&acc)[4][8], ldsp_t wl, int rbase, int cbase, int lane) const {
        const int fr = lane & 15, fq = lane >> 4, c4 = (lane & 31) * 4;
        const f32x4 gv = *(const f32x4*)(mod + mod_row(rbase) * 6144 + gchunk * 1024 + cbase + c4);
        const bool latent = rbase < TL;
        const float* sbase = (latent ? srcL + (size_t)rbase * D : srcC + (size_t)(rbase - TL) * D) + cbase + c4 + (size_t)(lane >> 5) * D;
        float* dbase = (latent ? dstL + (size_t)rbase * D : dstC + (size_t)(rbase - TL) * D) + cbase + c4 + (size_t)(lane >> 5) * D;
#pragma unroll
        for (int half = 0; half < 2; ++half) {
#pragma unroll
            for (int mm = 0; mm < 2; ++mm)
#pragma unroll
                for (int n = 0; n < 8; ++n) *(LAS f32x4*)(wl + (mm * 16 + fr) * EPF + (n * 16 + fq * 4) * 4) = acc[half * 2 + mm][n];
#pragma unroll
            for (int q = 0; q < 2; ++q) {
                f32x4 sv[8];
#pragma unroll
                for (int i = 0; i < 8; ++i) sv[i] = *(const f32x4*)(sbase + (size_t)(half * 32 + 16 * q + 2 * i) * D);
#pragma unroll
                for (int i = 0; i < 8; ++i) {
                    const int rl = 16 * q + 2 * i + (lane >> 5);
                    const f32x4 v = *(const LAS f32x4*)(wl + rl * EPF + c4 * 4);
                    *(f32x4*)(dbase + (size_t)(half * 32 + 16 * q + 2 * i) * D) = sv[i] + gv * v;
                }
            }
        }
    }
};
struct MEpiInProj {
    bf16_t* G; bf16_t* PU;
    __device__ __forceinline__ void operator()(f32x4 (&acc)[4][8], ldsp_t wl, int rbase, int cbase, int lane) const {
        const int fr = lane & 15, fq = lane >> 4;
        const bool isg = cbase < DR;
#pragma unroll
        for (int m = 0; m < 4; ++m)
#pragma unroll
            for (int n = 0; n < 8; ++n) {
                const f32x4 v = acc[m][n];
                if (isg) ep_put4(wl, m * 16 + fr, n * 16 + fq * 4, gelu_tanh(v[0]), gelu_tanh(v[1]), gelu_tanh(v[2]), gelu_tanh(v[3]));
                else ep_put4(wl, m * 16 + fr, n * 16 + fq * 4, v[0], v[1], v[2], v[3]);
            }
        bf16_t* base = isg ? (G + cbase) : (PU + (cbase - DR));
#pragma unroll 2
        for (int i = 0; i < 16; ++i) {
            const int rl = 4 * i + (lane >> 4), ch = lane & 15, r = rbase + rl;
            const u32x4 v = *(const LAS u32x4*)(wl + rl * EPB + ch * 16);
            if (!isg || r < TL) *(u32x4*)(base + (size_t)r * DR + ch * 8) = v;
        }
    }
};
#define vblock() (c.vb)

template <class RowMap>
__device__ __forceinline__ void tr_item64(const float* W, int ldw, int k0, int n0, bf16_t* dst, int ldd, const RowMap& rm, int lane) {
    const int nq = lane >> 2, kg = lane & 3;
    f32x4 v[16];
    const float* src = W + (size_t)(k0 + kg * 8) * ldw + n0 + 4 * nq;
#pragma unroll
    for (int h = 0; h < 2; ++h)
#pragma unroll
        for (int i = 0; i < 8; ++i) v[h * 8 + i] = *(const f32x4*)(src + (size_t)(h * 32 + i) * ldw);
#pragma unroll
    for (int cc = 0; cc < 4; ++cc) {
        bf16_t* drow = dst + (size_t)rm(n0 + 4 * nq + cc) * ldd + k0 + kg * 8;
#pragma unroll
        for (int h = 0; h < 2; ++h) {
            u32x4 o; o.x = pk2(v[h * 8 + 0][cc], v[h * 8 + 1][cc]); o.y = pk2(v[h * 8 + 2][cc], v[h * 8 + 3][cc]); o.z = pk2(v[h * 8 + 4][cc], v[h * 8 + 5][cc]); o.w = pk2(v[h * 8 + 6][cc], v[h * 8 + 7][cc]);
            *(u32x4*)(drow + h * 32) = o;
        }
    }
}
struct RMPlain { __device__ __forceinline__ int operator()(int n) const { return n; } };
struct RMGateUp { int mat; __device__ __forceinline__ int operator()(int h) const { return (h >> 7) * 256 + ((h >> 6) & 1) * 128 + (((h >> 4) & 3) * 2 + mat) * 16 + (h & 15); } };
__device__ __forceinline__ void tr_plain(const float* W, int K, int N, bf16_t* dst, int item, int lane) {
    const int nb = N / 64, kb = item / nb, n0 = (item % nb) * 64;
    tr_item64(W, N, kb * 64, n0, dst, K, RMPlain{}, lane);
}
__device__ __forceinline__ void tr_expert(const float* Wg, const float* Wu, const float* Wd, bf16_t* gu, bf16_t* dn, int item, int lane) {
    if (item < 128) {
        const int mat = item >> 6, it = item & 63, kb = it >> 2, n0 = (it & 3) * 64;
        tr_item64(Wg + (size_t)mat * (Wu - Wg), DE, kb * 64, n0, gu, D, RMGateUp{mat}, lane);
    } else {
        const int it = item - 128, kb = it >> 4, n0 = (it & 15) * 64;
        tr_item64(Wd, D, kb * 64, n0, dn, DE, RMPlain{}, lane);
    }
}
struct Ctx {
    const Params& p; float* lds; ldsp_t smem;
    int tid, lane, wid, vb;
    __device__ __forceinline__ Ctx(const Params& p_, float* l, ldsp_t sm) : p(p_), lds(l), smem(sm) { tid = threadIdx.x; lane = tid & 63; wid = tid >> 6; vb = blockIdx.x; }
#define WSF(name, type, off) __device__ __forceinline__ type* name() const { return (type*)(p.ws + (off)); }
    WSF(cnt, unsigned, CTL_CNT) WSF(mod, float, CTL_MOD) WSF(rope, float, WS_ROPE) WSF(sum, float, WS_SUM)
    WSF(AE, int, WS_AE) WSF(AW, float, WS_AW) WSF(APOS, int, WS_APOS) WSF(LIST, int, WS_LIST) WSF(XC, float, WS_XC)
    WSF(H, bf16_t, WS_H) WSF(ACT, bf16_t, WS_ACT) WSF(ACTS, bf16_t, WS_ACTS) WSF(Y, bf16_t, WS_BIG)
    WSF(Qb, bf16_t, WS_Q) WSF(Kb, bf16_t, WS_K) WSF(Vb, bf16_t, WS_V) WSF(Ob, bf16_t, WS_O)
    WSF(WQKV, bf16_t, WS_WQKV) WSF(WO, bf16_t, WS_WO) WSF(WIN, bf16_t, WS_WIN) WSF(WOUT, bf16_t, WS_WOUT) WSF(WSH, bf16_t, WS_WSH) WSF(WMOE, bf16_t, WS_WMOE)
    WSF(WGATES, bf16_t, WS_WGATES) WSF(WROUTER, bf16_t, WS_WROUTER) WSF(LC8, float, WS_LC8) WSF(CARRY, float, WS_CARRY)
    WSF(G, bf16_t, WS_G) WSF(PU, bf16_t, WS_PU) WSF(HG, bf16_t, WS_G) WSF(AB, float, WS_AB) WSF(HS, float, WS_WMOE)
#undef WSF
};

__device__ __forceinline__ void ph_prep(Ctx& c) {
    const float* cv = c.p.in[1]; const float* cctx = c.p.in[3]; const float* aw = c.p.in[4]; const float* ab = c.p.in[5];
    float* sil = c.lds;
    float* red = c.lds + 5120;
    __syncthreads();
    for (int i = c.tid; i < 5 * 1024; i += NTHREADS) { const int r = i >> 10, k = i & 1023; const float v = r < 4 ? cv[r * 1024 + k] : cctx[k]; sil[i] = silu_f(v); }
    __syncthreads();
    for (int item = blockIdx.x; item < 2 * 96; item += gridDim.x) {
        const int l = item / 96, jb = item % 96, kq = c.tid >> 4, cq = c.tid & 15;
        f32x4 a0 = {0, 0, 0, 0}, a1 = a0, a2 = a0, a3 = a0, a4 = a0;
        const float* w = aw + ((size_t)l * 1024 + kq * 64) * 6144 + jb * 64 + cq * 4;
        const float* sl = sil + kq * 64;
#pragma unroll 8
        for (int k = 0; k < 64; ++k) { const f32x4 wv = *(const f32x4*)(w + (size_t)k * 6144); a0 += sl[k] * wv; a1 += sl[1024 + k] * wv; a2 += sl[2048 + k] * wv; a3 += sl[3072 + k] * wv; a4 += sl[4096 + k] * wv; }
        float* rr = red + kq * 320 + cq * 4;
        *(f32x4*)(rr) = a0; *(f32x4*)(rr + 64) = a1; *(f32x4*)(rr + 128) = a2; *(f32x4*)(rr + 192) = a3; *(f32x4*)(rr + 256) = a4;
        __syncthreads();
        for (int i = c.tid; i < 320; i += NTHREADS) {
            const int r = i >> 6, jj = i & 63;
            float v = 0.f;
#pragma unroll
            for (int q = 0; q < 16; ++q) v += red[q * 320 + i];
            c.mod()[((size_t)l * 5 + r) * 6144 + jb * 64 + jj] = v + ab[l * 6144 + jb * 64 + jj];
        }
        __syncthreads();
    }
    if (blockIdx.x == gridDim.x - 1) {
        for (int i = c.tid; i < 1024; i += NTHREADS) {
            const int pos = i >> 4, f = i & 15;
            const float inv = expf(-logf(10000.0f) * (float)f / 16.0f);
            const float ang = (float)pos * inv;
            c.rope()[i] = cosf(ang); c.rope()[1024 + i] = sinf(ang);
        }
    }
}


__device__ __forceinline__ int find_expert(const int* tp, int rt) {
    int e = 0;
#pragma unroll 1
    for (int i = 1; i <= 64; ++i) if (tp[i] <= rt) e = i;
    return e;
}


__device__ __forceinline__ void ph_convert_small(Ctx& c) {
    const int wu = __builtin_amdgcn_readfirstlane(c.wid);
    const int gw = blockIdx.x * 4 + wu, NGW = gridDim.x * 4;
    constexpr int I_QKV = 16 * 24, I_O = 16 * 16, I_IN = 16 * 40, I_OUT = 20 * 16, I_SH = 192, I_R = 16;
    constexpr int NIT = I_QKV + I_O + I_IN + I_OUT + 2 * I_SH + 2 * I_R;
    for (int it = gw; it < NIT; it += NGW) {
        int r = it;
        if (r < I_QKV) { tr_plain(c.p.in[8], 1024, 1536, c.WQKV(), r, c.lane); continue; } r -= I_QKV;
        if (r < I_O) { tr_plain(c.p.in[9], 1024, 1024, c.WO(), r, c.lane); continue; } r -= I_O;
        if (r < I_IN) { tr_plain(c.p.in[11], 1024, 2560, c.WIN(), r, c.lane); continue; } r -= I_IN;
        if (r < I_OUT) { tr_plain(c.p.in[19], 1280, 1024, c.WOUT(), r, c.lane); continue; } r -= I_OUT;
        if (r < 2 * I_SH) {
            const int l = r / I_SH; r %= I_SH;
            bf16_t* base = c.WSH() + (size_t)l * (WSH_LAYER / 2);
            tr_expert(c.p.in[25] + (size_t)l * D * DE, c.p.in[26] + (size_t)l * D * DE, c.p.in[27] + (size_t)l * DE * D, base, base + WSH_D / 2, r, c.lane);
            continue;
        }
        r -= 2 * I_SH;
        { const int l = r / I_R; r %= I_R; tr_plain(c.p.in[20] + (size_t)l * D * NE, D, NE, c.WROUTER() + (size_t)l * 128 * D, r, c.lane); }
    }
    for (int i = blockIdx.x * NTHREADS + c.tid; i < 2 * 64 * D / 8; i += gridDim.x * NTHREADS) { const int l = i / (64 * D / 8), o = i % (64 * D / 8); *(u32x4*)(c.WROUTER() + (size_t)l * 128 * D + 64 * D + (size_t)o * 8) = (u32x4){0u, 0u, 0u, 0u}; }
}
__device__ __forceinline__ void ph_convert_moe(Ctx& c, int layer) {
    const int wu = __builtin_amdgcn_readfirstlane(c.wid);
    const int gw = vblock() * 4 + wu, NGW = gridDim.x * 4;
    for (int it = gw; it < NE * 192; it += NGW) {
        const int e = it / 192, r = it % 192; const size_t eo = ((size_t)layer * NE + e) * D * DE;
        tr_expert(c.p.in[22] + eo, c.p.in[23] + eo, c.p.in[24] + eo, c.WMOE() + (size_t)e * 512 * 1024, c.WMOE() + WMOE_D / 2 + (size_t)e * 1024 * 256, r, c.lane);
    }
}
template <class Epi>
__device__ __forceinline__ void dense_gemm(Ctx& c, const bf16_t* A, int lda, int mtiles, const bf16_t* Bt, int K, int ntiles, const Epi& ep) {
    const RowPlain rp{A, lda};
    const int nItems = mtiles * ntiles;
    for (int item = vblock(); item < nItems; item += gridDim.x) {
        const int mt = item / ntiles, nt = item % ntiles;
        mfma_tile(c.smem, rp, Bt + (size_t)nt * 256 * K, K, ep, mt * 128, nt * 256);
    }
}
__device__ __forceinline__ void ph_qkv_m(Ctx& c) { const MEpiQKV ep{c.Qb(), c.Kb(), c.Vb(), c.rope()}; dense_gemm(c, c.H(), D, T0 / 128, c.WQKV(), D, QKVN / 256, ep); }
__device__ __forceinline__ void ph_oproj_m(Ctx& c) { const MEpiResid ep{c.p.in[0], c.p.in[2], c.p.out, c.XC(), c.mod(), 2}; dense_gemm(c, c.Ob(), D, T0 / 128, c.WO(), D, D / 256, ep); }
__device__ __forceinline__ void ph_inproj_m(Ctx& c) { const MEpiInProj ep{c.G(), c.PU()}; dense_gemm(c, c.H(), D, T0 / 128, c.WIN(), D, 2 * DR / 256, ep); }
__device__ __forceinline__ void ph_outproj_m(Ctx& c) { const MEpiResid ep{c.p.out, c.XC(), c.p.out, c.XC(), c.mod() + 5 * 6144, 2}; dense_gemm(c, c.HG(), DR, TL / 128, c.WOUT(), DR, D / 256, ep); }


__device__ __forceinline__ void moe_tables128(Ctx& c, int layer, int T, int* tbl) {
    __syncthreads();
    if (c.tid < 64) tbl[136 + c.tid] = (int)c.cnt()[layer * 64 + c.tid];
    __syncthreads();
    if (c.tid == 0) {
        int o = 0, t = 0;
        for (int e = 0; e < NE; ++e) { const int n = tbl[136 + e]; tbl[e] = o; tbl[65 + e] = t; o += n; t += (n + 127) >> 7; }
        tbl[64] = o; tbl[65 + 64] = t; tbl[65 + 65] = t + ((T + 127) >> 7);
    }
    __syncthreads();
}
struct RowGather { const bf16_t* H; const int* list; int n; bool shared;
    __device__ __forceinline__ const bf16_t* operator()(int r) const { if (r >= n) return H; const int tok = shared ? r : (list[r] >> 3); return H + (size_t)tok * D; } };
struct MEpiAct { bf16_t* act; int n;
    __device__ __forceinline__ void operator()(f32x4 (&acc)[4][8], ldsp_t wl, int rbase, int cbase, int lane) const {
        const int fr = lane & 15, fq = lane >> 4;
#pragma unroll
        for (int m = 0; m < 4; ++m)
#pragma unroll
            for (int q = 0; q < 4; ++q) { const f32x4 g = acc[m][2 * q], u = acc[m][2 * q + 1];
                ep_put4(wl, m * 16 + fr, q * 16 + fq * 4, silu_f(g[0]) * u[0], silu_f(g[1]) * u[1], silu_f(g[2]) * u[2], silu_f(g[3]) * u[3]); }
        bf16_t* base = act + (cbase >> 1);
#pragma unroll 2
        for (int i = 0; i < 8; ++i) {
            const int rl = 8 * i + (lane >> 3), ch = lane & 7, r = rbase + rl;
            const u32x4 v = *(const LAS u32x4*)(wl + rl * EPB + ch * 16);
            if (r < n) *(u32x4*)(base + (size_t)r * DE + ch * 8) = v;
        }
    }
};
__device__ __forceinline__ void ph_moe_gateup_m(Ctx& c, int layer, int T) {
    int* tbl = (int*)(c.smem + LDS_LRU_END + 16);
    moe_tables128(c, layer, T, tbl);
    const int* tp = tbl + 65; const int ntile = tp[65];
#pragma unroll 1
    for (int item = vblock(); item < ntile * 2; item += gridDim.x) {
        const int rt = item >> 1, nt = item & 1, e = find_expert(tp, rt), mt = rt - tp[e];
        const bool sh = e >= NE;
        const int n = sh ? T : tbl[136 + e];
        const RowGather rp{c.H(), c.LIST() + (size_t)(sh ? 0 : e) * T0, n, sh};
        const bf16_t* Bt = (sh ? c.WSH() + (size_t)layer * (WSH_LAYER / 2) : c.WMOE() + (size_t)e * 512 * 1024) + (size_t)nt * 256 * D;
        const MEpiAct ep{sh ? c.ACTS() : c.ACT() + (size_t)tbl[e] * DE, n};
        mfma_tile(c.smem, rp, Bt, D, ep, mt * 128, nt * 256);
    }
}
struct MEpiDown { bf16_t* Y; const int* list; const float* aw; int n; bool shared; float* xl; float* xc; const float* mod; int a_reg; float w_reg;
    __device__ __forceinline__ void operator()(f32x4 (&acc)[4][8], ldsp_t wl, int rbase, int cbase, int lane) const {
        const int fr = lane & 15, fq = lane >> 4;
        if (!shared) {
#pragma unroll
            for (int m = 0; m < 4; ++m) {
                const float w = __shfl(w_reg, m * 16 + fr);
#pragma unroll
                for (int nn = 0; nn < 8; ++nn) ep_put4(wl, m * 16 + fr, nn * 16 + fq * 4, w * acc[m][nn][0], w * acc[m][nn][1], w * acc[m][nn][2], w * acc[m][nn][3]);
            }
#pragma unroll 2
            for (int i = 0; i < 16; ++i) {
                const int rl = 4 * i + (lane >> 4), ch = lane & 15, r = rbase + rl;
                const u32x4 v = *(const LAS u32x4*)(wl + rl * EPB + ch * 16);
                const int a = __shfl(a_reg, rl);
                if (r < n) *(u32x4*)(Y + (size_t)a * D + cbase + ch * 8) = v;
            }
        } else {
#pragma unroll
            for (int half = 0; half < 2; ++half) {
#pragma unroll
                for (int mm = 0; mm < 2; ++mm)
#pragma unroll
                    for (int nn = 0; nn < 8; ++nn) *(LAS f32x4*)(wl + (mm * 16 + fr) * EPF + (nn * 16 + fq * 4) * 4) = acc[half * 2 + mm][nn];
#pragma unroll 2
                for (int i = 0; i < 16; ++i) {
                    const int rl = 2 * i + (lane >> 5), c4 = (lane & 31) * 4, r = rbase + half * 32 + rl;
                    const f32x4 v = *(const LAS f32x4*)(wl + rl * EPF + c4 * 4);
                    if (r < n) {
                        const f32x4 gv = *(const f32x4*)(mod + mod_row(r) * 6144 + 5 * 1024 + cbase + c4);
                        float* d = (r < TL ? xl + (size_t)r * D : xc + (size_t)(r - TL) * D) + cbase + c4;
                        *(f32x4*)d += gv * v;
                    }
                }
            }
        }
    }
};
__device__ __forceinline__ void ph_moe_down_m(Ctx& c, int layer, int T) {
    int* tbl = (int*)(c.smem + LDS_LRU_END + 16);
    moe_tables128(c, layer, T, tbl);
    const int* tp = tbl + 65; const int ntile = tp[65];
    const float* modl = c.mod() + (size_t)layer * 5 * 6144;
#pragma unroll 1
    for (int item = vblock(); item < ntile * 4; item += gridDim.x) {
        const int rt = item >> 2, nt = item & 3, e = find_expert(tp, rt), mt = rt - tp[e];
        const bool sh = e >= NE;
        const int n = sh ? T : tbl[136 + e];
        const RowPlain rp{sh ? c.ACTS() : c.ACT() + (size_t)tbl[e] * DE, DE};
        const bf16_t* Bt = (sh ? c.WSH() + (size_t)layer * (WSH_LAYER / 2) + WSH_D / 2 : c.WMOE() + WMOE_D / 2 + (size_t)e * 1024 * 256) + (size_t)nt * 256 * DE;
        int a_reg = 0; float w_reg = 0.f;
        if (!sh) { const int rr = mt * 128 + (__builtin_amdgcn_readfirstlane(c.tid >> 6) >> 1) * 64 + c.lane; if (rr < n) { a_reg = c.LIST()[(size_t)e * T0 + rr]; w_reg = c.AW()[a_reg]; } }
        const MEpiDown ep{c.Y(), c.LIST() + (size_t)(sh ? 0 : e) * T0, c.AW(), n, sh, c.p.out, c.XC(), modl, a_reg, w_reg};
        mfma_tile(c.smem, rp, Bt, DE, ep, mt * 128, nt * 256);
    }
}


constexpr int NCH = 68;
constexpr int LU_PITCH = 104;
__device__ __forceinline__ float fast_sigmoid(float x) { return __builtin_amdgcn_rcpf(1.f + __builtin_amdgcn_exp2f(-LOG2E * x)); }
__device__ __forceinline__ void ph_convert_gates(Ctx& c) {
    const int NT = gridDim.x * NTHREADS, g0 = blockIdx.x * NTHREADS + c.tid;
    for (int i = g0; i < 2 * 2 * NBLK * BW * 96; i += NT) {
        const int k = i % 96, col = (i / 96) % BW, n = (i / (96 * BW)) % NBLK, mat = (i / (96 * BW * NBLK)) & 1, d = i / (96 * BW * NBLK * 2);
        const float* w = (mat ? c.p.in[16] : c.p.in[14]) + (((size_t)d * NBLK + n) * BW) * BW;
        c.WGATES()[i] = k < BW ? f2bf(w[(size_t)k * BW + col]) : (bf16_t)0;
    }
    for (int i = g0; i < 2 * DR; i += NT) c.LC8()[i] = 8.0f * LOG2E * log1pf(expf(-c.p.in[18][i]));
}
constexpr int L2_U = 0, L2_RAW = 13312, L2_OUT = L2_RAW + 10752, L2_END = L2_OUT + 2 * 64 * BW * 4;
template <bool REV, int PASS>
__device__ __forceinline__ void lru_scan16(const float (&a)[4][4], const float (&b)[4][4], float& cm, float& ptot, float (&h)[4][4], int lane, int fq) {
    const int l16 = REV ? ((lane + 16) & 63) : ((lane - 16) & 63), l32 = REV ? ((lane + 32) & 63) : ((lane - 32) & 63);
    const int ltot = (lane & 15) + (REV ? 0 : 48);
    float P[4], H[4], Pe[4], He[4], Pt[4], Ht[4];
#pragma unroll
    for (int m = 0; m < 4; ++m) {
        P[m] = 1.f; H[m] = 0.f;
#pragma unroll
        for (int jj = 0; jj < 4; ++jj) { const int j = REV ? 3 - jj : jj; H[m] = a[m][j] * H[m] + b[m][j]; P[m] *= a[m][j]; }
    }
    {   float Pp[4], Hp[4];
#pragma unroll
        for (int m = 0; m < 4; ++m) { Pp[m] = __shfl(P[m], l16); Hp[m] = __shfl(H[m], l16); }
#pragma unroll
        for (int m = 0; m < 4; ++m) if (REV ? (fq <= 2) : (fq >= 1)) { H[m] = P[m] * Hp[m] + H[m]; P[m] = P[m] * Pp[m]; }
#pragma unroll
        for (int m = 0; m < 4; ++m) { Pp[m] = __shfl(P[m], l32); Hp[m] = __shfl(H[m], l32); }
#pragma unroll
        for (int m = 0; m < 4; ++m) if (REV ? (fq <= 1) : (fq >= 2)) { H[m] = P[m] * Hp[m] + H[m]; P[m] = P[m] * Pp[m]; }
    }
#pragma unroll
    for (int m = 0; m < 4; ++m) { Pe[m] = __shfl(P[m], l16); He[m] = __shfl(H[m], l16); Pt[m] = __shfl(P[m], ltot); Ht[m] = __shfl(H[m], ltot); }
#pragma unroll
    for (int m = 0; m < 4; ++m) if (REV ? (fq == 3) : (fq == 0)) { Pe[m] = 1.f; He[m] = 0.f; }
#pragma unroll
    for (int mm = 0; mm < 4; ++mm) {
        const int m = REV ? 3 - mm : mm;
        const float hin = Pe[m] * cm + He[m];
        cm = Pt[m] * cm + Ht[m]; ptot *= Pt[m];
        if (PASS == 2) {
            float hh = hin;
#pragma unroll
            for (int jj = 0; jj < 4; ++jj) { const int j = REV ? 3 - jj : jj; hh = a[m][j] * hh + b[m][j]; h[m][j] = hh; }
        }
    }
}
template <int PASS>
__device__ __forceinline__ void ph_lru_pass(Ctx& c) {
    const int wu = __builtin_amdgcn_readfirstlane(c.wid), lane = c.lane, fr = lane & 15, fq = lane >> 4;
    const int dir = wu >> 1, nt0 = (wu & 1) ? 3 : 0, nnt = (wu & 1) ? 2 : 3;
    constexpr int NC = PASS == 1 ? NCH : 64;
    const float* cw = c.p.in[12]; const float* cb = c.p.in[13];
#pragma unroll 1
    for (int unit = vblock(); unit < NB * NC * NBLK; unit += gridDim.x) {
        const int n = unit % NBLK, cidx = (unit / NBLK) % NC + (PASS == 1 ? 0 : 4), b = unit / (NBLK * NC);
        int r0, seq0, seqn;
        if (cidx < 4) { seq0 = TL + b * C; seqn = C; r0 = seq0 + cidx * 64; } else { seq0 = b * S; seqn = S; r0 = seq0 + (cidx - 4) * 64; }
        __syncthreads();
        for (int idx = c.tid; idx < 67 * 10; idx += NTHREADS) {
            const int row = idx / 10, c8i = idx % 10, rr = r0 - 2 + row;
            u32x4 v = (u32x4){0u, 0u, 0u, 0u};
            if (rr >= seq0 && rr < seq0 + seqn) v = *(const u32x4*)(c.PU() + (size_t)rr * DR + n * BW + c8i * 8);
            *(LAS u32x4*)(c.smem + L2_RAW + row * 160 + c8i * 16) = v;
        }
        __syncthreads();
        for (int idx = c.tid; idx < 64 * 20; idx += NTHREADS) {
            const int t = idx / 20, c4 = (idx % 20) * 4, ch = n * BW + c4;
            float u0 = cb[ch], u1 = cb[ch + 1], u2 = cb[ch + 2], u3 = cb[ch + 3];
#pragma unroll
            for (int j = 0; j < 4; ++j) {
                const u32x2 raw = *(const LAS u32x2*)(c.smem + L2_RAW + (t + j) * 160 + c4 * 2);
                const float4 w = *(const float4*)(cw + j * DR + ch);
                u0 += w.x * __uint_as_float(raw.x << 16); u1 += w.y * __uint_as_float(raw.x & 0xffff0000u);
                u2 += w.z * __uint_as_float(raw.y << 16); u3 += w.w * __uint_as_float(raw.y & 0xffff0000u);
            }
            u32x2 o; o.x = pk2(u0, u1); o.y = pk2(u2, u3);
            *(LAS u32x2*)(c.smem + L2_U + (t * LU_PITCH + c4) * 2) = o;
        }
        for (int idx = c.tid; idx < 64 * 3; idx += NTHREADS) { const int t = idx / 3, q = idx % 3; *(LAS u32x4*)(c.smem + L2_U + (t * LU_PITCH + 80 + q * 8) * 2) = (u32x4){0u, 0u, 0u, 0u}; }
        __syncthreads();
        bf16x8 af[4][3];
#pragma unroll
        for (int m = 0; m < 4; ++m)
#pragma unroll
            for (int ks = 0; ks < 3; ++ks) af[m][ks] = *(const LAS bf16x8*)(c.smem + L2_U + (16 * m + fr) * (LU_PITCH * 2) + (ks * 32 + fq * 8) * 2);
        const bf16_t* wbase = c.WGATES() + ((((size_t)dir * 2) * NBLK + n) * BW + fr) * 96 + fq * 8;
        bf16x8 bcur[2][3];
#pragma unroll
        for (int mat = 0; mat < 2; ++mat)
#pragma unroll
            for (int ks = 0; ks < 3; ++ks) bcur[mat][ks] = *(const bf16x8*)(wbase + (size_t)mat * NBLK * BW * 96 + nt0 * 16 * 96 + ks * 32);
#pragma unroll 1
        for (int i = 0; i < nnt; ++i) {
            const int nt = nt0 + i, cl = nt * 16 + fr, ch = n * BW + cl;
            const float bav = c.p.in[15][dir * DR + ch], bxv = c.p.in[17][dir * DR + ch], c8v = c.LC8()[dir * DR + ch];
            float cm = PASS == 1 ? 0.f : c.CARRY()[((size_t)(b * 2 + dir) * NCH + cidx) * DR + ch], ptot = 1.f;
            f32x4 acc[2][4];
#pragma unroll
            for (int mat = 0; mat < 2; ++mat)
#pragma unroll
                for (int m = 0; m < 4; ++m) {
                    acc[mat][m] = (f32x4){0.f, 0.f, 0.f, 0.f};
#pragma unroll
                    for (int ks = 0; ks < 3; ++ks) acc[mat][m] = __builtin_amdgcn_mfma_f32_16x16x32_bf16(af[m][ks], bcur[mat][ks], acc[mat][m], 0, 0, 0);
                }
            if (i + 1 < nnt) {
#pragma unroll
                for (int mat = 0; mat < 2; ++mat)
#pragma unroll
                    for (int ks = 0; ks < 3; ++ks) bcur[mat][ks] = *(const bf16x8*)(wbase + (size_t)mat * NBLK * BW * 96 + (nt + 1) * 16 * 96 + ks * 32);
            }
            float av[4][4], bv[4][4], hv[4][4];
#pragma unroll
            for (int m = 0; m < 4; ++m)
#pragma unroll
                for (int j = 0; j < 4; ++j) {
                    const int t = 16 * m + fq * 4 + j;
                    const float r = fast_sigmoid(acc[0][m][j] + bav), ig = fast_sigmoid(acc[1][m][j] + bxv);
                    const float a = __builtin_amdgcn_exp2f(-c8v * r);
                    const float uv = bf2f(*(const LAS bf16_t*)(c.smem + L2_U + (t * LU_PITCH + cl) * 2));
                    av[m][j] = a; bv[m][j] = __builtin_amdgcn_sqrtf(fmaxf(1.f - a * a, 0.f)) * (ig * uv);
                }
            if (dir == 0) lru_scan16<false, PASS>(av, bv, cm, ptot, hv, lane, fq); else lru_scan16<true, PASS>(av, bv, cm, ptot, hv, lane, fq);
            if (PASS == 1) {
                if (fq == 0) { float* sp = c.sum() + (((size_t)(b * 2 + dir) * NCH + cidx) * 2) * DR + ch; sp[0] = ptot; sp[DR] = cm; }
            } else {
#pragma unroll
                for (int m = 0; m < 4; ++m)
#pragma unroll
                    for (int j = 0; j < 4; ++j) *(LAS float*)(c.smem + L2_OUT + ((dir * 64 + 16 * m + fq * 4 + j) * BW + cl) * 4) = hv[m][j];
            }
        }
        if (PASS == 2) {
            __syncthreads();
            for (int idx = c.tid; idx < 64 * 20; idx += NTHREADS) {
                const int t = idx / 20, c4 = (idx % 20) * 4;
                const f32x4 h0 = *(const LAS f32x4*)(c.smem + L2_OUT + (t * BW + c4) * 4), h1 = *(const LAS f32x4*)(c.smem + L2_OUT + ((64 + t) * BW + c4) * 4);
                bf16_t* gp = c.G() + (size_t)(r0 + t) * DR + n * BW + c4;
                const uint2 g = *(const uint2*)gp;
                st_bf16x4(gp, (h0[0] + h1[0]) * __uint_as_float(g.x << 16), (h0[1] + h1[1]) * __uint_as_float(g.x & 0xffff0000u),
                          (h0[2] + h1[2]) * __uint_as_float(g.y << 16), (h0[3] + h1[3]) * __uint_as_float(g.y & 0xffff0000u));
            }
        }
    }
}
__device__ __forceinline__ void ph_lru_carry(Ctx& c) {
    for (int i = blockIdx.x * NTHREADS + c.tid; i < NB * 2 * DR; i += gridDim.x * NTHREADS) {
        const int ch = i % DR, d = (i / DR) & 1, b = i / (2 * DR);
        const float* sp = c.sum() + ((size_t)(b * 2 + d) * NCH * 2) * DR + ch; float* cp = c.CARRY() + ((size_t)(b * 2 + d) * NCH) * DR + ch;
        float h = 0.f;
        if (d == 0) {
#pragma unroll 4
            for (int k = 0; k < NCH; ++k) { cp[(size_t)k * DR] = h; h = sp[(size_t)k * 2 * DR] * h + sp[(size_t)k * 2 * DR + DR]; }
        } else {
#pragma unroll 4
            for (int k = 3; k >= 0; --k) { cp[(size_t)k * DR] = h; h = sp[(size_t)k * 2 * DR] * h + sp[(size_t)k * 2 * DR + DR]; }
#pragma unroll 4
            for (int k = NCH - 1; k >= 4; --k) { cp[(size_t)k * DR] = h; h = sp[(size_t)k * 2 * DR] * h + sp[(size_t)k * 2 * DR + DR]; }
        }
    }
}


typedef float f32x16 __attribute__((ext_vector_type(16)));
typedef short s16x4 __attribute__((ext_vector_type(4)));
__device__ __forceinline__ s16x4 vtr(const LAS unsigned char* p) { return __builtin_bit_cast(s16x4, __builtin_amdgcn_ds_read_tr16_b64_v4i16((LAS s16x4*)p)); }
constexpr int AT_BUF = 16384;
__device__ __forceinline__ void ph_attn_m(Ctx& c) {
    const int tid = c.tid, lane = c.lane, wu = __builtin_amdgcn_readfirstlane(c.wid), r32 = lane & 31, hi = lane >> 5;
    const float* sinkp = c.p.in[10];
    const int NU = NB * 32 * NH + NB * 2 * NH;
#pragma unroll 1
    for (int unit = vblock(); unit < NU; unit += gridDim.x) {
        int b, qb, h, q0, nt, ilo;
        bool lat = unit < NB * 32 * NH;
        if (lat) { h = unit & 15; qb = (unit >> 4) & 31; b = unit >> 9; q0 = b * S + qb * 128; ilo = (qb == 0) ? 2 : 0; const int ihi = (qb == 31) ? 3 : 5; nt = 4 + (ihi - ilo + 1); }
        else { const int u2 = unit - NB * 32 * NH; h = u2 & 15; qb = (u2 >> 4) & 1; b = u2 >> 5; q0 = TL + b * C + qb * 128; ilo = 0; nt = 4; }
        const int g = h >> 2;
        const bf16_t* kbase = c.Kb() + (size_t)lane * KD + g * 64 + (2 * wu) * 8;
        const bf16_t* vbase = c.Vb() + (size_t)(16 * wu + (lane >> 2)) * KD + g * 64 + (lane & 3) * 8;
#define AT_STAGE(buf, kr0) do { \
        __builtin_amdgcn_global_load_lds((const unsigned*)(kbase + (size_t)(kr0) * KD), (LAS unsigned*)(c.smem + (buf) * AT_BUF + (2 * wu) * 1024), 16, 0, 0); \
        __builtin_amdgcn_global_load_lds((const unsigned*)(kbase + (size_t)(kr0) * KD + 8), (LAS unsigned*)(c.smem + (buf) * AT_BUF + (2 * wu + 1) * 1024), 16, 0, 0); \
        __builtin_amdgcn_global_load_lds((const unsigned*)(vbase + (size_t)(kr0) * KD), (LAS unsigned*)(c.smem + (buf) * AT_BUF + 8192 + wu * 1024), 16, 0, 0); \
        __builtin_amdgcn_global_load_lds((const unsigned*)(vbase + (size_t)(kr0) * KD + 32), (LAS unsigned*)(c.smem + (buf) * AT_BUF + 8192 + 4096 + wu * 1024), 16, 0, 0); } while (0)
#define AT_KR0(j) ((j) < 4 ? (TL + b * C + (j) * 64) : (b * S + qb * 128 - 128 + 64 * (ilo + (j) - 4)))
        bf16x8 qr[4];
        { const bf16_t* qp = c.Qb() + (size_t)(q0 + 32 * wu + r32) * 1024 + h * 64 + hi * 8;
#pragma unroll
          for (int ds = 0; ds < 4; ++ds) qr[ds] = *(const bf16x8*)(qp + ds * 16); }
        float m = sinkp[h] * LOG2E, l = hi == 0 ? 1.f : 0.f;
        f32x16 o0, o1;
#pragma unroll
        for (int r = 0; r < 16; ++r) { o0[r] = 0.f; o1[r] = 0.f; }
        const int qi = 32 * wu + r32;
        const int vaddr = ((lane >> 4) & 1) * 32 + (lane & 3) * 8 + (4 * hi + ((lane & 15) >> 2)) * 64;
        __syncthreads();
        AT_STAGE(0, AT_KR0(0));
        AT_STAGE(1, AT_KR0(1));
        AT_STAGE(2, AT_KR0(2));
#pragma unroll 1
        for (int j = 0; j < nt; ++j) {
            if (j + 2 < nt) asm volatile("s_waitcnt vmcnt(8)" ::: "memory");
            else if (j + 1 < nt) asm volatile("s_waitcnt vmcnt(4)" ::: "memory");
            else asm volatile("s_waitcnt vmcnt(0)" ::: "memory");
            __builtin_amdgcn_s_barrier();
            asm volatile("" ::: "memory");
            if (j + 3 < nt) { const int kr1 = AT_KR0(j + 3); AT_STAGE((j + 3) & 3, kr1); }
            const ldsp_t kb = c.smem + (j & 3) * AT_BUF, vb = kb + 8192;
            f32x16 p0, p1;
#pragma unroll
            for (int r = 0; r < 16; ++r) { p0[r] = 0.f; p1[r] = 0.f; }
#pragma unroll
            for (int ds = 0; ds < 4; ++ds) {
                const bf16x8 k0 = *(const LAS bf16x8*)(kb + (ds * 2 + hi) * 1024 + r32 * 16);
                const bf16x8 k1 = *(const LAS bf16x8*)(kb + (ds * 2 + hi) * 1024 + (32 + r32) * 16);
                p0 = __builtin_amdgcn_mfma_f32_32x32x16_bf16(k0, qr[ds], p0, 0, 0, 0);
                p1 = __builtin_amdgcn_mfma_f32_32x32x16_bf16(k1, qr[ds], p1, 0, 0, 0);
            }
            if (lat && j >= 4) {
                const int i = ilo + j - 4;
                if (i < 2 || i > 3) {
                    const int kj0 = 64 * i + 4 * hi;
#pragma unroll
                    for (int r = 0; r < 16; ++r) {
                        const int kj = kj0 + (r & 3) + 8 * (r >> 2);
                        if (kj < qi || kj > qi + 256) p0[r] = -INFINITY;
                        if (kj + 32 < qi || kj + 32 > qi + 256) p1[r] = -INFINITY;
                    }
                }
            }
            float mx = fmaxf(p0[0], p1[0]);
#pragma unroll
            for (int r = 1; r < 16; ++r) mx = fmaxf(mx, fmaxf(p0[r], p1[r]));
            mx = fmaxf(mx, __shfl_xor(mx, 32));
            const float mn = fmaxf(m, mx);
            const float alpha = __builtin_amdgcn_exp2f(m - mn);
            m = mn;
            float ls = 0.f;
#pragma unroll
            for (int r = 0; r < 16; ++r) { p0[r] = __builtin_amdgcn_exp2f(p0[r] - mn); p1[r] = __builtin_amdgcn_exp2f(p1[r] - mn); ls += p0[r] + p1[r]; }
            l = l * alpha + ls;
            if (__any(alpha != 1.f)) {
#pragma unroll
                for (int r = 0; r < 16; ++r) { o0[r] *= alpha; o1[r] *= alpha; }
            }
#pragma unroll
            for (int sub = 0; sub < 2; ++sub)
#pragma unroll
                for (int sk = 0; sk < 2; ++sk) {
                    u32x4 pw;
                    if (sub == 0) { pw.x = pk2(p0[8 * sk + 0], p0[8 * sk + 1]); pw.y = pk2(p0[8 * sk + 2], p0[8 * sk + 3]); pw.z = pk2(p0[8 * sk + 4], p0[8 * sk + 5]); pw.w = pk2(p0[8 * sk + 6], p0[8 * sk + 7]); }
                    else { pw.x = pk2(p1[8 * sk + 0], p1[8 * sk + 1]); pw.y = pk2(p1[8 * sk + 2], p1[8 * sk + 3]); pw.z = pk2(p1[8 * sk + 4], p1[8 * sk + 5]); pw.w = pk2(p1[8 * sk + 6], p1[8 * sk + 7]); }
                    const bf16x8 pf = __builtin_bit_cast(bf16x8, pw);
                    const int ko = (sub * 32 + sk * 16) * 64;
                    const s16x4 a0 = vtr(vb + vaddr + ko), a1 = vtr(vb + vaddr + ko + 512);
                    const s16x4 b0 = vtr(vb + 4096 + vaddr + ko), b1 = vtr(vb + 4096 + vaddr + ko + 512);
                    const bf16x8 vf0 = (bf16x8){a0[0], a0[1], a0[2], a0[3], a1[0], a1[1], a1[2], a1[3]};
                    const bf16x8 vf1 = (bf16x8){b0[0], b0[1], b0[2], b0[3], b1[0], b1[1], b1[2], b1[3]};
                    o0 = __builtin_amdgcn_mfma_f32_32x32x16_bf16(vf0, pf, o0, 0, 0, 0);
                    o1 = __builtin_amdgcn_mfma_f32_32x32x16_bf16(vf1, pf, o1, 0, 0, 0);
                }
        }
#undef AT_STAGE
#undef AT_KR0
        l += __shfl_xor(l, 32);
        const float rl = 1.f / l;
        bf16_t* op = c.Ob() + (size_t)(q0 + qi) * 1024 + h * 64 + 4 * hi;
#pragma unroll
        for (int g4 = 0; g4 < 4; ++g4) {
            st_bf16x4(op + 8 * g4, o0[4 * g4] * rl, o0[4 * g4 + 1] * rl, o0[4 * g4 + 2] * rl, o0[4 * g4 + 3] * rl);
            st_bf16x4(op + 32 + 8 * g4, o1[4 * g4] * rl, o1[4 * g4 + 1] * rl, o1[4 * g4 + 2] * rl, o1[4 * g4 + 3] * rl);
        }
    }
}


struct Row16 { float v[2][8]; };
__device__ __forceinline__ void row_load(Row16& x, const float* src, int lane) {
#pragma unroll
    for (int j = 0; j < 2; ++j) { const f32x4 a = *(const f32x4*)(src + j * 512 + lane * 8), b = *(const f32x4*)(src + j * 512 + lane * 8 + 4);
        x.v[j][0] = a[0]; x.v[j][1] = a[1]; x.v[j][2] = a[2]; x.v[j][3] = a[3]; x.v[j][4] = b[0]; x.v[j][5] = b[1]; x.v[j][6] = b[2]; x.v[j][7] = b[3]; }
}
__device__ __forceinline__ void row_store(const Row16& x, float* dst, int lane) {
#pragma unroll
    for (int j = 0; j < 2; ++j) { *(f32x4*)(dst + j * 512 + lane * 8) = (f32x4){x.v[j][0], x.v[j][1], x.v[j][2], x.v[j][3]}; *(f32x4*)(dst + j * 512 + lane * 8 + 4) = (f32x4){x.v[j][4], x.v[j][5], x.v[j][6], x.v[j][7]}; }
}
__device__ __forceinline__ float row_rinv(const Row16& x) {
    float ss = 0.f;
#pragma unroll
    for (int j = 0; j < 2; ++j)
#pragma unroll
        for (int e = 0; e < 8; ++e) ss += x.v[j][e] * x.v[j][e];
    return rsqrtf(wave_sum(ss) * (1.0f / D) + RMS_EPS);
}
__device__ __forceinline__ void row_normmod_store(const Row16& x, float rinv, const float* g, const float* shift, const float* scale, bf16_t* dst, int lane) {
#pragma unroll
    for (int j = 0; j < 2; ++j) {
        const int k = j * 512 + lane * 8; float h[8];
#pragma unroll
        for (int q = 0; q < 2; ++q) { const f32x4 gv = *(const f32x4*)(g + k + 4 * q), sh = *(const f32x4*)(shift + k + 4 * q), sc = *(const f32x4*)(scale + k + 4 * q);
#pragma unroll
            for (int e = 0; e < 4; ++e) h[4 * q + e] = (x.v[j][4 * q + e] * rinv * gv[e]) * (1.f + sc[e]) + sh[e]; }
        u32x4 o; o.x = pk2(h[0], h[1]); o.y = pk2(h[2], h[3]); o.z = pk2(h[4], h[5]); o.w = pk2(h[6], h[7]);
        *(u32x4*)(dst + k) = o;
    }
}
__device__ __forceinline__ void row_combine(Row16& x, const bf16_t* Y, int r, const float* g2, int lane) {
#pragma unroll
    for (int j = 0; j < 2; ++j) {
        const int k = j * 512 + lane * 8; float s[8];
#pragma unroll
        for (int e = 0; e < 8; ++e) s[e] = 0.f;
#pragma unroll
        for (int kk = 0; kk < TOPK; ++kk) { const u32x4 y = *(const u32x4*)(Y + ((size_t)r * 8 + kk) * D + k);
            s[0] += __uint_as_float(y.x << 16); s[1] += __uint_as_float(y.x & 0xffff0000u); s[2] += __uint_as_float(y.y << 16); s[3] += __uint_as_float(y.y & 0xffff0000u);
            s[4] += __uint_as_float(y.z << 16); s[5] += __uint_as_float(y.z & 0xffff0000u); s[6] += __uint_as_float(y.w << 16); s[7] += __uint_as_float(y.w & 0xffff0000u); }
        const f32x4 ga = *(const f32x4*)(g2 + k), gb = *(const f32x4*)(g2 + k + 4);
#pragma unroll
        for (int e = 0; e < 4; ++e) { x.v[j][e] += ga[e] * s[e]; x.v[j][4 + e] += gb[e] * s[4 + e]; }
    }
}
__device__ __forceinline__ float* xrow_ptr(Ctx& c, int r) { return r < TL ? c.p.out + (size_t)r * D : c.XC() + (size_t)(r - TL) * D; }
__device__ __forceinline__ void ph_norm1_l0_w(Ctx& c) {
    const float* g = c.p.in[6]; constexpr int RB = 2;
    for (int r0 = (blockIdx.x * 4 + c.wid) * RB; r0 < T0; r0 += gridDim.x * 4 * RB) {
        Row16 x[RB];
#pragma unroll
        for (int i = 0; i < RB; ++i) { const int r = r0 + i; row_load(x[i], r < TL ? c.p.in[0] + (size_t)r * D : c.p.in[2] + (size_t)(r - TL) * D, c.lane); }
#pragma unroll
        for (int i = 0; i < RB; ++i) { const int r = r0 + i; const float* m = c.mod() + mod_row(r) * 6144;
            row_normmod_store(x[i], row_rinv(x[i]), g, m, m + 1024, c.H() + (size_t)r * D, c.lane); }
    }
}
__device__ __forceinline__ void ph_norm2_w(Ctx& c, int layer) {
    const int T = layer == 0 ? T0 : TL; const float* g = c.p.in[7] + layer * D; constexpr int RB = 2;
    for (int r0 = (blockIdx.x * 4 + c.wid) * RB; r0 < T; r0 += gridDim.x * 4 * RB) {
        Row16 x[RB];
#pragma unroll
        for (int i = 0; i < RB; ++i) row_load(x[i], xrow_ptr(c, r0 + i), c.lane);
#pragma unroll
        for (int i = 0; i < RB; ++i) { const int r = r0 + i; const float* m = c.mod() + ((size_t)layer * 5 + mod_row(r)) * 6144;
            row_normmod_store(x[i], row_rinv(x[i]), g, m + 3 * 1024, m + 4 * 1024, c.H() + (size_t)r * D, c.lane); }
    }
}
__device__ __forceinline__ void ph_combine_norm1_w(Ctx& c) {
    const float* g = c.p.in[6] + D; constexpr int RB = 1;
    for (int r0 = (blockIdx.x * 4 + c.wid) * RB; r0 < T0; r0 += gridDim.x * 4 * RB) {
        Row16 x[RB];
#pragma unroll
        for (int i = 0; i < RB; ++i) row_load(x[i], xrow_ptr(c, r0 + i), c.lane);
#pragma unroll
        for (int i = 0; i < RB; ++i) row_combine(x[i], c.Y(), r0 + i, c.mod() + (size_t)mod_row(r0 + i) * 6144 + 5 * 1024, c.lane);
#pragma unroll
        for (int i = 0; i < RB; ++i) { const int r = r0 + i; row_store(x[i], xrow_ptr(c, r), c.lane);
            const float* m = c.mod() + ((size_t)5 + mod_row(r)) * 6144;
            row_normmod_store(x[i], row_rinv(x[i]), g, m, m + 1024, c.H() + (size_t)r * D, c.lane); }
    }
}
__device__ __forceinline__ void ph_final_w(Ctx& c) {
    const float* g = c.p.in[28]; constexpr int RB = 1;
    for (int r0 = (blockIdx.x * 4 + c.wid) * RB; r0 < TL; r0 += gridDim.x * 4 * RB) {
        Row16 x[RB];
#pragma unroll
        for (int i = 0; i < RB; ++i) row_load(x[i], c.p.out + (size_t)(r0 + i) * D, c.lane);
#pragma unroll
        for (int i = 0; i < RB; ++i) row_combine(x[i], c.Y(), r0 + i, c.mod() + ((size_t)5 + mod_row(r0 + i)) * 6144 + 5 * 1024, c.lane);
#pragma unroll
        for (int i = 0; i < RB; ++i) {
            const float rinv = row_rinv(x[i]);
#pragma unroll
            for (int j = 0; j < 2; ++j) { const int k = j * 512 + c.lane * 8; const f32x4 ga = *(const f32x4*)(g + k), gb = *(const f32x4*)(g + k + 4);
#pragma unroll
                for (int e = 0; e < 4; ++e) { x[i].v[j][e] = x[i].v[j][e] * rinv * ga[e]; x[i].v[j][4 + e] = x[i].v[j][4 + e] * rinv * gb[e]; } }
            row_store(x[i], c.p.out + (size_t)(r0 + i) * D, c.lane);
        }
    }
}
struct MEpiRouter { ldsp_t lg;
    __device__ __forceinline__ void operator()(f32x4 (&acc)[4][8], ldsp_t wl, int rbase, int cbase, int lane) const {
        const int fr = lane & 15, fq = lane >> 4, rl = (rbase & 127);
#pragma unroll
        for (int m = 0; m < 4; ++m)
#pragma unroll
            for (int n = 0; n < 2; ++n)
#pragma unroll
                for (int j = 0; j < 4; ++j) *(LAS float*)(lg + ((rl + m * 16 + fr) * 65 + cbase + n * 16 + fq * 4 + j) * 4) = acc[m][n][j];
        __syncthreads();
    }
};
__device__ __forceinline__ void ph_route_m(Ctx& c, int layer) {
    const int T = layer == 0 ? T0 : TL;
    const RowPlain rp{c.H(), D};
    const MEpiRouter ep{c.smem};
    LAS float* bias = (LAS float*)(c.smem + 128 * 65 * 4);
    for (int mt = vblock(); mt < T / 128; mt += gridDim.x) {
        router_tile(c.smem, c.H(), c.WROUTER() + (size_t)layer * 128 * D, D, ep, mt * 128);
        if (c.tid < NE) bias[c.tid] = c.p.in[21][layer * NE + c.tid];
        __syncthreads();
        if (c.tid < 128) {
            LAS float* sc = (LAS float*)c.smem + c.tid * 65;
            for (int e = 0; e < NE; ++e) sc[e] = fast_sigmoid(sc[e]);
            unsigned gmask = 0; float gs[8];
#pragma unroll
            for (int g = 0; g < 8; ++g) {
                float m1 = -INFINITY, m2 = -INFINITY;
#pragma unroll
                for (int i = 0; i < 8; ++i) { const float v = sc[g * 8 + i] + bias[g * 8 + i]; if (v > m1) { m2 = m1; m1 = v; } else if (v > m2) m2 = v; }
                gs[g] = m1 + m2;
            }
#pragma unroll
            for (int it = 0; it < 4; ++it) {
                float best = -INFINITY; int bi = 0;
#pragma unroll
                for (int g = 0; g < 8; ++g) { const bool used = (gmask >> g) & 1u; if (!used && gs[g] > best) { best = gs[g]; bi = g; } }
                gmask |= 1u << bi;
            }
            unsigned long long used = 0ull; float wsum = 0.f; int se[TOPK]; float ss[TOPK];
#pragma unroll
            for (int it = 0; it < TOPK; ++it) {
                float best = -INFINITY; int bi = -1;
#pragma unroll 1
                for (int e = 0; e < NE; ++e) {
                    if (!((gmask >> (e >> 3)) & 1u)) continue;
                    if ((used >> e) & 1ull) continue;
                    const float v = sc[e] + bias[e];
                    if (bi < 0 || v > best) { best = v; bi = e; }
                }
                used |= 1ull << bi; se[it] = bi; ss[it] = sc[bi]; wsum += ss[it];
            }
            const float norm = 2.5f / wsum; const int t = mt * 128 + c.tid;
#pragma unroll
            for (int k = 0; k < TOPK; ++k) {
                const int e = se[k]; const int pos = (int)atomicAdd(&c.cnt()[layer * 64 + e], 1u); const int a = t * 8 + k;
                c.AE()[a] = e; c.APOS()[a] = pos; c.AW()[a] = ss[k] * norm; c.LIST()[(size_t)e * T0 + pos] = a;
            }
        }
    }
}

__global__ void __launch_bounds__(NTHREADS, 2) mega(const Params p) {
    __shared__ __attribute__((aligned(16))) unsigned char smem[LDS_LRU_END + 16 + 1024];
    float* lds = (float*)smem;
    Ctx c(p, lds, (ldsp_t)smem);
    volatile unsigned* st = (volatile unsigned*)(smem + LDS_LRU_END);
    if (c.tid < 4) st[c.tid] = 0u;
    __syncthreads();
    const XcdBarrier bar = xcd_barrier_post((unsigned*)(p.ws + CTL_BAR), st);
#define GB() xcd_barrier(bar)
#define REPEAT(n, stmt) do { for (int rep_ = 0; rep_ < (n); ++rep_) { stmt; if (rep_ + 1 < (n)) GB(); } } while (0)
    REPEAT(REP_PREP, (ph_prep(c), ph_convert_small(c), ph_convert_gates(c), ph_convert_moe(c, 0))); GB();
    {
        if (c.tid == 0) {
            unsigned* ctl = (unsigned*)(p.ws + CTL_BAR);
            const unsigned tk = xb_add((unsigned*)(p.ws + CTL_TICKET) + 64 * bar.x, 1u);
            unsigned base = 0u;
            for (unsigned j = 0; j < 16; ++j) { const unsigned n = xb_ld(&ctl[XB_XCNT(j)]); base += (j < bar.x) ? n : 0u; }
            st[2] = base + tk;
        }
        __syncthreads();
        c.vb = __builtin_amdgcn_readfirstlane((int)st[2]);
    }
    ph_norm1_l0_w(c); GB();
    REPEAT(REP_QKV, ph_qkv_m(c)); GB();
    REPEAT(REP_ATTN, ph_attn_m(c)); GB();
    ph_oproj_m(c); GB();
    REPEAT(REP_NORM2, ph_norm2_w(c, 0)); GB();
    ph_route_m(c, 0); GB();
    REPEAT(REP_GATEUP, ph_moe_gateup_m(c, 0, T0)); GB();
    ph_moe_down_m(c, 0, T0); GB();
    ph_combine_norm1_w(c); ph_convert_moe(c, 1); GB();
    REPEAT(REP_INPROJ, ph_inproj_m(c)); GB();
    REPEAT(REP_LRU1, ph_lru_pass<1>(c)); GB();
    ph_lru_carry(c); GB();
    ph_lru_pass<2>(c); GB();
    ph_outproj_m(c); GB();
    ph_norm2_w(c, 1); GB();
    ph_route_m(c, 1); GB();
    ph_moe_gateup_m(c, 1, TL); GB();
    ph_moe_down_m(c, 1, TL); GB();
    ph_final_w(c);
#undef GB
}
}

extern "C" void kernel_launch(void* const* d_in, const int* in_sizes, int n_in, void* d_out, int out_size, void* d_ws, size_t ws_size, hipStream_t stream) {
    if (n_in != 29 || ws_size < WS_END) { fprintf(stderr, "kernel_launch: unexpected n_in %d or ws_size %zu (< %zu)\n", n_in, ws_size, (size_t)WS_END); return; }
    static int grid = 0;
    if (grid == 0) {
        int dev = 0, cus = 0, per_cu = 0;
        hipGetDevice(&dev);
        hipDeviceGetAttribute(&cus, hipDeviceAttributeMultiprocessorCount, dev);
        hipOccupancyMaxActiveBlocksPerMultiprocessor(&per_cu, (const void*)mega, NTHREADS, 0);
        if (per_cu > 2) per_cu = 2;
        if (per_cu < 1) per_cu = 1;
        grid = cus * per_cu;
    }
    hipMemsetAsync((char*)d_ws + WS_CTL, 0, CTL_BYTES, stream);
    Params p{};
    for (int i = 0; i < 29; ++i) p.in[i] = (const float*)d_in[i];
    p.out = (float*)d_out; p.ws = (unsigned char*)d_ws;
    p.ph_lo = 0; p.ph_hi = 20;
    void* args[] = {&p};
    hipError_t e = hipLaunchCooperativeKernel((const void*)mega, dim3(grid), dim3(NTHREADS), args, 0, stream);
    if (e != hipSuccess) fprintf(stderr, "cooperative launch failed: %s (grid %d)\n", hipGetErrorString(e), grid);
}
```

```cpp
#include <hip/hip_runtime.h>
#include <stdint.h>
#include <cstdio>

namespace {
typedef unsigned short bf16_t;
constexpr int D = 1024, NB = 4, S = 4096, C = 256, TL = NB * S, TC = NB * C, T0 = TL + TC;
constexpr int NH = 16, NKV = 4, HD = 64, KD = 256, QKVN = 1536;
constexpr int DR = 1280, NBLK = 16, BW = 80;
constexpr int NE = 64, TOPK = 8, DE = 256;
constexpr float RMS_EPS = 1e-6f;
constexpr float LOG2E = 1.4426950408889634f;
constexpr float QSCALE = 0.125f * LOG2E;
constexpr int NTHREADS = 256;
constexpr int REP_PREP = 1, REP_QKV = 1, REP_ATTN = 1, REP_GATEUP = 1, REP_INPROJ = 1, REP_LRU1 = 1, REP_NORM2 = 1;
constexpr int LDS_U = 0, LDS_A = 13312, LDS_B0 = LDS_A + 20480, LDS_B1 = LDS_B0 + 20480, LDS_LRU_END = LDS_B1 + 20480;

constexpr size_t MiB = 1u << 20;
constexpr size_t WS_CTL = 0, CTL_BYTES = 1 * MiB;
constexpr size_t CTL_BAR = 0;
constexpr size_t CTL_TICKET = 16384;
constexpr size_t CTL_CNT = 32768;
constexpr size_t CTL_MOD = 65536;
constexpr size_t WS_ROPE = 1 * MiB + 512 * 1024;
constexpr size_t WS_SUM = 2 * MiB;
constexpr size_t WS_AE = 8 * MiB;
constexpr size_t WS_AW = WS_AE + 640 * 1024;
constexpr size_t WS_APOS = WS_AW + 640 * 1024;
constexpr size_t WS_LIST = 10 * MiB;
constexpr size_t WS_XC = 15 * MiB;
constexpr size_t WS_WQKV = 19 * MiB, WS_WO = 22 * MiB, WS_WIN = 24 * MiB, WS_WOUT = 29 * MiB, WS_WGATES = 32 * MiB, WS_WROUTER = 33 * MiB, WS_WSH = 34 * MiB;
constexpr size_t WSH_LAYER = 1536 * 1024, WSH_D = 1024 * 1024;
constexpr size_t WMOE_D = 64 * MiB;
constexpr size_t WS_WMOE = 37 * MiB;
constexpr size_t WS_H = 138 * MiB;
constexpr size_t WS_ACT = 172 * MiB;
constexpr size_t WS_ACTS = 240 * MiB;
constexpr size_t WS_BIG = 249 * MiB;
constexpr size_t WS_Q = WS_BIG, WS_K = WS_BIG + 34 * MiB, WS_V = WS_K + 9 * MiB, WS_O = WS_V + 9 * MiB;
constexpr size_t WS_G = WS_BIG, WS_PU = WS_BIG + 40 * MiB, WS_AB = WS_BIG + 83 * MiB;
constexpr size_t WS_CARRY = WS_BIG + 84 * MiB;
constexpr size_t WS_LC8 = 1 * MiB + 640 * 1024;
constexpr size_t WS_END = 521 * MiB;

struct Params {
    const float* in[29];
    float* out;
    unsigned char* ws;
    int ph_lo, ph_hi;
};

__device__ __forceinline__ float bf2f(bf16_t h) { return __uint_as_float(((unsigned)h) << 16); }
__device__ __forceinline__ bf16_t f2bf(float f) { unsigned u = __float_as_uint(f); return (bf16_t)((u + 0x7fffu + ((u >> 16) & 1u)) >> 16); }
__device__ __forceinline__ float silu_f(float v) { return v * __builtin_amdgcn_rcpf(1.f + __builtin_amdgcn_exp2f(-LOG2E * v)); }
__device__ __forceinline__ float gelu_tanh(float v) { const float u = 0.7978845608028654f * (v + 0.044715f * v * v * v); return v * __builtin_amdgcn_rcpf(1.f + __builtin_amdgcn_exp2f(-2.f * LOG2E * u)); }
__device__ __forceinline__ float wave_sum(float v) {
#pragma unroll
    for (int o = 32; o > 0; o >>= 1) v += __shfl_xor(v, o);
    return v;
}
__device__ __forceinline__ int mod_row(int r) { return r < TL ? (r >> 12) : 4; }

#define XB_TMO      128
#define XB_XCNT(j)  (256  + 64 * (j))
#define XB_XSUB(j)  (1280 + 64 * (j))
#define XB_XGEN(j)  (2304 + 64 * (j))
#define XB_TOP      3328
#define XB_TOPGEN   3392
#define XCD_BAR_WORDS 3456
#define XB_SPIN_CAP (1u << 22)
#define LAS __attribute__((address_space(3)))
__device__ __forceinline__ unsigned xb_ld(unsigned* p)              { return __hip_atomic_load(p, __ATOMIC_RELAXED, __HIP_MEMORY_SCOPE_AGENT); }
__device__ __forceinline__ unsigned xb_add(unsigned* p, unsigned v) { return __hip_atomic_fetch_add(p, v, __ATOMIC_RELAXED, __HIP_MEMORY_SCOPE_AGENT); }
__device__ __forceinline__ unsigned xb_xcc_id() { return (unsigned)__builtin_amdgcn_s_getreg((3 << 11) | 20) & 0xFu; }
#define XB_SPIN(cond, bar) do { unsigned _sp = 0; while (cond) { __builtin_amdgcn_s_sleep(1); \
    if ((++_sp & 255u) == 0u) { if (xb_ld(&(bar)[XB_TMO])) break; if (_sp > XB_SPIN_CAP) { atomicAdd(&(bar)[XB_TMO], 1u); break; } } } } while (0)
struct XcdBarrier { unsigned* bar; unsigned x; volatile unsigned* st; };
__device__ __forceinline__ XcdBarrier xcd_barrier_post(unsigned* bar, volatile unsigned* st) {
    XcdBarrier b; b.bar = bar; b.x = xb_xcc_id(); b.st = st;
    if (threadIdx.x == 0) (void)xb_add(&bar[XB_XCNT(b.x)], 1u);
    return b;
}
__device__ __forceinline__ void xcd_barrier_complete(unsigned* bar, unsigned x, unsigned& nloc, unsigned& nx) {
    const unsigned G = gridDim.x * gridDim.y * gridDim.z;
    unsigned sum, cnt, mine, sp = 0u;
    for (;;) {
        sum = 0u; cnt = 0u; mine = 0u;
#pragma unroll
        for (unsigned j = 0; j < 16; ++j) { const unsigned c = xb_ld(&bar[XB_XCNT(j)]); sum += c; cnt += (c > 0u) ? 1u : 0u; mine = (j == x) ? c : mine; }
        if (sum == G) break;
        __builtin_amdgcn_s_sleep(1);
        if ((++sp & 255u) == 0u) { if (xb_ld(&bar[XB_TMO])) break; if (sp > XB_SPIN_CAP) { atomicAdd(&bar[XB_TMO], 1u); break; } }
    }
    nloc = mine > 0u ? mine : 1u; nx = cnt > 0u ? cnt : 1u;
}
__device__ __forceinline__ void xcd_barrier(const XcdBarrier& b) {
    asm volatile("s_waitcnt vmcnt(0)" ::: "memory");
    __syncthreads();
    if (threadIdx.x == 0) {
        unsigned* bar = b.bar;
        __builtin_amdgcn_s_waitcnt(0);
        unsigned nloc = b.st[0], nx = b.st[1];
        if (nloc == 0u) { xcd_barrier_complete(bar, b.x, nloc, nx); b.st[0] = nloc; b.st[1] = nx; }
        const unsigned old = xb_add(&bar[XB_XSUB(b.x)], 1u);
        const unsigned gen = old / nloc;
        if (old + 1u == (gen + 1u) * nloc) {
            __builtin_amdgcn_fence(__ATOMIC_RELEASE, "agent");
            asm volatile("s_waitcnt vmcnt(0)" ::: "memory");
            const unsigned og = xb_add(&bar[XB_TOP], 1u);
            const unsigned tg = og / nx;
            if (og + 1u == (tg + 1u) * nx) xb_add(&bar[XB_TOPGEN], 1u);
            else XB_SPIN(xb_ld(&bar[XB_TOPGEN]) == tg, bar);
            __builtin_amdgcn_fence(__ATOMIC_ACQUIRE, "agent");
            xb_add(&bar[XB_XGEN(b.x)], 1u);
            asm volatile("s_waitcnt vmcnt(0)" ::: "memory");
        } else {
            XB_SPIN(xb_ld(&bar[XB_XGEN(b.x)]) == gen, bar);
            __builtin_amdgcn_fence(__ATOMIC_ACQUIRE, "agent");
            asm volatile("s_waitcnt vmcnt(0)" ::: "memory");
        }
    }
    __syncthreads();
}


typedef short bf16x8 __attribute__((ext_vector_type(8)));
typedef float f32x4 __attribute__((ext_vector_type(4)));
typedef unsigned u32x4 __attribute__((ext_vector_type(4)));
typedef unsigned u32x2 __attribute__((ext_vector_type(2)));
typedef LAS unsigned char* ldsp_t;
constexpr int EP_WAVE = 17408;
constexpr int GT_STG = 24576;
template <class RowPtr, class Epi>
__device__ __forceinline__ void mfma_tile(ldsp_t lds, const RowPtr& rp, const bf16_t* Bt, int K, const Epi& ep, int row0, int col0) {
    const int tid = threadIdx.x, lane = tid & 63, wid = __builtin_amdgcn_readfirstlane(tid >> 6), wr = wid >> 1, wc = wid & 1, fr = lane & 15, fq = lane >> 4;
    const int sch = ((tid & 3) ^ ((-(tid >> 4)) & 3)) * 8;
    const bf16_t* ap0 = rp(row0 + (tid >> 2)) + sch;
    const bf16_t* ap1 = rp(row0 + 64 + (tid >> 2)) + sch;
    const bf16_t* bp = Bt + (size_t)(tid >> 2) * K + sch;
    const size_t bstep = (size_t)64 * K;
    const int cterm = ((fq ^ ((-(fr >> 2)) & 3)) << 4);
    const int aoff = (wr * 64 + fr) * 64 + cterm, boff = 8192 + (wc * 128 + fr) * 64 + cterm;
    f32x4 acc[4][8];
#pragma unroll
    for (int m = 0; m < 4; ++m)
#pragma unroll
        for (int n = 0; n < 8; ++n) acc[m][n] = (f32x4){0.f, 0.f, 0.f, 0.f};
#define GT_STAGE(sb, k0) do { const ldsp_t d_ = lds + (sb) + wid * 1024; \
        __builtin_amdgcn_global_load_lds((const unsigned*)(ap0 + (k0)), (LAS unsigned*)(d_), 16, 0, 0); \
        __builtin_amdgcn_global_load_lds((const unsigned*)(ap1 + (k0)), (LAS unsigned*)(d_ + 4096), 16, 0, 0); \
        _Pragma("unroll") for (int i_ = 0; i_ < 4; ++i_) \
            __builtin_amdgcn_global_load_lds((const unsigned*)(bp + i_ * bstep + (k0)), (LAS unsigned*)(d_ + 8192 + i_ * 4096), 16, 0, 0); } while (0)
    const int nt = K >> 5;
    asm volatile("s_waitcnt lgkmcnt(0)" ::: "memory");
    __builtin_amdgcn_s_barrier();
    asm volatile("" ::: "memory");
    GT_STAGE(0, 0);
    GT_STAGE(GT_STG, 32);
    int scur = 0, snx = 2 * GT_STG;
#pragma unroll 1
    for (int t = 0; t < nt; ++t) {
        if (t + 1 < nt) asm volatile("s_waitcnt vmcnt(6)" ::: "memory"); else asm volatile("s_waitcnt vmcnt(0)" ::: "memory");
        __builtin_amdgcn_s_barrier();
        asm volatile("" ::: "memory");
        if (t + 2 < nt) GT_STAGE(snx, (t + 2) * 32);
        const ldsp_t base = lds + scur;
        bf16x8 af[4], bfr[8];
#pragma unroll
        for (int m = 0; m < 4; ++m) af[m] = *(const LAS bf16x8*)(base + aoff + m * 1024);
#pragma unroll
        for (int n = 0; n < 8; ++n) bfr[n] = *(const LAS bf16x8*)(base + boff + n * 1024);
#pragma unroll
        for (int m = 0; m < 4; ++m)
#pragma unroll
            for (int n = 0; n < 8; ++n) acc[m][n] = __builtin_amdgcn_mfma_f32_16x16x32_bf16(bfr[n], af[m], acc[m][n], 0, 0, 0);
        scur = (scur == 2 * GT_STG) ? 0 : scur + GT_STG;
        snx = (snx == 2 * GT_STG) ? 0 : snx + GT_STG;
    }
#undef GT_STAGE
    __syncthreads();
    ep(acc, lds + wid * EP_WAVE, row0 + wr * 64, col0 + wc * 128, lane);
}
constexpr int RT_STG = 12288, RT_NS = 6;
template <class Epi>
__device__ __forceinline__ void router_tile(ldsp_t lds, const bf16_t* A, const bf16_t* Bt, int K, const Epi& ep, int row0) {
    const int tid = threadIdx.x, lane = tid & 63, wid = __builtin_amdgcn_readfirstlane(tid >> 6), wr = wid >> 1, wc = wid & 1, fr = lane & 15, fq = lane >> 4;
    const int sch = ((tid & 3) ^ ((-(tid >> 4)) & 3)) * 8;
    const bf16_t* ap0 = A + (size_t)(row0 + (tid >> 2)) * K + sch;
    const bf16_t* ap1 = ap0 + (size_t)64 * K;
    const bf16_t* bp = Bt + (size_t)(tid >> 2) * K + sch;
    const int cterm = ((fq ^ ((-(fr >> 2)) & 3)) << 4);
    const int aoff = (wr * 64 + fr) * 64 + cterm, boff = 8192 + (wc * 32 + fr) * 64 + cterm;
    f32x4 acc[4][8];
#pragma unroll
    for (int m = 0; m < 4; ++m)
#pragma unroll
        for (int n = 0; n < 8; ++n) acc[m][n] = (f32x4){0.f, 0.f, 0.f, 0.f};
#define RT_STAGE(sb, k0) do { const ldsp_t d_ = lds + (sb) + wid * 1024; \
        __builtin_amdgcn_global_load_lds((const unsigned*)(ap0 + (k0)), (LAS unsigned*)(d_), 16, 0, 0); \
        __builtin_amdgcn_global_load_lds((const unsigned*)(ap1 + (k0)), (LAS unsigned*)(d_ + 4096), 16, 0, 0); \
        __builtin_amdgcn_global_load_lds((const unsigned*)(bp + (k0)), (LAS unsigned*)(d_ + 8192), 16, 0, 0); } while (0)
    const int nt = K >> 5;
    asm volatile("s_waitcnt lgkmcnt(0)" ::: "memory");
    __builtin_amdgcn_s_barrier();
    asm volatile("" ::: "memory");
#pragma unroll
    for (int q = 0; q < RT_NS - 1; ++q) RT_STAGE(q * RT_STG, q * 32);
    int scur = 0, snx = (RT_NS - 1) * RT_STG;
#pragma unroll 1
    for (int t = 0; t < nt; ++t) {
        if (t + RT_NS - 1 <= nt) asm volatile("s_waitcnt vmcnt(12)" ::: "memory");
        else asm volatile("s_waitcnt vmcnt(0)" ::: "memory");
        __builtin_amdgcn_s_barrier();
        asm volatile("" ::: "memory");
        if (t + RT_NS - 1 < nt) RT_STAGE(snx, (t + RT_NS - 1) * 32);
        const ldsp_t base = lds + scur;
        bf16x8 af[4], bfr[2];
#pragma unroll
        for (int m = 0; m < 4; ++m) af[m] = *(const LAS bf16x8*)(base + aoff + m * 1024);
#pragma unroll
        for (int n = 0; n < 2; ++n) bfr[n] = *(const LAS bf16x8*)(base + boff + n * 1024);
#pragma unroll
        for (int m = 0; m < 4; ++m)
#pragma unroll
            for (int n = 0; n < 2; ++n) acc[m][n] = __builtin_amdgcn_mfma_f32_16x16x32_bf16(bfr[n], af[m], acc[m][n], 0, 0, 0);
        scur = (scur == (RT_NS - 1) * RT_STG) ? 0 : scur + RT_STG;
        snx = (snx == (RT_NS - 1) * RT_STG) ? 0 : snx + RT_STG;
    }
#undef RT_STAGE
    __syncthreads();
    ep(acc, lds, row0 + wr * 64, wc * 32, lane);
}
typedef float f32x2_t __attribute__((ext_vector_type(2))); typedef __bf16 bf16x2_t __attribute__((ext_vector_type(2)));
__device__ __forceinline__ unsigned pk2(float lo, float hi) { f32x2_t v = {lo, hi}; bf16x2_t b = __builtin_convertvector(v, bf16x2_t); return __builtin_bit_cast(unsigned, b); }
__device__ __forceinline__ void st_bf16x4(bf16_t* p, float a, float b, float c, float d) { uint2 o; o.x = pk2(a, b); o.y = pk2(c, d); *(uint2*)p = o; }

struct RowPlain { const bf16_t* A; int lda; __device__ __forceinline__ const bf16_t* operator()(int r) const { return A + (size_t)r * lda; } };

constexpr int EPB = 272;
constexpr int EPF = 528;
__device__ __forceinline__ void ep_put4(ldsp_t wl, int row, int col, float a, float b, float c, float d) { u32x2 o; o.x = pk2(a, b); o.y = pk2(c, d); *(LAS u32x2*)(wl + row * EPB + col * 2) = o; }
struct MEpiQKV {
    bf16_t *Q, *K, *V; const float* rope;
    __device__ __forceinline__ void operator()(f32x4 (&acc)[4][8], ldsp_t wl, int rbase, int cbase0, int lane) const {
        const int fr = lane & 15, fq = lane >> 4;
#pragma unroll
        for (int hh = 0; hh < 2; ++hh) {
            const int cbase = cbase0 + hh * 64;
            const bool isq = cbase < 1024, isk = (cbase >= 1024 && cbase < 1280);
#pragma unroll
            for (int m = 0; m < 4; ++m) {
                const int r = rbase + m * 16 + fr;
                f32x4 v0 = acc[m][hh * 4 + 0], v1 = acc[m][hh * 4 + 1], v2 = acc[m][hh * 4 + 2], v3 = acc[m][hh * 4 + 3];
                if ((isq || isk) && r < TL) {
                    const int s = r & (S - 1), prow = s >> 6, pcol = s & 63;
                    const f32x4 cr = *(const f32x4*)(rope + prow * 16 + fq * 4), sr = *(const f32x4*)(rope + 1024 + prow * 16 + fq * 4);
                    const f32x4 cc = *(const f32x4*)(rope + pcol * 16 + fq * 4), sc = *(const f32x4*)(rope + 1024 + pcol * 16 + fq * 4);
                    const f32x4 o0 = v0 * cr - v1 * sr, o1 = v1 * cr + v0 * sr, o2 = v2 * cc - v3 * sc, o3 = v3 * cc + v2 * sc;
                    v0 = o0; v1 = o1; v2 = o2; v3 = o3;
                }
                if (isq) { v0 *= QSCALE; v1 *= QSCALE; v2 *= QSCALE; v3 *= QSCALE; }
                const int rl = m * 16 + fr, cl = hh * 64 + fq * 4;
                ep_put4(wl, rl, cl, v0[0], v0[1], v0[2], v0[3]); ep_put4(wl, rl, cl + 16, v1[0], v1[1], v1[2], v1[3]);
                ep_put4(wl, rl, cl + 32, v2[0], v2[1], v2[2], v2[3]); ep_put4(wl, rl, cl + 48, v3[0], v3[1], v3[2], v3[3]);
            }
        }
        const bool isq = cbase0 < 1024, isk = (cbase0 >= 1024 && cbase0 < 1280);
        bf16_t* base = isq ? (Q + cbase0) : isk ? (K + (cbase0 - 1024)) : (V + (cbase0 - 1280));
        const size_t pitch = isq ? 1024 : 256;
#pragma unroll 2
        for (int i = 0; i < 16; ++i) {
            const int rl = 4 * i + (lane >> 4), ch = lane & 15;
            const u32x4 v = *(const LAS u32x4*)(wl + rl * EPB + ch * 16);
            *(u32x4*)(base + (size_t)(rbase + rl) * pitch + ch * 8) = v;
        }
    }
};
struct MEpiResid {
    const float* srcL; const float* srcC; float* dstL; float* dstC; const float* mod; int gchunk;
    __device__ __forceinline__ void operator()(f32x4 (&acc)[4][8], ldsp_t wl, int rbase, int cbase, int lane) const {
        const int fr = lane & 15, fq = lane >> 4, c4 = (lane & 31) * 4;
        const f32x4 gv = *(const f32x4*)(mod + mod_row(rbase) * 6144 + gchunk * 1024 + cbase + c4);
        const bool latent = rbase < TL;
        const float* sbase = (latent ? srcL + (size_t)rbase * D : srcC + (size_t)(rbase - TL) * D) + cbase + c4 + (size_t)(lane >> 5) * D;
        float* dbase = (latent ? dstL + (size_t)rbase * D : dstC + (size_t)(rbase - TL) * D) + cbase + c4 + (size_t)(lane >> 5) * D;
#pragma unroll
        for (int half = 0; half < 2; ++half) {
#pragma unroll
            for (int mm = 0; mm < 2; ++mm)
#pragma unroll
                for (int n = 0; n < 8; ++n) *(LAS f32x4*)(wl + (mm * 16 + fr) * EPF + (n * 16 + fq * 4) * 4) = acc[half * 2 + mm][n];
#pragma unroll
            for (int q = 0; q < 2; ++q) {
                f32x4 sv[8];
#pragma unroll
                for (int i = 0; i < 8; ++i) sv[i] = *(const f32x4*)(sbase + (size_t)(half * 32 + 16 * q + 2 * i) * D);
#pragma unroll
                for (int i = 0; i < 8; ++i) {
                    const int rl = 16 * q + 2 * i + (lane >> 5);
                    const f32x4 v = *(const LAS f32x4*)(wl + rl * EPF + c4 * 4);
                    *(f32x4*)(dbase + (size_t)(half * 32 + 16 * q + 2 * i) * D) = sv[i] + gv * v;
                }
            }
        }
    }
};
struct MEpiInProj {
    bf16_t* G; bf16_t* PU;
    __device__ __forceinline__ void operator()(f32x4 (&acc)[4][8], ldsp_t wl, int rbase, int cbase, int lane) const {
        const int fr = lane & 15, fq = lane >> 4;
        const bool isg = cbase < DR;
#pragma unroll
        for (int m = 0; m < 4; ++m)
#pragma unroll
            for (int n = 0; n < 8; ++n) {
                const f32x4 v = acc[m][n];
                if (isg) ep_put4(wl, m * 16 + fr, n * 16 + fq * 4, gelu_tanh(v[0]), gelu_tanh(v[1]), gelu_tanh(v[2]), gelu_tanh(v[3]));
                else ep_put4(wl, m * 16 + fr, n * 16 + fq * 4, v[0], v[1], v[2], v[3]);
            }
        bf16_t* base = isg ? (G + cbase) : (PU + (cbase - DR));
#pragma unroll 2
        for (int i = 0; i < 16; ++i) {
            const int rl = 4 * i + (lane >> 4), ch = lane & 15, r = rbase + rl;
            const u32x4 v = *(const LAS u32x4*)(wl + rl * EPB + ch * 16);
            if (!isg || r < TL) *(u32x4*)(base + (size_t)r * DR + ch * 8) = v;
        }
    }
};
#define vblock() (c.vb)

template <class RowMap>
__device__ __forceinline__ void tr_item64(const float* W, int ldw, int k0, int n0, bf16_t* dst, int ldd, const RowMap& rm, int lane) {
    const int nq = lane >> 2, kg = lane & 3;
    f32x4 v[16];
    const float* src = W + (size_t)(k0 + kg * 8) * ldw + n0 + 4 * nq;
#pragma unroll
    for (int h = 0; h < 2; ++h)
#pragma unroll
        for (int i = 0; i < 8; ++i) v[h * 8 + i] = *(const f32x4*)(src + (size_t)(h * 32 + i) * ldw);
#pragma unroll
    for (int cc = 0; cc < 4; ++cc) {
        bf16_t* drow = dst + (size_t)rm(n0 + 4 * nq + cc) * ldd + k0 + kg * 8;
#pragma unroll
        for (int h = 0; h < 2; ++h) {
            u32x4 o; o.x = pk2(v[h * 8 + 0][cc], v[h * 8 + 1][cc]); o.y = pk2(v[h * 8 + 2][cc], v[h * 8 + 3][cc]); o.z = pk2(v[h * 8 + 4][cc], v[h * 8 + 5][cc]); o.w = pk2(v[h * 8 + 6][cc], v[h * 8 + 7][cc]);
            *(u32x4*)(drow + h * 32) = o;
        }
    }
}
struct RMPlain { __device__ __forceinline__ int operator()(int n) const { return n; } };
struct RMGateUp { int mat; __device__ __forceinline__ int operator()(int h) const { return (h >> 7) * 256 + ((h >> 6) & 1) * 128 + (((h >> 4) & 3) * 2 + mat) * 16 + (h & 15); } };
__device__ __forceinline__ void tr_plain(const float* W, int K, int N, bf16_t* dst, int item, int lane) {
    const int nb = N / 64, kb = item / nb, n0 = (item % nb) * 64;
    tr_item64(W, N, kb * 64, n0, dst, K, RMPlain{}, lane);
}
__device__ __forceinline__ void tr_expert(const float* Wg, const float* Wu, const float* Wd, bf16_t* gu, bf16_t* dn, int item, int lane) {
    if (item < 128) {
        const int mat = item >> 6, it = item & 63, kb = it >> 2, n0 = (it & 3) * 64;
        tr_item64(Wg + (size_t)mat * (Wu - Wg), DE, kb * 64, n0, gu, D, RMGateUp{mat}, lane);
    } else {
        const int it = item - 128, kb = it >> 4, n0 = (it & 15) * 64;
        tr_item64(Wd, D, kb * 64, n0, dn, DE, RMPlain{}, lane);
    }
}
struct Ctx {
    const Params& p; float* lds; ldsp_t smem;
    int tid, lane, wid, vb;
    __device__ __forceinline__ Ctx(const Params& p_, float* l, ldsp_t sm) : p(p_), lds(l), smem(sm) { tid = threadIdx.x; lane = tid & 63; wid = tid >> 6; vb = blockIdx.x; }
#define WSF(name, type, off) __device__ __forceinline__ type* name() const { return (type*)(p.ws + (off)); }
    WSF(cnt, unsigned, CTL_CNT) WSF(mod, float, CTL_MOD) WSF(rope, float, WS_ROPE) WSF(sum, float, WS_SUM)
    WSF(AE, int, WS_AE) WSF(AW, float, WS_AW) WSF(APOS, int, WS_APOS) WSF(LIST, int, WS_LIST) WSF(XC, float, WS_XC)
    WSF(H, bf16_t, WS_H) WSF(ACT, bf16_t, WS_ACT) WSF(ACTS, bf16_t, WS_ACTS) WSF(Y, bf16_t, WS_BIG)
    WSF(Qb, bf16_t, WS_Q) WSF(Kb, bf16_t, WS_K) WSF(Vb, bf16_t, WS_V) WSF(Ob, bf16_t, WS_O)
    WSF(WQKV, bf16_t, WS_WQKV) WSF(WO, bf16_t, WS_WO) WSF(WIN, bf16_t, WS_WIN) WSF(WOUT, bf16_t, WS_WOUT) WSF(WSH, bf16_t, WS_WSH) WSF(WMOE, bf16_t, WS_WMOE)
    WSF(WGATES, bf16_t, WS_WGATES) WSF(WROUTER, bf16_t, WS_WROUTER) WSF(LC8, float, WS_LC8) WSF(CARRY, float, WS_CARRY)
    WSF(G, bf16_t, WS_G) WSF(PU, bf16_t, WS_PU) WSF(HG, bf16_t, WS_G) WSF(AB, float, WS_AB) WSF(HS, float, WS_WMOE)
#undef WSF
};

__device__ __forceinline__ void ph_prep(Ctx& c) {
    const float* cv = c.p.in[1]; const float* cctx = c.p.in[3]; const float* aw = c.p.in[4]; const float* ab = c.p.in[5];
    float* sil = c.lds;
    float* red = c.lds + 5120;
    __syncthreads();
    for (int i = c.tid; i < 5 * 1024; i += NTHREADS) { const int r = i >> 10, k = i & 1023; const float v = r < 4 ? cv[r * 1024 + k] : cctx[k]; sil[i] = silu_f(v); }
    __syncthreads();
    for (int item = blockIdx.x; item < 2 * 96; item += gridDim.x) {
        const int l = item / 96, jb = item % 96, kq = c.tid >> 4, cq = c.tid & 15;
        f32x4 a0 = {0, 0, 0, 0}, a1 = a0, a2 = a0, a3 = a0, a4 = a0;
        const float* w = aw + ((size_t)l * 1024 + kq * 64) * 6144 + jb * 64 + cq * 4;
        const float* sl = sil + kq * 64;
#pragma unroll 8
        for (int k = 0; k < 64; ++k) { const f32x4 wv = *(const f32x4*)(w + (size_t)k * 6144); a0 += sl[k] * wv; a1 += sl[1024 + k] * wv; a2 += sl[2048 + k] * wv; a3 += sl[3072 + k] * wv; a4 += sl[4096 + k] * wv; }
        float* rr = red + kq * 320 + cq * 4;
        *(f32x4*)(rr) = a0; *(f32x4*)(rr + 64) = a1; *(f32x4*)(rr + 128) = a2; *(f32x4*)(rr + 192) = a3; *(f32x4*)(rr + 256) = a4;
        __syncthreads();
        for (int i = c.tid; i < 320; i += NTHREADS) {
            const int r = i >> 6, jj = i & 63;
            float v = 0.f;
#pragma unroll
            for (int q = 0; q < 16; ++q) v += red[q * 320 + i];
            c.mod()[((size_t)l * 5 + r) * 6144 + jb * 64 + jj] = v + ab[l * 6144 + jb * 64 + jj];
        }
        __syncthreads();
    }
    if (blockIdx.x == gridDim.x - 1) {
        for (int i = c.tid; i < 1024; i += NTHREADS) {
            const int pos = i >> 4, f = i & 15;
            const float inv = expf(-logf(10000.0f) * (float)f / 16.0f);
            const float ang = (float)pos * inv;
            c.rope()[i] = cosf(ang); c.rope()[1024 + i] = sinf(ang);
        }
    }
}


__device__ __forceinline__ int find_expert(const int* tp, int rt) {
    const int lane = threadIdx.x & 63;
    const unsigned long long m = __ballot(tp[lane] <= rt);
    const int e = tp[64] <= rt ? 64 : (int)__popcll(m) - 1;
    return __builtin_amdgcn_readfirstlane(e);
}


__device__ __forceinline__ void ph_convert_small(Ctx& c) {
    const int wu = __builtin_amdgcn_readfirstlane(c.wid);
    const int gw = blockIdx.x * 4 + wu, NGW = gridDim.x * 4;
    constexpr int I_QKV = 16 * 24, I_O = 16 * 16, I_IN = 16 * 40, I_OUT = 20 * 16, I_SH = 192, I_R = 16;
    constexpr int NIT = I_QKV + I_O + I_IN + I_OUT + 2 * I_SH + 2 * I_R;
    for (int it = gw; it < NIT; it += NGW) {
        int r = it;
        if (r < I_QKV) { tr_plain(c.p.in[8], 1024, 1536, c.WQKV(), r, c.lane); continue; } r -= I_QKV;
        if (r < I_O) { tr_plain(c.p.in[9], 1024, 1024, c.WO(), r, c.lane); continue; } r -= I_O;
        if (r < I_IN) { tr_plain(c.p.in[11], 1024, 2560, c.WIN(), r, c.lane); continue; } r -= I_IN;
        if (r < I_OUT) { tr_plain(c.p.in[19], 1280, 1024, c.WOUT(), r, c.lane); continue; } r -= I_OUT;
        if (r < 2 * I_SH) {
            const int l = r / I_SH; r %= I_SH;
            bf16_t* base = c.WSH() + (size_t)l * (WSH_LAYER / 2);
            tr_expert(c.p.in[25] + (size_t)l * D * DE, c.p.in[26] + (size_t)l * D * DE, c.p.in[27] + (size_t)l * DE * D, base, base + WSH_D / 2, r, c.lane);
            continue;
        }
        r -= 2 * I_SH;
        { const int l = r / I_R; r %= I_R; tr_plain(c.p.in[20] + (size_t)l * D * NE, D, NE, c.WROUTER() + (size_t)l * 128 * D, r, c.lane); }
    }
    for (int i = blockIdx.x * NTHREADS + c.tid; i < 2 * 64 * D / 8; i += gridDim.x * NTHREADS) { const int l = i / (64 * D / 8), o = i % (64 * D / 8); *(u32x4*)(c.WROUTER() + (size_t)l * 128 * D + 64 * D + (size_t)o * 8) = (u32x4){0u, 0u, 0u, 0u}; }
}
__device__ __forceinline__ void ph_convert_moe(Ctx& c, int layer) {
    const int wu = __builtin_amdgcn_readfirstlane(c.wid);
    const int gw = vblock() * 4 + wu, NGW = gridDim.x * 4;
    for (int it = gw; it < NE * 192; it += NGW) {
        const int e = it / 192, r = it % 192; const size_t eo = ((size_t)layer * NE + e) * D * DE;
        tr_expert(c.p.in[22] + eo, c.p.in[23] + eo, c.p.in[24] + eo, c.WMOE() + (size_t)e * 512 * 1024, c.WMOE() + WMOE_D / 2 + (size_t)e * 1024 * 256, r, c.lane);
    }
}
template <class Epi>
__device__ __forceinline__ void dense_gemm(Ctx& c, const bf16_t* A, int lda, int mtiles, const bf16_t* Bt, int K, int ntiles, const Epi& ep) {
    const RowPlain rp{A, lda};
    const int nItems = mtiles * ntiles;
    for (int item = vblock(); item < nItems; item += gridDim.x) {
        const int mt = item / ntiles, nt = item % ntiles;
        mfma_tile(c.smem, rp, Bt + (size_t)nt * 256 * K, K, ep, mt * 128, nt * 256);
    }
}
__device__ __forceinline__ void ph_qkv_m(Ctx& c) { const MEpiQKV ep{c.Qb(), c.Kb(), c.Vb(), c.rope()}; dense_gemm(c, c.H(), D, T0 / 128, c.WQKV(), D, QKVN / 256, ep); }
__device__ __forceinline__ void ph_oproj_m(Ctx& c) { const MEpiResid ep{c.p.in[0], c.p.in[2], c.p.out, c.XC(), c.mod(), 2}; dense_gemm(c, c.Ob(), D, T0 / 128, c.WO(), D, D / 256, ep); }
__device__ __forceinline__ void ph_inproj_m(Ctx& c) { const MEpiInProj ep{c.G(), c.PU()}; dense_gemm(c, c.H(), D, T0 / 128, c.WIN(), D, 2 * DR / 256, ep); }
__device__ __forceinline__ void ph_outproj_m(Ctx& c) { const MEpiResid ep{c.p.out, c.XC(), c.p.out, c.XC(), c.mod() + 5 * 6144, 2}; dense_gemm(c, c.HG(), DR, TL / 128, c.WOUT(), DR, D / 256, ep); }


__device__ __forceinline__ void moe_tables128(Ctx& c, int layer, int T, int* tbl) {
    __syncthreads();
    if (c.tid < 64) tbl[136 + c.tid] = (int)c.cnt()[layer * 64 + c.tid];
    __syncthreads();
    if (c.tid == 0) {
        int o = 0, t = 0;
        for (int e = 0; e < NE; ++e) { const int n = tbl[136 + e]; tbl[e] = o; tbl[65 + e] = t; o += n; t += (n + 127) >> 7; }
        tbl[64] = o; tbl[65 + 64] = t; tbl[65 + 65] = t + ((T + 127) >> 7);
    }
    __syncthreads();
}
struct RowGather { const bf16_t* H; const int* list; int n; bool shared;
    __device__ __forceinline__ const bf16_t* operator()(int r) const { if (r >= n) return H; const int tok = shared ? r : (list[r] >> 3); return H + (size_t)tok * D; } };
struct MEpiAct { bf16_t* act; int n;
    __device__ __forceinline__ void operator()(f32x4 (&acc)[4][8], ldsp_t wl, int rbase, int cbase, int lane) const {
        const int fr = lane & 15, fq = lane >> 4;
#pragma unroll
        for (int m = 0; m < 4; ++m)
#pragma unroll
            for (int q = 0; q < 4; ++q) { const f32x4 g = acc[m][2 * q], u = acc[m][2 * q + 1];
                ep_put4(wl, m * 16 + fr, q * 16 + fq * 4, silu_f(g[0]) * u[0], silu_f(g[1]) * u[1], silu_f(g[2]) * u[2], silu_f(g[3]) * u[3]); }
        bf16_t* base = act + (cbase >> 1);
#pragma unroll 2
        for (int i = 0; i < 8; ++i) {
            const int rl = 8 * i + (lane >> 3), ch = lane & 7, r = rbase + rl;
            const u32x4 v = *(const LAS u32x4*)(wl + rl * EPB + ch * 16);
            if (r < n) *(u32x4*)(base + (size_t)r * DE + ch * 8) = v;
        }
    }
};
__device__ __forceinline__ void ph_moe_gateup_m(Ctx& c, int layer, int T) {
    int* tbl = (int*)(c.smem + LDS_LRU_END + 16);
    moe_tables128(c, layer, T, tbl);
    const int* tp = tbl + 65; const int ntile = tp[65];
#pragma unroll 1
    for (int item = vblock(); item < ntile * 2; item += gridDim.x) {
        const int rt = item >> 1, nt = item & 1, e = find_expert(tp, rt), mt = rt - tp[e];
        const bool sh = e >= NE;
        const int n = sh ? T : tbl[136 + e];
        const RowGather rp{c.H(), c.LIST() + (size_t)(sh ? 0 : e) * T0, n, sh};
        const bf16_t* Bt = (sh ? c.WSH() + (size_t)layer * (WSH_LAYER / 2) : c.WMOE() + (size_t)e * 512 * 1024) + (size_t)nt * 256 * D;
        const MEpiAct ep{sh ? c.ACTS() : c.ACT() + (size_t)tbl[e] * DE, n};
        mfma_tile(c.smem, rp, Bt, D, ep, mt * 128, nt * 256);
    }
}
struct MEpiDown { bf16_t* Y; const int* list; const float* aw; int n; bool shared; float* xl; float* xc; const float* mod; int a_reg; float w_reg;
    __device__ __forceinline__ void operator()(f32x4 (&acc)[4][8], ldsp_t wl, int rbase, int cbase, int lane) const {
        const int fr = lane & 15, fq = lane >> 4;
        if (!shared) {
#pragma unroll
            for (int m = 0; m < 4; ++m) {
                const float w = __shfl(w_reg, m * 16 + fr);
#pragma unroll
                for (int nn = 0; nn < 8; ++nn) ep_put4(wl, m * 16 + fr, nn * 16 + fq * 4, w * acc[m][nn][0], w * acc[m][nn][1], w * acc[m][nn][2], w * acc[m][nn][3]);
            }
#pragma unroll 2
            for (int i = 0; i < 16; ++i) {
                const int rl = 4 * i + (lane >> 4), ch = lane & 15, r = rbase + rl;
                const u32x4 v = *(const LAS u32x4*)(wl + rl * EPB + ch * 16);
                const int a = __shfl(a_reg, rl);
                if (r < n) *(u32x4*)(Y + (size_t)a * D + cbase + ch * 8) = v;
            }
        } else {
#pragma unroll
            for (int half = 0; half < 2; ++half) {
#pragma unroll
                for (int mm = 0; mm < 2; ++mm)
#pragma unroll
                    for (int nn = 0; nn < 8; ++nn) *(LAS f32x4*)(wl + (mm * 16 + fr) * EPF + (nn * 16 + fq * 4) * 4) = acc[half * 2 + mm][nn];
#pragma unroll 2
                for (int i = 0; i < 16; ++i) {
                    const int rl = 2 * i + (lane >> 5), c4 = (lane & 31) * 4, r = rbase + half * 32 + rl;
                    const f32x4 v = *(const LAS f32x4*)(wl + rl * EPF + c4 * 4);
                    if (r < n) {
                        const f32x4 gv = *(const f32x4*)(mod + mod_row(r) * 6144 + 5 * 1024 + cbase + c4);
                        float* d = (r < TL ? xl + (size_t)r * D : xc + (size_t)(r - TL) * D) + cbase + c4;
                        *(f32x4*)d += gv * v;
                    }
                }
            }
        }
    }
};
__device__ __forceinline__ void ph_moe_down_m(Ctx& c, int layer, int T) {
    int* tbl = (int*)(c.smem + LDS_LRU_END + 16);
    moe_tables128(c, layer, T, tbl);
    const int* tp = tbl + 65; const int ntile = tp[65];
    const float* modl = c.mod() + (size_t)layer * 5 * 6144;
#pragma unroll 1
    for (int item = vblock(); item < ntile * 4; item += gridDim.x) {
        const int rt = item >> 2, nt = item & 3, e = find_expert(tp, rt), mt = rt - tp[e];
        const bool sh = e >= NE;
        const int n = sh ? T : tbl[136 + e];
        const RowPlain rp{sh ? c.ACTS() : c.ACT() + (size_t)tbl[e] * DE, DE};
        const bf16_t* Bt = (sh ? c.WSH() + (size_t)layer * (WSH_LAYER / 2) + WSH_D / 2 : c.WMOE() + WMOE_D / 2 + (size_t)e * 1024 * 256) + (size_t)nt * 256 * DE;
        int a_reg = 0; float w_reg = 0.f;
        if (!sh) { const int rr = mt * 128 + (__builtin_amdgcn_readfirstlane(c.tid >> 6) >> 1) * 64 + c.lane; if (rr < n) { a_reg = c.LIST()[(size_t)e * T0 + rr]; w_reg = c.AW()[a_reg]; } }
        const MEpiDown ep{c.Y(), c.LIST() + (size_t)(sh ? 0 : e) * T0, c.AW(), n, sh, c.p.out, c.XC(), modl, a_reg, w_reg};
        mfma_tile(c.smem, rp, Bt, DE, ep, mt * 128, nt * 256);
    }
}


constexpr int NCH = 68;
constexpr int LU_PITCH = 104;
__device__ __forceinline__ float fast_sigmoid(float x) { return __builtin_amdgcn_rcpf(1.f + __builtin_amdgcn_exp2f(-LOG2E * x)); }
__device__ __forceinline__ void ph_convert_gates(Ctx& c) {
    const int NT = gridDim.x * NTHREADS, g0 = blockIdx.x * NTHREADS + c.tid;
    for (int i = g0; i < 2 * 2 * NBLK * BW * 96; i += NT) {
        const int k = i % 96, col = (i / 96) % BW, n = (i / (96 * BW)) % NBLK, mat = (i / (96 * BW * NBLK)) & 1, d = i / (96 * BW * NBLK * 2);
        const float* w = (mat ? c.p.in[16] : c.p.in[14]) + (((size_t)d * NBLK + n) * BW) * BW;
        c.WGATES()[i] = k < BW ? f2bf(w[(size_t)k * BW + col]) : (bf16_t)0;
    }
    for (int i = g0; i < 2 * DR; i += NT) c.LC8()[i] = 8.0f * LOG2E * log1pf(expf(-c.p.in[18][i]));
}
constexpr int L2_U = 0, L2_RAW = 13312, L2_OUT = L2_RAW + 10752, L2_END = L2_OUT + 2 * 64 * BW * 4;
template <bool REV, int PASS>
__device__ __forceinline__ void lru_scan16(const float (&a)[4][4], const float (&b)[4][4], float& cm, float& ptot, float (&h)[4][4], int lane, int fq) {
    const int l16 = REV ? ((lane + 16) & 63) : ((lane - 16) & 63), l32 = REV ? ((lane + 32) & 63) : ((lane - 32) & 63);
    const int ltot = (lane & 15) + (REV ? 0 : 48);
    float P[4], H[4], Pe[4], He[4], Pt[4], Ht[4];
#pragma unroll
    for (int m = 0; m < 4; ++m) {
        P[m] = 1.f; H[m] = 0.f;
#pragma unroll
        for (int jj = 0; jj < 4; ++jj) { const int j = REV ? 3 - jj : jj; H[m] = a[m][j] * H[m] + b[m][j]; P[m] *= a[m][j]; }
    }
    {   float Pp[4], Hp[4];
#pragma unroll
        for (int m = 0; m < 4; ++m) { Pp[m] = __shfl(P[m], l16); Hp[m] = __shfl(H[m], l16); }
#pragma unroll
        for (int m = 0; m < 4; ++m) if (REV ? (fq <= 2) : (fq >= 1)) { H[m] = P[m] * Hp[m] + H[m]; P[m] = P[m] * Pp[m]; }
#pragma unroll
        for (int m = 0; m < 4; ++m) { Pp[m] = __shfl(P[m], l32); Hp[m] = __shfl(H[m], l32); }
#pragma unroll
        for (int m = 0; m < 4; ++m) if (REV ? (fq <= 1) : (fq >= 2)) { H[m] = P[m] * Hp[m] + H[m]; P[m] = P[m] * Pp[m]; }
    }
#pragma unroll
    for (int m = 0; m < 4; ++m) { Pe[m] = __shfl(P[m], l16); He[m] = __shfl(H[m], l16); Pt[m] = __shfl(P[m], ltot); Ht[m] = __shfl(H[m], ltot); }
#pragma unroll
    for (int m = 0; m < 4; ++m) if (REV ? (fq == 3) : (fq == 0)) { Pe[m] = 1.f; He[m] = 0.f; }
#pragma unroll
    for (int mm = 0; mm < 4; ++mm) {
        const int m = REV ? 3 - mm : mm;
        const float hin = Pe[m] * cm + He[m];
        cm = Pt[m] * cm + Ht[m]; ptot *= Pt[m];
        if (PASS == 2) {
            float hh = hin;
#pragma unroll
            for (int jj = 0; jj < 4; ++jj) { const int j = REV ? 3 - jj : jj; hh = a[m][j] * hh + b[m][j]; h[m][j] = hh; }
        }
    }
}
template <int PASS>
__device__ __forceinline__ void ph_lru_pass(Ctx& c) {
    const int wu = __builtin_amdgcn_readfirstlane(c.wid), lane = c.lane, fr = lane & 15, fq = lane >> 4;
    const int dir = wu >> 1, nt0 = (wu & 1) ? 3 : 0, nnt = (wu & 1) ? 2 : 3;
    constexpr int NC = PASS == 1 ? NCH : 64;
    const float* cw = c.p.in[12]; const float* cb = c.p.in[13];
#pragma unroll 1
    for (int unit = vblock(); unit < NB * NC * NBLK; unit += gridDim.x) {
        const int n = unit % NBLK, cidx = (unit / NBLK) % NC + (PASS == 1 ? 0 : 4), b = unit / (NBLK * NC);
        int r0, seq0, seqn;
        if (cidx < 4) { seq0 = TL + b * C; seqn = C; r0 = seq0 + cidx * 64; } else { seq0 = b * S; seqn = S; r0 = seq0 + (cidx - 4) * 64; }
        __syncthreads();
        for (int idx = c.tid; idx < 67 * 10; idx += NTHREADS) {
            const int row = idx / 10, c8i = idx % 10, rr = r0 - 2 + row;
            u32x4 v = (u32x4){0u, 0u, 0u, 0u};
            if (rr >= seq0 && rr < seq0 + seqn) v = *(const u32x4*)(c.PU() + (size_t)rr * DR + n * BW + c8i * 8);
            *(LAS u32x4*)(c.smem + L2_RAW + row * 160 + c8i * 16) = v;
        }
        __syncthreads();
        for (int idx = c.tid; idx < 64 * 20; idx += NTHREADS) {
            const int t = idx / 20, c4 = (idx % 20) * 4, ch = n * BW + c4;
            float u0 = cb[ch], u1 = cb[ch + 1], u2 = cb[ch + 2], u3 = cb[ch + 3];
#pragma unroll
            for (int j = 0; j < 4; ++j) {
                const u32x2 raw = *(const LAS u32x2*)(c.smem + L2_RAW + (t + j) * 160 + c4 * 2);
                const float4 w = *(const float4*)(cw + j * DR + ch);
                u0 += w.x * __uint_as_float(raw.x << 16); u1 += w.y * __uint_as_float(raw.x & 0xffff0000u);
                u2 += w.z * __uint_as_float(raw.y << 16); u3 += w.w * __uint_as_float(raw.y & 0xffff0000u);
            }
            u32x2 o; o.x = pk2(u0, u1); o.y = pk2(u2, u3);
            *(LAS u32x2*)(c.smem + L2_U + (t * LU_PITCH + c4) * 2) = o;
        }
        for (int idx = c.tid; idx < 64 * 3; idx += NTHREADS) { const int t = idx / 3, q = idx % 3; *(LAS u32x4*)(c.smem + L2_U + (t * LU_PITCH + 80 + q * 8) * 2) = (u32x4){0u, 0u, 0u, 0u}; }
        __syncthreads();
        bf16x8 af[4][3];
#pragma unroll
        for (int m = 0; m < 4; ++m)
#pragma unroll
            for (int ks = 0; ks < 3; ++ks) af[m][ks] = *(const LAS bf16x8*)(c.smem + L2_U + (16 * m + fr) * (LU_PITCH * 2) + (ks * 32 + fq * 8) * 2);
        const bf16_t* wbase = c.WGATES() + ((((size_t)dir * 2) * NBLK + n) * BW + fr) * 96 + fq * 8;
        bf16x8 bcur[2][3];
#pragma unroll
        for (int mat = 0; mat < 2; ++mat)
#pragma unroll
            for (int ks = 0; ks < 3; ++ks) bcur[mat][ks] = *(const bf16x8*)(wbase + (size_t)mat * NBLK * BW * 96 + nt0 * 16 * 96 + ks * 32);
#pragma unroll 1
        for (int i = 0; i < nnt; ++i) {
            const int nt = nt0 + i, cl = nt * 16 + fr, ch = n * BW + cl;
            const float bav = c.p.in[15][dir * DR + ch], bxv = c.p.in[17][dir * DR + ch], c8v = c.LC8()[dir * DR + ch];
            float cm = PASS == 1 ? 0.f : c.CARRY()[((size_t)(b * 2 + dir) * NCH + cidx) * DR + ch], ptot = 1.f;
            f32x4 acc[2][4];
#pragma unroll
            for (int mat = 0; mat < 2; ++mat)
#pragma unroll
                for (int m = 0; m < 4; ++m) {
                    acc[mat][m] = (f32x4){0.f, 0.f, 0.f, 0.f};
#pragma unroll
                    for (int ks = 0; ks < 3; ++ks) acc[mat][m] = __builtin_amdgcn_mfma_f32_16x16x32_bf16(af[m][ks], bcur[mat][ks], acc[mat][m], 0, 0, 0);
                }
            if (i + 1 < nnt) {
#pragma unroll
                for (int mat = 0; mat < 2; ++mat)
#pragma unroll
                    for (int ks = 0; ks < 3; ++ks) bcur[mat][ks] = *(const bf16x8*)(wbase + (size_t)mat * NBLK * BW * 96 + (nt + 1) * 16 * 96 + ks * 32);
            }
            float av[4][4], bv[4][4], hv[4][4];
#pragma unroll
            for (int m = 0; m < 4; ++m)
#pragma unroll
                for (int j = 0; j < 4; ++j) {
                    const int t = 16 * m + fq * 4 + j;
                    const float r = fast_sigmoid(acc[0][m][j] + bav), ig = fast_sigmoid(acc[1][m][j] + bxv);
                    const float a = __builtin_amdgcn_exp2f(-c8v * r);
                    const float uv = bf2f(*(const LAS bf16_t*)(c.smem + L2_U + (t * LU_PITCH + cl) * 2));
                    av[m][j] = a; bv[m][j] = __builtin_amdgcn_sqrtf(fmaxf(1.f - a * a, 0.f)) * (ig * uv);
                }
            if (dir == 0) lru_scan16<false, PASS>(av, bv, cm, ptot, hv, lane, fq); else lru_scan16<true, PASS>(av, bv, cm, ptot, hv, lane, fq);
            if (PASS == 1) {
                if (fq == 0) { float* sp = c.sum() + (((size_t)(b * 2 + dir) * NCH + cidx) * 2) * DR + ch; sp[0] = ptot; sp[DR] = cm; }
            } else {
#pragma unroll
                for (int m = 0; m < 4; ++m)
#pragma unroll
                    for (int j = 0; j < 4; ++j) *(LAS float*)(c.smem + L2_OUT + ((dir * 64 + 16 * m + fq * 4 + j) * BW + cl) * 4) = hv[m][j];
            }
        }
        if (PASS == 2) {
            __syncthreads();
            for (int idx = c.tid; idx < 64 * 20; idx += NTHREADS) {
                const int t = idx / 20, c4 = (idx % 20) * 4;
                const f32x4 h0 = *(const LAS f32x4*)(c.smem + L2_OUT + (t * BW + c4) * 4), h1 = *(const LAS f32x4*)(c.smem + L2_OUT + ((64 + t) * BW + c4) * 4);
                bf16_t* gp = c.G() + (size_t)(r0 + t) * DR + n * BW + c4;
                const uint2 g = *(const uint2*)gp;
                st_bf16x4(gp, (h0[0] + h1[0]) * __uint_as_float(g.x << 16), (h0[1] + h1[1]) * __uint_as_float(g.x & 0xffff0000u),
                          (h0[2] + h1[2]) * __uint_as_float(g.y << 16), (h0[3] + h1[3]) * __uint_as_float(g.y & 0xffff0000u));
            }
        }
    }
}
__device__ __forceinline__ void ph_lru_carry(Ctx& c) {
    for (int i = blockIdx.x * NTHREADS + c.tid; i < NB * 2 * DR; i += gridDim.x * NTHREADS) {
        const int ch = i % DR, d = (i / DR) & 1, b = i / (2 * DR);
        const float* sp = c.sum() + ((size_t)(b * 2 + d) * NCH * 2) * DR + ch; float* cp = c.CARRY() + ((size_t)(b * 2 + d) * NCH) * DR + ch;
        float h = 0.f;
        if (d == 0) {
#pragma unroll 4
            for (int k = 0; k < NCH; ++k) { cp[(size_t)k * DR] = h; h = sp[(size_t)k * 2 * DR] * h + sp[(size_t)k * 2 * DR + DR]; }
        } else {
#pragma unroll 4
            for (int k = 3; k >= 0; --k) { cp[(size_t)k * DR] = h; h = sp[(size_t)k * 2 * DR] * h + sp[(size_t)k * 2 * DR + DR]; }
#pragma unroll 4
            for (int k = NCH - 1; k >= 4; --k) { cp[(size_t)k * DR] = h; h = sp[(size_t)k * 2 * DR] * h + sp[(size_t)k * 2 * DR + DR]; }
        }
    }
}


typedef float f32x16 __attribute__((ext_vector_type(16)));
typedef short s16x4 __attribute__((ext_vector_type(4)));
__device__ __forceinline__ s16x4 vtr(const LAS unsigned char* p) { return __builtin_bit_cast(s16x4, __builtin_amdgcn_ds_read_tr16_b64_v4i16((LAS s16x4*)p)); }
constexpr int AT_BUF = 16384;
__device__ __forceinline__ void ph_attn_m(Ctx& c) {
    const int tid = c.tid, lane = c.lane, wu = __builtin_amdgcn_readfirstlane(c.wid), r32 = lane & 31, hi = lane >> 5;
    const float* sinkp = c.p.in[10];
    const int NU = NB * 32 * NH + NB * 2 * NH;
#pragma unroll 1
    for (int unit = vblock(); unit < NU; unit += gridDim.x) {
        int b, qb, h, q0, nt, ilo;
        bool lat = unit < NB * 32 * NH;
        if (lat) { h = unit & 15; qb = (unit >> 4) & 31; b = unit >> 9; q0 = b * S + qb * 128; ilo = (qb == 0) ? 2 : 0; const int ihi = (qb == 31) ? 3 : 5; nt = 4 + (ihi - ilo + 1); }
        else { const int u2 = unit - NB * 32 * NH; h = u2 & 15; qb = (u2 >> 4) & 1; b = u2 >> 5; q0 = TL + b * C + qb * 128; ilo = 0; nt = 4; }
        const int g = h >> 2;
        const bf16_t* kbase = c.Kb() + (size_t)lane * KD + g * 64 + (2 * wu) * 8;
        const bf16_t* vbase = c.Vb() + (size_t)(16 * wu + (lane >> 2)) * KD + g * 64 + (lane & 3) * 8;
#define AT_STAGE(buf, kr0) do { \
        __builtin_amdgcn_global_load_lds((const unsigned*)(kbase + (size_t)(kr0) * KD), (LAS unsigned*)(c.smem + (buf) * AT_BUF + (2 * wu) * 1024), 16, 0, 0); \
        __builtin_amdgcn_global_load_lds((const unsigned*)(kbase + (size_t)(kr0) * KD + 8), (LAS unsigned*)(c.smem + (buf) * AT_BUF + (2 * wu + 1) * 1024), 16, 0, 0); \
        __builtin_amdgcn_global_load_lds((const unsigned*)(vbase + (size_t)(kr0) * KD), (LAS unsigned*)(c.smem + (buf) * AT_BUF + 8192 + wu * 1024), 16, 0, 0); \
        __builtin_amdgcn_global_load_lds((const unsigned*)(vbase + (size_t)(kr0) * KD + 32), (LAS unsigned*)(c.smem + (buf) * AT_BUF + 8192 + 4096 + wu * 1024), 16, 0, 0); } while (0)
#define AT_KR0(j) ((j) < 4 ? (TL + b * C + (j) * 64) : (b * S + qb * 128 - 128 + 64 * (ilo + (j) - 4)))
        bf16x8 qr[4];
        { const bf16_t* qp = c.Qb() + (size_t)(q0 + 32 * wu + r32) * 1024 + h * 64 + hi * 8;
#pragma unroll
          for (int ds = 0; ds < 4; ++ds) qr[ds] = *(const bf16x8*)(qp + ds * 16); }
        float m = sinkp[h] * LOG2E, l = hi == 0 ? 1.f : 0.f;
        f32x16 o0, o1;
#pragma unroll
        for (int r = 0; r < 16; ++r) { o0[r] = 0.f; o1[r] = 0.f; }
        const int qi = 32 * wu + r32;
        const int vaddr = ((lane >> 4) & 1) * 32 + (lane & 3) * 8 + (4 * hi + ((lane & 15) >> 2)) * 64;
        __syncthreads();
        AT_STAGE(0, AT_KR0(0));
        AT_STAGE(1, AT_KR0(1));
        AT_STAGE(2, AT_KR0(2));
#pragma unroll 1
        for (int j = 0; j < nt; ++j) {
            if (j + 2 < nt) asm volatile("s_waitcnt vmcnt(8)" ::: "memory");
            else if (j + 1 < nt) asm volatile("s_waitcnt vmcnt(4)" ::: "memory");
            else asm volatile("s_waitcnt vmcnt(0)" ::: "memory");
            __builtin_amdgcn_s_barrier();
            asm volatile("" ::: "memory");
            if (j + 3 < nt) { const int kr1 = AT_KR0(j + 3); AT_STAGE((j + 3) & 3, kr1); }
            const ldsp_t kb = c.smem + (j & 3) * AT_BUF, vb = kb + 8192;
            f32x16 p0, p1;
#pragma unroll
            for (int r = 0; r < 16; ++r) { p0[r] = 0.f; p1[r] = 0.f; }
#pragma unroll
            for (int ds = 0; ds < 4; ++ds) {
                const bf16x8 k0 = *(const LAS bf16x8*)(kb + (ds * 2 + hi) * 1024 + r32 * 16);
                const bf16x8 k1 = *(const LAS bf16x8*)(kb + (ds * 2 + hi) * 1024 + (32 + r32) * 16);
                p0 = __builtin_amdgcn_mfma_f32_32x32x16_bf16(k0, qr[ds], p0, 0, 0, 0);
                p1 = __builtin_amdgcn_mfma_f32_32x32x16_bf16(k1, qr[ds], p1, 0, 0, 0);
            }
            if (lat && j >= 4) {
                const int i = ilo + j - 4;
                if (i < 2 || i > 3) {
                    const int kj0 = 64 * i + 4 * hi;
#pragma unroll
                    for (int r = 0; r < 16; ++r) {
                        const int kj = kj0 + (r & 3) + 8 * (r >> 2);
                        if (kj < qi || kj > qi + 256) p0[r] = -INFINITY;
                        if (kj + 32 < qi || kj + 32 > qi + 256) p1[r] = -INFINITY;
                    }
                }
            }
            float mx = fmaxf(p0[0], p1[0]);
#pragma unroll
            for (int r = 1; r < 16; ++r) mx = fmaxf(mx, fmaxf(p0[r], p1[r]));
            mx = fmaxf(mx, __shfl_xor(mx, 32));
            const float mn = fmaxf(m, mx);
            const float alpha = __builtin_amdgcn_exp2f(m - mn);
            m = mn;
            float ls = 0.f;
#pragma unroll
            for (int r = 0; r < 16; ++r) { p0[r] = __builtin_amdgcn_exp2f(p0[r] - mn); p1[r] = __builtin_amdgcn_exp2f(p1[r] - mn); ls += p0[r] + p1[r]; }
            l = l * alpha + ls;
            if (__any(alpha != 1.f)) {
#pragma unroll
                for (int r = 0; r < 16; ++r) { o0[r] *= alpha; o1[r] *= alpha; }
            }
#pragma unroll
            for (int sub = 0; sub < 2; ++sub)
#pragma unroll
                for (int sk = 0; sk < 2; ++sk) {
                    u32x4 pw;
                    if (sub == 0) { pw.x = pk2(p0[8 * sk + 0], p0[8 * sk + 1]); pw.y = pk2(p0[8 * sk + 2], p0[8 * sk + 3]); pw.z = pk2(p0[8 * sk + 4], p0[8 * sk + 5]); pw.w = pk2(p0[8 * sk + 6], p0[8 * sk + 7]); }
                    else { pw.x = pk2(p1[8 * sk + 0], p1[8 * sk + 1]); pw.y = pk2(p1[8 * sk + 2], p1[8 * sk + 3]); pw.z = pk2(p1[8 * sk + 4], p1[8 * sk + 5]); pw.w = pk2(p1[8 * sk + 6], p1[8 * sk + 7]); }
                    const bf16x8 pf = __builtin_bit_cast(bf16x8, pw);
                    const int ko = (sub * 32 + sk * 16) * 64;
                    const s16x4 a0 = vtr(vb + vaddr + ko), a1 = vtr(vb + vaddr + ko + 512);
                    const s16x4 b0 = vtr(vb + 4096 + vaddr + ko), b1 = vtr(vb + 4096 + vaddr + ko + 512);
                    const bf16x8 vf0 = (bf16x8){a0[0], a0[1], a0[2], a0[3], a1[0], a1[1], a1[2], a1[3]};
                    const bf16x8 vf1 = (bf16x8){b0[0], b0[1], b0[2], b0[3], b1[0], b1[1], b1[2], b1[3]};
                    o0 = __builtin_amdgcn_mfma_f32_32x32x16_bf16(vf0, pf, o0, 0, 0, 0);
                    o1 = __builtin_amdgcn_mfma_f32_32x32x16_bf16(vf1, pf, o1, 0, 0, 0);
                }
        }
#undef AT_STAGE
#undef AT_KR0
        l += __shfl_xor(l, 32);
        const float rl = 1.f / l;
        bf16_t* op = c.Ob() + (size_t)(q0 + qi) * 1024 + h * 64 + 4 * hi;
#pragma unroll
        for (int g4 = 0; g4 < 4; ++g4) {
            st_bf16x4(op + 8 * g4, o0[4 * g4] * rl, o0[4 * g4 + 1] * rl, o0[4 * g4 + 2] * rl, o0[4 * g4 + 3] * rl);
            st_bf16x4(op + 32 + 8 * g4, o1[4 * g4] * rl, o1[4 * g4 + 1] * rl, o1[4 * g4 + 2] * rl, o1[4 * g4 + 3] * rl);
        }
    }
}


struct Row16 { float v[2][8]; };
__device__ __forceinline__ void row_load(Row16& x, const float* src, int lane) {
#pragma unroll
    for (int j = 0; j < 2; ++j) { const f32x4 a = *(const f32x4*)(src + j * 512 + lane * 8), b = *(const f32x4*)(src + j * 512 + lane * 8 + 4);
        x.v[j][0] = a[0]; x.v[j][1] = a[1]; x.v[j][2] = a[2]; x.v[j][3] = a[3]; x.v[j][4] = b[0]; x.v[j][5] = b[1]; x.v[j][6] = b[2]; x.v[j][7] = b[3]; }
}
__device__ __forceinline__ void row_store(const Row16& x, float* dst, int lane) {
#pragma unroll
    for (int j = 0; j < 2; ++j) { *(f32x4*)(dst + j * 512 + lane * 8) = (f32x4){x.v[j][0], x.v[j][1], x.v[j][2], x.v[j][3]}; *(f32x4*)(dst + j * 512 + lane * 8 + 4) = (f32x4){x.v[j][4], x.v[j][5], x.v[j][6], x.v[j][7]}; }
}
__device__ __forceinline__ float row_rinv(const Row16& x) {
    float ss = 0.f;
#pragma unroll
    for (int j = 0; j < 2; ++j)
#pragma unroll
        for (int e = 0; e < 8; ++e) ss += x.v[j][e] * x.v[j][e];
    return rsqrtf(wave_sum(ss) * (1.0f / D) + RMS_EPS);
}
__device__ __forceinline__ void row_normmod_store(const Row16& x, float rinv, const float* g, const float* shift, const float* scale, bf16_t* dst, int lane) {
#pragma unroll
    for (int j = 0; j < 2; ++j) {
        const int k = j * 512 + lane * 8; float h[8];
#pragma unroll
        for (int q = 0; q < 2; ++q) { const f32x4 gv = *(const f32x4*)(g + k + 4 * q), sh = *(const f32x4*)(shift + k + 4 * q), sc = *(const f32x4*)(scale + k + 4 * q);
#pragma unroll
            for (int e = 0; e < 4; ++e) h[4 * q + e] = (x.v[j][4 * q + e] * rinv * gv[e]) * (1.f + sc[e]) + sh[e]; }
        u32x4 o; o.x = pk2(h[0], h[1]); o.y = pk2(h[2], h[3]); o.z = pk2(h[4], h[5]); o.w = pk2(h[6], h[7]);
        *(u32x4*)(dst + k) = o;
    }
}
__device__ __forceinline__ void row_combine(Row16& x, const bf16_t* Y, int r, const float* g2, int lane) {
#pragma unroll
    for (int j = 0; j < 2; ++j) {
        const int k = j * 512 + lane * 8; float s[8];
#pragma unroll
        for (int e = 0; e < 8; ++e) s[e] = 0.f;
#pragma unroll
        for (int kk = 0; kk < TOPK; ++kk) { const u32x4 y = *(const u32x4*)(Y + ((size_t)r * 8 + kk) * D + k);
            s[0] += __uint_as_float(y.x << 16); s[1] += __uint_as_float(y.x & 0xffff0000u); s[2] += __uint_as_float(y.y << 16); s[3] += __uint_as_float(y.y & 0xffff0000u);
            s[4] += __uint_as_float(y.z << 16); s[5] += __uint_as_float(y.z & 0xffff0000u); s[6] += __uint_as_float(y.w << 16); s[7] += __uint_as_float(y.w & 0xffff0000u); }
        const f32x4 ga = *(const f32x4*)(g2 + k), gb = *(const f32x4*)(g2 + k + 4);
#pragma unroll
        for (int e = 0; e < 4; ++e) { x.v[j][e] += ga[e] * s[e]; x.v[j][4 + e] += gb[e] * s[4 + e]; }
    }
}
__device__ __forceinline__ float* xrow_ptr(Ctx& c, int r) { return r < TL ? c.p.out + (size_t)r * D : c.XC() + (size_t)(r - TL) * D; }
__device__ __forceinline__ void ph_norm1_l0_w(Ctx& c) {
    const float* g = c.p.in[6]; constexpr int RB = 2;
    for (int r0 = (blockIdx.x * 4 + c.wid) * RB; r0 < T0; r0 += gridDim.x * 4 * RB) {
        Row16 x[RB];
#pragma unroll
        for (int i = 0; i < RB; ++i) { const int r = r0 + i; row_load(x[i], r < TL ? c.p.in[0] + (size_t)r * D : c.p.in[2] + (size_t)(r - TL) * D, c.lane); }
#pragma unroll
        for (int i = 0; i < RB; ++i) { const int r = r0 + i; const float* m = c.mod() + mod_row(r) * 6144;
            row_normmod_store(x[i], row_rinv(x[i]), g, m, m + 1024, c.H() + (size_t)r * D, c.lane); }
    }
}
__device__ __forceinline__ void ph_norm2_w(Ctx& c, int layer) {
    const int T = layer == 0 ? T0 : TL; const float* g = c.p.in[7] + layer * D; constexpr int RB = 2;
    for (int r0 = (blockIdx.x * 4 + c.wid) * RB; r0 < T; r0 += gridDim.x * 4 * RB) {
        Row16 x[RB];
#pragma unroll
        for (int i = 0; i < RB; ++i) row_load(x[i], xrow_ptr(c, r0 + i), c.lane);
#pragma unroll
        for (int i = 0; i < RB; ++i) { const int r = r0 + i; const float* m = c.mod() + ((size_t)layer * 5 + mod_row(r)) * 6144;
            row_normmod_store(x[i], row_rinv(x[i]), g, m + 3 * 1024, m + 4 * 1024, c.H() + (size_t)r * D, c.lane); }
    }
}
__device__ __forceinline__ void ph_combine_norm1_w(Ctx& c) {
    const float* g = c.p.in[6] + D; constexpr int RB = 1;
    for (int r0 = (blockIdx.x * 4 + c.wid) * RB; r0 < T0; r0 += gridDim.x * 4 * RB) {
        Row16 x[RB];
#pragma unroll
        for (int i = 0; i < RB; ++i) row_load(x[i], xrow_ptr(c, r0 + i), c.lane);
#pragma unroll
        for (int i = 0; i < RB; ++i) row_combine(x[i], c.Y(), r0 + i, c.mod() + (size_t)mod_row(r0 + i) * 6144 + 5 * 1024, c.lane);
#pragma unroll
        for (int i = 0; i < RB; ++i) { const int r = r0 + i; row_store(x[i], xrow_ptr(c, r), c.lane);
            const float* m = c.mod() + ((size_t)5 + mod_row(r)) * 6144;
            row_normmod_store(x[i], row_rinv(x[i]), g, m, m + 1024, c.H() + (size_t)r * D, c.lane); }
    }
}
__device__ __forceinline__ void ph_final_w(Ctx& c) {
    const float* g = c.p.in[28]; constexpr int RB = 1;
    for (int r0 = (blockIdx.x * 4 + c.wid) * RB; r0 < TL; r0 += gridDim.x * 4 * RB) {
        Row16 x[RB];
#pragma unroll
        for (int i = 0; i < RB; ++i) row_load(x[i], c.p.out + (size_t)(r0 + i) * D, c.lane);
#pragma unroll
        for (int i = 0; i < RB; ++i) row_combine(x[i], c.Y(), r0 + i, c.mod() + ((size_t)5 + mod_row(r0 + i)) * 6144 + 5 * 1024, c.lane);
#pragma unroll
        for (int i = 0; i < RB; ++i) {
            const float rinv = row_rinv(x[i]);
#pragma unroll
            for (int j = 0; j < 2; ++j) { const int k = j * 512 + c.lane * 8; const f32x4 ga = *(const f32x4*)(g + k), gb = *(const f32x4*)(g + k + 4);
#pragma unroll
                for (int e = 0; e < 4; ++e) { x[i].v[j][e] = x[i].v[j][e] * rinv * ga[e]; x[i].v[j][4 + e] = x[i].v[j][4 + e] * rinv * gb[e]; } }
            row_store(x[i], c.p.out + (size_t)(r0 + i) * D, c.lane);
        }
    }
}
struct MEpiRouter { ldsp_t lg;
    __device__ __forceinline__ void operator()(f32x4 (&acc)[4][8], ldsp_t wl, int rbase, int cbase, int lane) const {
        const int fr = lane & 15, fq = lane >> 4, rl = (rbase & 127);
#pragma unroll
        for (int m = 0; m < 4; ++m)
#pragma unroll
            for (int n = 0; n < 2; ++n)
#pragma unroll
                for (int j = 0; j < 4; ++j) *(LAS float*)(lg + ((rl + m * 16 + fr) * 65 + cbase + n * 16 + fq * 4 + j) * 4) = acc[m][n][j];
        __syncthreads();
    }
};
__device__ __forceinline__ void ph_route_m(Ctx& c, int layer) {
    const int T = layer == 0 ? T0 : TL;
    const RowPlain rp{c.H(), D};
    const MEpiRouter ep{c.smem};
    LAS float* bias = (LAS float*)(c.smem + 128 * 65 * 4);
    for (int mt = vblock(); mt < T / 128; mt += gridDim.x) {
        router_tile(c.smem, c.H(), c.WROUTER() + (size_t)layer * 128 * D, D, ep, mt * 128);
        if (c.tid < NE) bias[c.tid] = c.p.in[21][layer * NE + c.tid];
        __syncthreads();
        if (c.tid < 128) {
            LAS float* sc = (LAS float*)c.smem + c.tid * 65;
            for (int e = 0; e < NE; ++e) sc[e] = fast_sigmoid(sc[e]);
            unsigned gmask = 0; float gs[8];
#pragma unroll
            for (int g = 0; g < 8; ++g) {
                float m1 = -INFINITY, m2 = -INFINITY;
#pragma unroll
                for (int i = 0; i < 8; ++i) { const float v = sc[g * 8 + i] + bias[g * 8 + i]; if (v > m1) { m2 = m1; m1 = v; } else if (v > m2) m2 = v; }
                gs[g] = m1 + m2;
            }
#pragma unroll
            for (int it = 0; it < 4; ++it) {
                float best = -INFINITY; int bi = 0;
#pragma unroll
                for (int g = 0; g < 8; ++g) { const bool used = (gmask >> g) & 1u; if (!used && gs[g] > best) { best = gs[g]; bi = g; } }
                gmask |= 1u << bi;
            }
            unsigned long long used = 0ull; float wsum = 0.f; int se[TOPK]; float ss[TOPK];
#pragma unroll
            for (int it = 0; it < TOPK; ++it) {
                float best = -INFINITY; int bi = -1;
#pragma unroll 1
                for (int e = 0; e < NE; ++e) {
                    if (!((gmask >> (e >> 3)) & 1u)) continue;
                    if ((used >> e) & 1ull) continue;
                    const float v = sc[e] + bias[e];
                    if (bi < 0 || v > best) { best = v; bi = e; }
                }
                used |= 1ull << bi; se[it] = bi; ss[it] = sc[bi]; wsum += ss[it];
            }
            const float norm = 2.5f / wsum; const int t = mt * 128 + c.tid;
#pragma unroll
            for (int k = 0; k < TOPK; ++k) {
                const int e = se[k]; const int pos = (int)atomicAdd(&c.cnt()[layer * 64 + e], 1u); const int a = t * 8 + k;
                c.AE()[a] = e; c.APOS()[a] = pos; c.AW()[a] = ss[k] * norm; c.LIST()[(size_t)e * T0 + pos] = a;
            }
        }
    }
}

__global__ void __launch_bounds__(NTHREADS, 2) mega(const Params p) {
    __shared__ __attribute__((aligned(16))) unsigned char smem[LDS_LRU_END + 16 + 1024];
    float* lds = (float*)smem;
    Ctx c(p, lds, (ldsp_t)smem);
    volatile unsigned* st = (volatile unsigned*)(smem + LDS_LRU_END);
    if (c.tid < 4) st[c.tid] = 0u;
    __syncthreads();
    const XcdBarrier bar = xcd_barrier_post((unsigned*)(p.ws + CTL_BAR), st);
#define GB() xcd_barrier(bar)
#define REPEAT(n, stmt) do { for (int rep_ = 0; rep_ < (n); ++rep_) { stmt; if (rep_ + 1 < (n)) GB(); } } while (0)
    REPEAT(REP_PREP, (ph_prep(c), ph_convert_small(c), ph_convert_gates(c), ph_convert_moe(c, 0))); GB();
    {
        if (c.tid == 0) {
            unsigned* ctl = (unsigned*)(p.ws + CTL_BAR);
            const unsigned tk = xb_add((unsigned*)(p.ws + CTL_TICKET) + 64 * bar.x, 1u);
            unsigned base = 0u;
            for (unsigned j = 0; j < 16; ++j) { const unsigned n = xb_ld(&ctl[XB_XCNT(j)]); base += (j < bar.x) ? n : 0u; }
            st[2] = base + tk;
        }
        __syncthreads();
        c.vb = __builtin_amdgcn_readfirstlane((int)st[2]);
    }
    ph_norm1_l0_w(c); GB();
    REPEAT(REP_QKV, ph_qkv_m(c)); GB();
    REPEAT(REP_ATTN, ph_attn_m(c)); GB();
    ph_oproj_m(c); GB();
    REPEAT(REP_NORM2, ph_norm2_w(c, 0)); GB();
    ph_route_m(c, 0); GB();
    REPEAT(REP_GATEUP, ph_moe_gateup_m(c, 0, T0)); GB();
    ph_moe_down_m(c, 0, T0); GB();
    ph_combine_norm1_w(c); ph_convert_moe(c, 1); GB();
    REPEAT(REP_INPROJ, ph_inproj_m(c)); GB();
    REPEAT(REP_LRU1, ph_lru_pass<1>(c)); GB();
    ph_lru_carry(c); GB();
    ph_lru_pass<2>(c); GB();
    ph_outproj_m(c); GB();
    ph_norm2_w(c, 1); GB();
    ph_route_m(c, 1); GB();
    ph_moe_gateup_m(c, 1, TL); GB();
    ph_moe_down_m(c, 1, TL); GB();
    ph_final_w(c);
#undef GB
}
}

extern "C" void kernel_launch(void* const* d_in, const int* in_sizes, int n_in, void* d_out, int out_size, void* d_ws, size_t ws_size, hipStream_t stream) {
    if (n_in != 29 || ws_size < WS_END) { fprintf(stderr, "kernel_launch: unexpected n_in %d or ws_size %zu (< %zu)\n", n_in, ws_size, (size_t)WS_END); return; }
    static int grid = 0;
    if (grid == 0) {
        int dev = 0, cus = 0, per_cu = 0;
        hipGetDevice(&dev);
        hipDeviceGetAttribute(&cus, hipDeviceAttributeMultiprocessorCount, dev);
        hipOccupancyMaxActiveBlocksPerMultiprocessor(&per_cu, (const void*)mega, NTHREADS, 0);
        if (per_cu > 2) per_cu = 2;
        if (per_cu < 1) per_cu = 1;
        grid = cus * per_cu;
    }
    hipMemsetAsync((char*)d_ws + WS_CTL, 0, CTL_BYTES, stream);
    Params p{};
    for (int i = 0; i < 29; ++i) p.in[i] = (const float*)d_in[i];
    p.out = (float*)d_out; p.ws = (unsigned char*)d_ws;
    p.ph_lo = 0; p.ph_hi = 20;
    void* args[] = {&p};
    hipError_t e = hipLaunchCooperativeKernel((const void*)mega, dim3(grid), dim3(NTHREADS), args, 0, stream);
    if (e != hipSuccess) fprintf(stderr, "cooperative launch failed: %s (grid %d)\n", hipGetErrorString(e), grid);
}
```

```cpp
#include <hip/hip_runtime.h>
#include <stdint.h>
#include <cstdio>

namespace {
typedef unsigned short bf16_t;
constexpr int D = 1024, NB = 4, S = 4096, C = 256, TL = NB * S, TC = NB * C, T0 = TL + TC;
constexpr int NH = 16, NKV = 4, HD = 64, KD = 256, QKVN = 1536;
constexpr int DR = 1280, NBLK = 16, BW = 80;
constexpr int NE = 64, TOPK = 8, DE = 256;
constexpr float RMS_EPS = 1e-6f;
constexpr float LOG2E = 1.4426950408889634f;
constexpr float QSCALE = 0.125f * LOG2E;
constexpr int NTHREADS = 256;
constexpr int REP_PREP = 1, REP_QKV = 1, REP_ATTN = 1, REP_GATEUP = 1, REP_INPROJ = 1, REP_LRU1 = 1, REP_NORM2 = 1;
constexpr int LDS_U = 0, LDS_A = 13312, LDS_B0 = LDS_A + 20480, LDS_B1 = LDS_B0 + 20480, LDS_LRU_END = LDS_B1 + 20480;

constexpr size_t MiB = 1u << 20;
constexpr size_t WS_CTL = 0, CTL_BYTES = 1 * MiB;
constexpr size_t CTL_BAR = 0;
constexpr size_t CTL_TICKET = 16384;
constexpr size_t CTL_CNT = 32768;
constexpr size_t CTL_MOD = 65536;
constexpr size_t WS_ROPE = 1 * MiB + 512 * 1024;
constexpr size_t WS_SUM = 2 * MiB;
constexpr size_t WS_AE = 8 * MiB;
constexpr size_t WS_AW = WS_AE + 640 * 1024;
constexpr size_t WS_APOS = WS_AW + 640 * 1024;
constexpr size_t WS_LIST = 10 * MiB;
constexpr size_t WS_XC = 15 * MiB;
constexpr size_t WS_WQKV = 19 * MiB, WS_WO = 22 * MiB, WS_WIN = 24 * MiB, WS_WOUT = 29 * MiB, WS_WGATES = 32 * MiB, WS_WROUTER = 33 * MiB, WS_WSH = 34 * MiB;
constexpr size_t WSH_LAYER = 1536 * 1024, WSH_D = 1024 * 1024;
constexpr size_t WMOE_D = 64 * MiB;
constexpr size_t WS_WMOE = 37 * MiB;
constexpr size_t WS_H = 138 * MiB;
constexpr size_t WS_ACT = 172 * MiB;
constexpr size_t WS_ACTS = 240 * MiB;
constexpr size_t WS_BIG = 249 * MiB;
constexpr size_t WS_Q = WS_BIG, WS_K = WS_BIG + 34 * MiB, WS_V = WS_K + 9 * MiB, WS_O = WS_V + 9 * MiB;
constexpr size_t WS_G = WS_BIG, WS_PU = WS_BIG + 40 * MiB, WS_AB = WS_BIG + 83 * MiB;
constexpr size_t WS_CARRY = WS_BIG + 84 * MiB;
constexpr size_t WS_LC8 = 1 * MiB + 640 * 1024;
constexpr size_t WS_END = 521 * MiB;

struct Params {
    const float* in[29];
    float* out;
    unsigned char* ws;
    int ph_lo, ph_hi;
};

__device__ __forceinline__ float bf2f(bf16_t h) { return __uint_as_float(((unsigned)h) << 16); }
__device__ __forceinline__ bf16_t f2bf(float f) { unsigned u = __float_as_uint(f); return (bf16_t)((u + 0x7fffu + ((u >> 16) & 1u)) >> 16); }
__device__ __forceinline__ float silu_f(float v) { return v * __builtin_amdgcn_rcpf(1.f + __builtin_amdgcn_exp2f(-LOG2E * v)); }
__device__ __forceinline__ float gelu_tanh(float v) { const float u = 0.7978845608028654f * (v + 0.044715f * v * v * v); return v * __builtin_amdgcn_rcpf(1.f + __builtin_amdgcn_exp2f(-2.f * LOG2E * u)); }
__device__ __forceinline__ float wave_sum(float v) {
#pragma unroll
    for (int o = 32; o > 0; o >>= 1) v += __shfl_xor(v, o);
    return v;
}
__device__ __forceinline__ int mod_row(int r) { return r < TL ? (r >> 12) : 4; }

#define XB_TMO      128
#define XB_XCNT(j)  (256  + 64 * (j))
#define XB_XSUB(j)  (1280 + 64 * (j))
#define XB_XGEN(j)  (2304 + 64 * (j))
#define XB_TOP      3328
#define XB_TOPGEN   3392
#define XCD_BAR_WORDS 3456
#define XB_SPIN_CAP (1u << 22)
#define LAS __attribute__((address_space(3)))
__device__ __forceinline__ unsigned xb_ld(unsigned* p)              { return __hip_atomic_load(p, __ATOMIC_RELAXED, __HIP_MEMORY_SCOPE_AGENT); }
__device__ __forceinline__ unsigned xb_add(unsigned* p, unsigned v) { return __hip_atomic_fetch_add(p, v, __ATOMIC_RELAXED, __HIP_MEMORY_SCOPE_AGENT); }
__device__ __forceinline__ unsigned xb_xcc_id() { return (unsigned)__builtin_amdgcn_s_getreg((3 << 11) | 20) & 0xFu; }
#define XB_SPIN(cond, bar) do { unsigned _sp = 0; while (cond) { __builtin_amdgcn_s_sleep(1); \
    if ((++_sp & 255u) == 0u) { if (xb_ld(&(bar)[XB_TMO])) break; if (_sp > XB_SPIN_CAP) { atomicAdd(&(bar)[XB_TMO], 1u); break; } } } } while (0)
struct XcdBarrier { unsigned* bar; unsigned x; volatile unsigned* st; };
__device__ __forceinline__ XcdBarrier xcd_barrier_post(unsigned* bar, volatile unsigned* st) {
    XcdBarrier b; b.bar = bar; b.x = xb_xcc_id(); b.st = st;
    if (threadIdx.x == 0) (void)xb_add(&bar[XB_XCNT(b.x)], 1u);
    return b;
}
__device__ __forceinline__ void xcd_barrier_complete(unsigned* bar, unsigned x, unsigned& nloc, unsigned& nx) {
    const unsigned G = gridDim.x * gridDim.y * gridDim.z;
    unsigned sum, cnt, mine, sp = 0u;
    for (;;) {
        sum = 0u; cnt = 0u; mine = 0u;
#pragma unroll
        for (unsigned j = 0; j < 16; ++j) { const unsigned c = xb_ld(&bar[XB_XCNT(j)]); sum += c; cnt += (c > 0u) ? 1u : 0u; mine = (j == x) ? c : mine; }
        if (sum == G) break;
        __builtin_amdgcn_s_sleep(1);
        if ((++sp & 255u) == 0u) { if (xb_ld(&bar[XB_TMO])) break; if (sp > XB_SPIN_CAP) { atomicAdd(&bar[XB_TMO], 1u); break; } }
    }
    nloc = mine > 0u ? mine : 1u; nx = cnt > 0u ? cnt : 1u;
}
__device__ __forceinline__ void xcd_barrier(const XcdBarrier& b) {
    asm volatile("s_waitcnt vmcnt(0)" ::: "memory");
    __syncthreads();
    if (threadIdx.x == 0) {
        unsigned* bar = b.bar;
        __builtin_amdgcn_s_waitcnt(0);
        unsigned nloc = b.st[0], nx = b.st[1];
        if (nloc == 0u) { xcd_barrier_complete(bar, b.x, nloc, nx); b.st[0] = nloc; b.st[1] = nx; }
        const unsigned old = xb_add(&bar[XB_XSUB(b.x)], 1u);
        const unsigned gen = old / nloc;
        if (old + 1u == (gen + 1u) * nloc) {
            __builtin_amdgcn_fence(__ATOMIC_RELEASE, "agent");
            asm volatile("s_waitcnt vmcnt(0)" ::: "memory");
            const unsigned og = xb_add(&bar[XB_TOP], 1u);
            const unsigned tg = og / nx;
            if (og + 1u == (tg + 1u) * nx) xb_add(&bar[XB_TOPGEN], 1u);
            else XB_SPIN(xb_ld(&bar[XB_TOPGEN]) == tg, bar);
            __builtin_amdgcn_fence(__ATOMIC_ACQUIRE, "agent");
            xb_add(&bar[XB_XGEN(b.x)], 1u);
            asm volatile("s_waitcnt vmcnt(0)" ::: "memory");
        } else {
            XB_SPIN(xb_ld(&bar[XB_XGEN(b.x)]) == gen, bar);
            __builtin_amdgcn_fence(__ATOMIC_ACQUIRE, "agent");
            asm volatile("s_waitcnt vmcnt(0)" ::: "memory");
        }
    }
    __syncthreads();
}


typedef short bf16x8 __attribute__((ext_vector_type(8)));
typedef float f32x4 __attribute__((ext_vector_type(4)));
typedef unsigned u32x4 __attribute__((ext_vector_type(4)));
typedef unsigned u32x2 __attribute__((ext_vector_type(2)));
typedef LAS unsigned char* ldsp_t;
constexpr int EP_WAVE = 17408;
constexpr int GT_STG = 24576;
template <class RowPtr, class Epi>
__device__ __forceinline__ void mfma_tile(ldsp_t lds, const RowPtr& rp, const bf16_t* Bt, int K, const Epi& ep, int row0, int col0) {
    const int tid = threadIdx.x, lane = tid & 63, wid = __builtin_amdgcn_readfirstlane(tid >> 6), wr = wid >> 1, wc = wid & 1, fr = lane & 15, fq = lane >> 4;
    const int sch = ((tid & 3) ^ ((-(tid >> 4)) & 3)) * 8;
    const bf16_t* ap0 = rp(row0 + (tid >> 2)) + sch;
    const bf16_t* ap1 = rp(row0 + 64 + (tid >> 2)) + sch;
    const bf16_t* bp = Bt + (size_t)(tid >> 2) * K + sch;
    const size_t bstep = (size_t)64 * K;
    const int cterm = ((fq ^ ((-(fr >> 2)) & 3)) << 4);
    const int aoff = (wr * 64 + fr) * 64 + cterm, boff = 8192 + (wc * 128 + fr) * 64 + cterm;
    f32x4 acc[4][8];
#pragma unroll
    for (int m = 0; m < 4; ++m)
#pragma unroll
        for (int n = 0; n < 8; ++n) acc[m][n] = (f32x4){0.f, 0.f, 0.f, 0.f};
#define GT_STAGE(sb, k0) do { const ldsp_t d_ = lds + (sb) + wid * 1024; \
        __builtin_amdgcn_global_load_lds((const unsigned*)(ap0 + (k0)), (LAS unsigned*)(d_), 16, 0, 0); \
        __builtin_amdgcn_global_load_lds((const unsigned*)(ap1 + (k0)), (LAS unsigned*)(d_ + 4096), 16, 0, 0); \
        _Pragma("unroll") for (int i_ = 0; i_ < 4; ++i_) \
            __builtin_amdgcn_global_load_lds((const unsigned*)(bp + i_ * bstep + (k0)), (LAS unsigned*)(d_ + 8192 + i_ * 4096), 16, 0, 0); } while (0)
    const int nt = K >> 5;
    asm volatile("s_waitcnt lgkmcnt(0)" ::: "memory");
    __builtin_amdgcn_s_barrier();
    asm volatile("" ::: "memory");
    GT_STAGE(0, 0);
    GT_STAGE(GT_STG, 32);
    int scur = 0, snx = 2 * GT_STG;
#pragma unroll 1
    for (int t = 0; t < nt; ++t) {
        if (t + 1 < nt) asm volatile("s_waitcnt vmcnt(6)" ::: "memory"); else asm volatile("s_waitcnt vmcnt(0)" ::: "memory");
        __builtin_amdgcn_s_barrier();
        asm volatile("" ::: "memory");
        if (t + 2 < nt) GT_STAGE(snx, (t + 2) * 32);
        const ldsp_t base = lds + scur;
        bf16x8 af[4], bfr[8];
#pragma unroll
        for (int m = 0; m < 4; ++m) af[m] = *(const LAS bf16x8*)(base + aoff + m * 1024);
#pragma unroll
        for (int n = 0; n < 8; ++n) bfr[n] = *(const LAS bf16x8*)(base + boff + n * 1024);
#pragma unroll
        for (int m = 0; m < 4; ++m)
#pragma unroll
            for (int n = 0; n < 8; ++n) acc[m][n] = __builtin_amdgcn_mfma_f32_16x16x32_bf16(bfr[n], af[m], acc[m][n], 0, 0, 0);
        scur = (scur == 2 * GT_STG) ? 0 : scur + GT_STG;
        snx = (snx == 2 * GT_STG) ? 0 : snx + GT_STG;
    }
#undef GT_STAGE
    __syncthreads();
    ep(acc, lds + wid * EP_WAVE, row0 + wr * 64, col0 + wc * 128, lane);
}
constexpr int RT_STG = 12288, RT_NS = 6;
template <class Epi>
__device__ __forceinline__ void router_tile(ldsp_t lds, const bf16_t* A, const bf16_t* Bt, int K, const Epi& ep, int row0) {
    const int tid = threadIdx.x, lane = tid & 63, wid = __builtin_amdgcn_readfirstlane(tid >> 6), wr = wid >> 1, wc = wid & 1, fr = lane & 15, fq = lane >> 4;
    const int sch = ((tid & 3) ^ ((-(tid >> 4)) & 3)) * 8;
    const bf16_t* ap0 = A + (size_t)(row0 + (tid >> 2)) * K + sch;
    const bf16_t* ap1 = ap0 + (size_t)64 * K;
    const bf16_t* bp = Bt + (size_t)(tid >> 2) * K + sch;
    const int cterm = ((fq ^ ((-(fr >> 2)) & 3)) << 4);
    const int aoff = (wr * 64 + fr) * 64 + cterm, boff = 8192 + (wc * 32 + fr) * 64 + cterm;
    f32x4 acc[4][8];
#pragma unroll
    for (int m = 0; m < 4; ++m)
#pragma unroll
        for (int n = 0; n < 8; ++n) acc[m][n] = (f32x4){0.f, 0.f, 0.f, 0.f};
#define RT_STAGE(sb, k0) do { const ldsp_t d_ = lds + (sb) + wid * 1024; \
        __builtin_amdgcn_global_load_lds((const unsigned*)(ap0 + (k0)), (LAS unsigned*)(d_), 16, 0, 0); \
        __builtin_amdgcn_global_load_lds((const unsigned*)(ap1 + (k0)), (LAS unsigned*)(d_ + 4096), 16, 0, 0); \
        __builtin_amdgcn_global_load_lds((const unsigned*)(bp + (k0)), (LAS unsigned*)(d_ + 8192), 16, 0, 0); } while (0)
    const int nt = K >> 5;
    asm volatile("s_waitcnt lgkmcnt(0)" ::: "memory");
    __builtin_amdgcn_s_barrier();
    asm volatile("" ::: "memory");
#pragma unroll
    for (int q = 0; q < RT_NS - 1; ++q) RT_STAGE(q * RT_STG, q * 32);
    int scur = 0, snx = (RT_NS - 1) * RT_STG;
#pragma unroll 1
    for (int t = 0; t < nt; ++t) {
        if (t + RT_NS - 1 <= nt) asm volatile("s_waitcnt vmcnt(12)" ::: "memory");
        else asm volatile("s_waitcnt vmcnt(0)" ::: "memory");
        __builtin_amdgcn_s_barrier();
        asm volatile("" ::: "memory");
        if (t + RT_NS - 1 < nt) RT_STAGE(snx, (t + RT_NS - 1) * 32);
        const ldsp_t base = lds + scur;
        bf16x8 af[4], bfr[2];
#pragma unroll
        for (int m = 0; m < 4; ++m) af[m] = *(const LAS bf16x8*)(base + aoff + m * 1024);
#pragma unroll
        for (int n = 0; n < 2; ++n) bfr[n] = *(const LAS bf16x8*)(base + boff + n * 1024);
#pragma unroll
        for (int m = 0; m < 4; ++m)
#pragma unroll
            for (int n = 0; n < 2; ++n) acc[m][n] = __builtin_amdgcn_mfma_f32_16x16x32_bf16(bfr[n], af[m], acc[m][n], 0, 0, 0);
        scur = (scur == (RT_NS - 1) * RT_STG) ? 0 : scur + RT_STG;
        snx = (snx == (RT_NS - 1) * RT_STG) ? 0 : snx + RT_STG;
    }
#undef RT_STAGE
    __syncthreads();
    ep(acc, lds, row0 + wr * 64, wc * 32, lane);
}
typedef float f32x2_t __attribute__((ext_vector_type(2))); typedef __bf16 bf16x2_t __attribute__((ext_vector_type(2)));
__device__ __forceinline__ unsigned pk2(float lo, float hi) { f32x2_t v = {lo, hi}; bf16x2_t b = __builtin_convertvector(v, bf16x2_t); return __builtin_bit_cast(unsigned, b); }
__device__ __forceinline__ void st_bf16x4(bf16_t* p, float a, float b, float c, float d) { uint2 o; o.x = pk2(a, b); o.y = pk2(c, d); *(uint2*)p = o; }

struct RowPlain { const bf16_t* A; int lda; __device__ __forceinline__ const bf16_t* operator()(int r) const { return A + (size_t)r * lda; } };

constexpr int EPB = 272;
constexpr int EPF = 528;
__device__ __forceinline__ void ep_put4(ldsp_t wl, int row, int col, float a, float b, float c, float d) { u32x2 o; o.x = pk2(a, b); o.y = pk2(c, d); *(LAS u32x2*)(wl + row * EPB + col * 2) = o; }
struct MEpiQKV {
    bf16_t *Q, *K, *V; const float* rope;
    __device__ __forceinline__ void operator()(f32x4 (&acc)[4][8], ldsp_t wl, int rbase, int cbase0, int lane) const {
        const int fr = lane & 15, fq = lane >> 4;
#pragma unroll
        for (int hh = 0; hh < 2; ++hh) {
            const int cbase = cbase0 + hh * 64;
            const bool isq = cbase < 1024, isk = (cbase >= 1024 && cbase < 1280);
#pragma unroll
            for (int m = 0; m < 4; ++m) {
                const int r = rbase + m * 16 + fr;
                f32x4 v0 = acc[m][hh * 4 + 0], v1 = acc[m][hh * 4 + 1], v2 = acc[m][hh * 4 + 2], v3 = acc[m][hh * 4 + 3];
                if ((isq || isk) && r < TL) {
                    const int s = r & (S - 1), prow = s >> 6, pcol = s & 63;
                    const f32x4 cr = *(const f32x4*)(rope + prow * 16 + fq * 4), sr = *(const f32x4*)(rope + 1024 + prow * 16 + fq * 4);
                    const f32x4 cc = *(const f32x4*)(rope + pcol * 16 + fq * 4), sc = *(const f32x4*)(rope + 1024 + pcol * 16 + fq * 4);
                    const f32x4 o0 = v0 * cr - v1 * sr, o1 = v1 * cr + v0 * sr, o2 = v2 * cc - v3 * sc, o3 = v3 * cc + v2 * sc;
                    v0 = o0; v1 = o1; v2 = o2; v3 = o3;
                }
                if (isq) { v0 *= QSCALE; v1 *= QSCALE; v2 *= QSCALE; v3 *= QSCALE; }
                const int rl = m * 16 + fr, cl = hh * 64 + fq * 4;
                ep_put4(wl, rl, cl, v0[0], v0[1], v0[2], v0[3]); ep_put4(wl, rl, cl + 16, v1[0], v1[1], v1[2], v1[3]);
                ep_put4(wl, rl, cl + 32, v2[0], v2[1], v2[2], v2[3]); ep_put4(wl, rl, cl + 48, v3[0], v3[1], v3[2], v3[3]);
            }
        }
        const bool isq = cbase0 < 1024, isk = (cbase0 >= 1024 && cbase0 < 1280);
        bf16_t* base = isq ? (Q + cbase0) : isk ? (K + (cbase0 - 1024)) : (V + (cbase0 - 1280));
        const size_t pitch = isq ? 1024 : 256;
#pragma unroll 2
        for (int i = 0; i < 16; ++i) {
            const int rl = 4 * i + (lane >> 4), ch = lane & 15;
            const u32x4 v = *(const LAS u32x4*)(wl + rl * EPB + ch * 16);
            *(u32x4*)(base + (size_t)(rbase + rl) * pitch + ch * 8) = v;
        }
    }
};
struct MEpiResid {
    const float* srcL; const float* srcC; float* dstL; float* dstC; const float* mod; int gchunk;
    __device__ __forceinline__ void operator()(f32x4 (&acc)[4][8], ldsp_t wl, int rbase, int cbase, int lane) const {
        const int fr = lane & 15, fq = lane >> 4, c4 = (lane & 31) * 4;
        const f32x4 gv = *(const f32x4*)(mod + mod_row(rbase) * 6144 + gchunk * 1024 + cbase + c4);
        const bool latent = rbase < TL;
        const float* sbase = (latent ? srcL + (size_t)rbase * D : srcC + (size_t)(rbase - TL) * D) + cbase + c4 + (size_t)(lane >> 5) * D;
        float* dbase = (latent ? dstL + (size_t)rbase * D : dstC + (size_t)(rbase - TL) * D) + cbase + c4 + (size_t)(lane >> 5) * D;
#pragma unroll
        for (int half = 0; half < 2; ++half) {
#pragma unroll
            for (int mm = 0; mm < 2; ++mm)
#pragma unroll
                for (int n = 0; n < 8; ++n) *(LAS f32x4*)(wl + (mm * 16 + fr) * EPF + (n * 16 + fq * 4) * 4) = acc[half * 2 + mm][n];
#pragma unroll
            for (int q = 0; q < 2; ++q) {
                f32x4 sv[8];
#pragma unroll
                for (int i = 0; i < 8; ++i) sv[i] = *(const f32x4*)(sbase + (size_t)(half * 32 + 16 * q + 2 * i) * D);
#pragma unroll
                for (int i = 0; i < 8; ++i) {
                    const int rl = 16 * q + 2 * i + (lane >> 5);
                    const f32x4 v = *(const LAS f32x4*)(wl + rl * EPF + c4 * 4);
                    *(f32x4*)(dbase + (size_t)(half * 32 + 16 * q + 2 * i) * D) = sv[i] + gv * v;
                }
            }
        }
    }
};
struct MEpiInProj {
    bf16_t* G; bf16_t* PU;
    __device__ __forceinline__ void operator()(f32x4 (&acc)[4][8], ldsp_t wl, int rbase, int cbase, int lane) const {
        const int fr = lane & 15, fq = lane >> 4;
        const bool isg = cbase < DR;
#pragma unroll
        for (int m = 0; m < 4; ++m)
#pragma unroll
            for (int n = 0; n < 8; ++n) {
                const f32x4 v = acc[m][n];
                if (isg) ep_put4(wl, m * 16 + fr, n * 16 + fq * 4, gelu_tanh(v[0]), gelu_tanh(v[1]), gelu_tanh(v[2]), gelu_tanh(v[3]));
                else ep_put4(wl, m * 16 + fr, n * 16 + fq * 4, v[0], v[1], v[2], v[3]);
            }
        bf16_t* base = isg ? (G + cbase) : (PU + (cbase - DR));
#pragma unroll 2
        for (int i = 0; i < 16; ++i) {
            const int rl = 4 * i + (lane >> 4), ch = lane & 15, r = rbase + rl;
            const u32x4 v = *(const LAS u32x4*)(wl + rl * EPB + ch * 16);
            if (!isg || r < TL) *(u32x4*)(base + (size_t)r * DR + ch * 8) = v;
        }
    }
};
#define vblock() (c.vb)

template <class RowMap>
__device__ __forceinline__ void tr_item64(const float* W, int ldw, int k0, int n0, bf16_t* dst, int ldd, const RowMap& rm, int lane) {
    const int nq = lane >> 2, kg = lane & 3;
    f32x4 v[16];
    const float* src = W + (size_t)(k0 + kg * 8) * ldw + n0 + 4 * nq;
#pragma unroll
    for (int h = 0; h < 2; ++h)
#pragma unroll
        for (int i = 0; i < 8; ++i) v[h * 8 + i] = *(const f32x4*)(src + (size_t)(h * 32 + i) * ldw);
#pragma unroll
    for (int cc = 0; cc < 4; ++cc) {
        bf16_t* drow = dst + (size_t)rm(n0 + 4 * nq + cc) * ldd + k0 + kg * 8;
#pragma unroll
        for (int h = 0; h < 2; ++h) {
            u32x4 o; o.x = pk2(v[h * 8 + 0][cc], v[h * 8 + 1][cc]); o.y = pk2(v[h * 8 + 2][cc], v[h * 8 + 3][cc]); o.z = pk2(v[h * 8 + 4][cc], v[h * 8 + 5][cc]); o.w = pk2(v[h * 8 + 6][cc], v[h * 8 + 7][cc]);
            *(u32x4*)(drow + h * 32) = o;
        }
    }
}
struct RMPlain { __device__ __forceinline__ int operator()(int n) const { return n; } };
struct RMGateUp { int mat; __device__ __forceinline__ int operator()(int h) const { return (h >> 7) * 256 + ((h >> 6) & 1) * 128 + (((h >> 4) & 3) * 2 + mat) * 16 + (h & 15); } };
__device__ __forceinline__ void tr_plain(const float* W, int K, int N, bf16_t* dst, int item, int lane) {
    const int nb = N / 64, kb = item / nb, n0 = (item % nb) * 64;
    tr_item64(W, N, kb * 64, n0, dst, K, RMPlain{}, lane);
}
__device__ __forceinline__ void tr_expert(const float* Wg, const float* Wu, const float* Wd, bf16_t* gu, bf16_t* dn, int item, int lane) {
    if (item < 128) {
        const int mat = item >> 6, it = item & 63, kb = it >> 2, n0 = (it & 3) * 64;
        tr_item64(Wg + (size_t)mat * (Wu - Wg), DE, kb * 64, n0, gu, D, RMGateUp{mat}, lane);
    } else {
        const int it = item - 128, kb = it >> 4, n0 = (it & 15) * 64;
        tr_item64(Wd, D, kb * 64, n0, dn, DE, RMPlain{}, lane);
    }
}
struct Ctx {
    const Params& p; float* lds; ldsp_t smem;
    int tid, lane, wid, vb;
    __device__ __forceinline__ Ctx(const Params& p_, float* l, ldsp_t sm) : p(p_), lds(l), smem(sm) { tid = threadIdx.x; lane = tid & 63; wid = tid >> 6; vb = blockIdx.x; }
#define WSF(name, type, off) __device__ __forceinline__ type* name() const { return (type*)(p.ws + (off)); }
    WSF(cnt, unsigned, CTL_CNT) WSF(mod, float, CTL_MOD) WSF(rope, float, WS_ROPE) WSF(sum, float, WS_SUM)
    WSF(AE, int, WS_AE) WSF(AW, float, WS_AW) WSF(APOS, int, WS_APOS) WSF(LIST, int, WS_LIST) WSF(XC, float, WS_XC)
    WSF(H, bf16_t, WS_H) WSF(ACT, bf16_t, WS_ACT) WSF(ACTS, bf16_t, WS_ACTS) WSF(Y, bf16_t, WS_BIG)
    WSF(Qb, bf16_t, WS_Q) WSF(Kb, bf16_t, WS_K) WSF(Vb, bf16_t, WS_V) WSF(Ob, bf16_t, WS_O)
    WSF(WQKV, bf16_t, WS_WQKV) WSF(WO, bf16_t, WS_WO) WSF(WIN, bf16_t, WS_WIN) WSF(WOUT, bf16_t, WS_WOUT) WSF(WSH, bf16_t, WS_WSH) WSF(WMOE, bf16_t, WS_WMOE)
    WSF(WGATES, bf16_t, WS_WGATES) WSF(WROUTER, bf16_t, WS_WROUTER) WSF(LC8, float, WS_LC8) WSF(CARRY, float, WS_CARRY)
    WSF(G, bf16_t, WS_G) WSF(PU, bf16_t, WS_PU) WSF(HG, bf16_t, WS_G) WSF(AB, float, WS_AB) WSF(HS, float, WS_WMOE)
#undef WSF
};

__device__ __forceinline__ void ph_prep(Ctx& c) {
    const float* cv = c.p.in[1]; const float* cctx = c.p.in[3]; const float* aw = c.p.in[4]; const float* ab = c.p.in[5];
    float* sil = c.lds;
    float* red = c.lds + 5120;
    __syncthreads();
    for (int i = c.tid; i < 5 * 1024; i += NTHREADS) { const int r = i >> 10, k = i & 1023; const float v = r < 4 ? cv[r * 1024 + k] : cctx[k]; sil[i] = silu_f(v); }
    __syncthreads();
    for (int item = blockIdx.x; item < 2 * 96; item += gridDim.x) {
        const int l = item / 96, jb = item % 96, kq = c.tid >> 4, cq = c.tid & 15;
        f32x4 a0 = {0, 0, 0, 0}, a1 = a0, a2 = a0, a3 = a0, a4 = a0;
        const float* w = aw + ((size_t)l * 1024 + kq * 64) * 6144 + jb * 64 + cq * 4;
        const float* sl = sil + kq * 64;
#pragma unroll 8
        for (int k = 0; k < 64; ++k) { const f32x4 wv = *(const f32x4*)(w + (size_t)k * 6144); a0 += sl[k] * wv; a1 += sl[1024 + k] * wv; a2 += sl[2048 + k] * wv; a3 += sl[3072 + k] * wv; a4 += sl[4096 + k] * wv; }
        float* rr = red + kq * 320 + cq * 4;
        *(f32x4*)(rr) = a0; *(f32x4*)(rr + 64) = a1; *(f32x4*)(rr + 128) = a2; *(f32x4*)(rr + 192) = a3; *(f32x4*)(rr + 256) = a4;
        __syncthreads();
        for (int i = c.tid; i < 320; i += NTHREADS) {
            const int r = i >> 6, jj = i & 63;
            float v = 0.f;
#pragma unroll
            for (int q = 0; q < 16; ++q) v += red[q * 320 + i];
            c.mod()[((size_t)l * 5 + r) * 6144 + jb * 64 + jj] = v + ab[l * 6144 + jb * 64 + jj];
        }
        __syncthreads();
    }
    if (blockIdx.x == gridDim.x - 1) {
        for (int i = c.tid; i < 1024; i += NTHREADS) {
            const int pos = i >> 4, f = i & 15;
            const float inv = expf(-logf(10000.0f) * (float)f / 16.0f);
            const float ang = (float)pos * inv;
            c.rope()[i] = cosf(ang); c.rope()[1024 + i] = sinf(ang);
        }
    }
}


__device__ __forceinline__ int find_expert(const int* tp, int rt) {
    const int lane = threadIdx.x & 63;
    const unsigned long long m = __ballot(tp[lane] <= rt);
    const int e = tp[64] <= rt ? 64 : (int)__popcll(m) - 1;
    return __builtin_amdgcn_readfirstlane(e);
}


__device__ __forceinline__ void ph_convert_small(Ctx& c) {
    const int wu = __builtin_amdgcn_readfirstlane(c.wid);
    const int gw = blockIdx.x * 4 + wu, NGW = gridDim.x * 4;
    constexpr int I_QKV = 16 * 24, I_O = 16 * 16, I_IN = 16 * 40, I_OUT = 20 * 16, I_SH = 192, I_R = 16;
    constexpr int NIT = I_QKV + I_O + I_IN + I_OUT + 2 * I_SH + 2 * I_R;
    for (int it = gw; it < NIT; it += NGW) {
        int r = it;
        if (r < I_QKV) { tr_plain(c.p.in[8], 1024, 1536, c.WQKV(), r, c.lane); continue; } r -= I_QKV;
        if (r < I_O) { tr_plain(c.p.in[9], 1024, 1024, c.WO(), r, c.lane); continue; } r -= I_O;
        if (r < I_IN) { tr_plain(c.p.in[11], 1024, 2560, c.WIN(), r, c.lane); continue; } r -= I_IN;
        if (r < I_OUT) { tr_plain(c.p.in[19], 1280, 1024, c.WOUT(), r, c.lane); continue; } r -= I_OUT;
        if (r < 2 * I_SH) {
            const int l = r / I_SH; r %= I_SH;
            bf16_t* base = c.WSH() + (size_t)l * (WSH_LAYER / 2);
            tr_expert(c.p.in[25] + (size_t)l * D * DE, c.p.in[26] + (size_t)l * D * DE, c.p.in[27] + (size_t)l * DE * D, base, base + WSH_D / 2, r, c.lane);
            continue;
        }
        r -= 2 * I_SH;
        { const int l = r / I_R; r %= I_R; tr_plain(c.p.in[20] + (size_t)l * D * NE, D, NE, c.WROUTER() + (size_t)l * 128 * D, r, c.lane); }
    }
    for (int i = blockIdx.x * NTHREADS + c.tid; i < 2 * 64 * D / 8; i += gridDim.x * NTHREADS) { const int l = i / (64 * D / 8), o = i % (64 * D / 8); *(u32x4*)(c.WROUTER() + (size_t)l * 128 * D + 64 * D + (size_t)o * 8) = (u32x4){0u, 0u, 0u, 0u}; }
}
__device__ __forceinline__ void ph_convert_moe(Ctx& c, int layer) {
    const int wu = __builtin_amdgcn_readfirstlane(c.wid);
    const int gw = vblock() * 4 + wu, NGW = gridDim.x * 4;
    for (int it = gw; it < NE * 192; it += NGW) {
        const int e = it / 192, r = it % 192; const size_t eo = ((size_t)layer * NE + e) * D * DE;
        tr_expert(c.p.in[22] + eo, c.p.in[23] + eo, c.p.in[24] + eo, c.WMOE() + (size_t)e * 512 * 1024, c.WMOE() + WMOE_D / 2 + (size_t)e * 1024 * 256, r, c.lane);
    }
}
template <class Epi>
__device__ __forceinline__ void dense_gemm(Ctx& c, const bf16_t* A, int lda, int mtiles, const bf16_t* Bt, int K, int ntiles, const Epi& ep) {
    const RowPlain rp{A, lda};
    const int nItems = mtiles * ntiles;
    for (int item = vblock(); item < nItems; item += gridDim.x) {
        const int mt = item / ntiles, nt = item % ntiles;
        mfma_tile(c.smem, rp, Bt + (size_t)nt * 256 * K, K, ep, mt * 128, nt * 256);
    }
}
__device__ __forceinline__ void ph_qkv_m(Ctx& c) { const MEpiQKV ep{c.Qb(), c.Kb(), c.Vb(), c.rope()}; dense_gemm(c, c.H(), D, T0 / 128, c.WQKV(), D, QKVN / 256, ep); }
__device__ __forceinline__ void ph_oproj_m(Ctx& c) { const MEpiResid ep{c.p.in[0], c.p.in[2], c.p.out, c.XC(), c.mod(), 2}; dense_gemm(c, c.Ob(), D, T0 / 128, c.WO(), D, D / 256, ep); }
__device__ __forceinline__ void ph_inproj_m(Ctx& c) { const MEpiInProj ep{c.G(), c.PU()}; dense_gemm(c, c.H(), D, T0 / 128, c.WIN(), D, 2 * DR / 256, ep); }
__device__ __forceinline__ void ph_outproj_m(Ctx& c) { const MEpiResid ep{c.p.out, c.XC(), c.p.out, c.XC(), c.mod() + 5 * 6144, 2}; dense_gemm(c, c.HG(), DR, TL / 128, c.WOUT(), DR, D / 256, ep); }


__device__ __forceinline__ void moe_tables128(Ctx& c, int layer, int T, int* tbl) {
    __syncthreads();
    if (c.tid < 64) {
        const int n = (int)c.cnt()[layer * 64 + c.tid], nt = (n + 127) >> 7;
        int o = n, t = nt;
#pragma unroll
        for (int d = 1; d < 64; d <<= 1) { const int o2 = __shfl_up(o, d), t2 = __shfl_up(t, d); if (c.tid >= d) { o += o2; t += t2; } }
        tbl[136 + c.tid] = n; tbl[c.tid] = o - n; tbl[65 + c.tid] = t - nt;
        if (c.tid == 63) { tbl[64] = o; tbl[65 + 64] = t; tbl[65 + 65] = t + ((T + 127) >> 7); }
    }
    __syncthreads();
}
struct RowGather { const bf16_t* H; const int* list; int n; bool shared;
    __device__ __forceinline__ const bf16_t* operator()(int r) const { if (r >= n) return H; const int tok = shared ? r : (list[r] >> 3); return H + (size_t)tok * D; } };
struct MEpiAct { bf16_t* act; int n;
    __device__ __forceinline__ void operator()(f32x4 (&acc)[4][8], ldsp_t wl, int rbase, int cbase, int lane) const {
        const int fr = lane & 15, fq = lane >> 4;
#pragma unroll
        for (int m = 0; m < 4; ++m)
#pragma unroll
            for (int q = 0; q < 4; ++q) { const f32x4 g = acc[m][2 * q], u = acc[m][2 * q + 1];
                ep_put4(wl, m * 16 + fr, q * 16 + fq * 4, silu_f(g[0]) * u[0], silu_f(g[1]) * u[1], silu_f(g[2]) * u[2], silu_f(g[3]) * u[3]); }
        bf16_t* base = act + (cbase >> 1);
#pragma unroll 2
        for (int i = 0; i < 8; ++i) {
            const int rl = 8 * i + (lane >> 3), ch = lane & 7, r = rbase + rl;
            const u32x4 v = *(const LAS u32x4*)(wl + rl * EPB + ch * 16);
            if (r < n) *(u32x4*)(base + (size_t)r * DE + ch * 8) = v;
        }
    }
};
__device__ __forceinline__ void ph_moe_gateup_m(Ctx& c, int layer, int T) {
    int* tbl = (int*)(c.smem + LDS_LRU_END + 16);
    moe_tables128(c, layer, T, tbl);
    const int* tp = tbl + 65; const int ntile = tp[65];
#pragma unroll 1
    for (int item = vblock(); item < ntile * 2; item += gridDim.x) {
        const int rt = item >> 1, nt = item & 1, e = find_expert(tp, rt), mt = rt - tp[e];
        const bool sh = e >= NE;
        const int n = sh ? T : tbl[136 + e];
        const RowGather rp{c.H(), c.LIST() + (size_t)(sh ? 0 : e) * T0, n, sh};
        const bf16_t* Bt = (sh ? c.WSH() + (size_t)layer * (WSH_LAYER / 2) : c.WMOE() + (size_t)e * 512 * 1024) + (size_t)nt * 256 * D;
        const MEpiAct ep{sh ? c.ACTS() : c.ACT() + (size_t)tbl[e] * DE, n};
        mfma_tile(c.smem, rp, Bt, D, ep, mt * 128, nt * 256);
    }
}
struct MEpiDown { bf16_t* Y; const int* list; const float* aw; int n; bool shared; float* xl; float* xc; const float* mod; int a_reg; float w_reg;
    __device__ __forceinline__ void operator()(f32x4 (&acc)[4][8], ldsp_t wl, int rbase, int cbase, int lane) const {
        const int fr = lane & 15, fq = lane >> 4;
        if (!shared) {
#pragma unroll
            for (int m = 0; m < 4; ++m) {
                const float w = __shfl(w_reg, m * 16 + fr);
#pragma unroll
                for (int nn = 0; nn < 8; ++nn) ep_put4(wl, m * 16 + fr, nn * 16 + fq * 4, w * acc[m][nn][0], w * acc[m][nn][1], w * acc[m][nn][2], w * acc[m][nn][3]);
            }
#pragma unroll 2
            for (int i = 0; i < 16; ++i) {
                const int rl = 4 * i + (lane >> 4), ch = lane & 15, r = rbase + rl;
                const u32x4 v = *(const LAS u32x4*)(wl + rl * EPB + ch * 16);
                const int a = __shfl(a_reg, rl);
                if (r < n) *(u32x4*)(Y + (size_t)a * D + cbase + ch * 8) = v;
            }
        } else {
#pragma unroll
            for (int half = 0; half < 2; ++half) {
#pragma unroll
                for (int mm = 0; mm < 2; ++mm)
#pragma unroll
                    for (int nn = 0; nn < 8; ++nn) *(LAS f32x4*)(wl + (mm * 16 + fr) * EPF + (nn * 16 + fq * 4) * 4) = acc[half * 2 + mm][nn];
#pragma unroll 2
                for (int i = 0; i < 16; ++i) {
                    const int rl = 2 * i + (lane >> 5), c4 = (lane & 31) * 4, r = rbase + half * 32 + rl;
                    const f32x4 v = *(const LAS f32x4*)(wl + rl * EPF + c4 * 4);
                    if (r < n) {
                        const f32x4 gv = *(const f32x4*)(mod + mod_row(r) * 6144 + 5 * 1024 + cbase + c4);
                        float* d = (r < TL ? xl + (size_t)r * D : xc + (size_t)(r - TL) * D) + cbase + c4;
                        *(f32x4*)d += gv * v;
                    }
                }
            }
        }
    }
};
__device__ __forceinline__ void ph_moe_down_m(Ctx& c, int layer, int T) {
    int* tbl = (int*)(c.smem + LDS_LRU_END + 16);
    moe_tables128(c, layer, T, tbl);
    const int* tp = tbl + 65; const int ntile = tp[65];
    const float* modl = c.mod() + (size_t)layer * 5 * 6144;
#pragma unroll 1
    for (int item = vblock(); item < ntile * 4; item += gridDim.x) {
        const int rt = item >> 2, nt = item & 3, e = find_expert(tp, rt), mt = rt - tp[e];
        const bool sh = e >= NE;
        const int n = sh ? T : tbl[136 + e];
        const RowPlain rp{sh ? c.ACTS() : c.ACT() + (size_t)tbl[e] * DE, DE};
        const bf16_t* Bt = (sh ? c.WSH() + (size_t)layer * (WSH_LAYER / 2) + WSH_D / 2 : c.WMOE() + WMOE_D / 2 + (size_t)e * 1024 * 256) + (size_t)nt * 256 * DE;
        int a_reg = 0; float w_reg = 0.f;
        if (!sh) { const int rr = mt * 128 + (__builtin_amdgcn_readfirstlane(c.tid >> 6) >> 1) * 64 + c.lane; if (rr < n) { a_reg = c.LIST()[(size_t)e * T0 + rr]; w_reg = c.AW()[a_reg]; } }
        const MEpiDown ep{c.Y(), c.LIST() + (size_t)(sh ? 0 : e) * T0, c.AW(), n, sh, c.p.out, c.XC(), modl, a_reg, w_reg};
        mfma_tile(c.smem, rp, Bt, DE, ep, mt * 128, nt * 256);
    }
}


constexpr int NCH = 68;
constexpr int LU_PITCH = 104;
__device__ __forceinline__ float fast_sigmoid(float x) { return __builtin_amdgcn_rcpf(1.f + __builtin_amdgcn_exp2f(-LOG2E * x)); }
__device__ __forceinline__ void ph_convert_gates(Ctx& c) {
    const int NT = gridDim.x * NTHREADS, g0 = blockIdx.x * NTHREADS + c.tid;
    for (int i = g0; i < 2 * 2 * NBLK * BW * 96; i += NT) {
        const int k = i % 96, col = (i / 96) % BW, n = (i / (96 * BW)) % NBLK, mat = (i / (96 * BW * NBLK)) & 1, d = i / (96 * BW * NBLK * 2);
        const float* w = (mat ? c.p.in[16] : c.p.in[14]) + (((size_t)d * NBLK + n) * BW) * BW;
        c.WGATES()[i] = k < BW ? f2bf(w[(size_t)k * BW + col]) : (bf16_t)0;
    }
    for (int i = g0; i < 2 * DR; i += NT) c.LC8()[i] = 8.0f * LOG2E * log1pf(expf(-c.p.in[18][i]));
}
constexpr int L2_U = 0, L2_RAW = 13312, L2_OUT = L2_RAW + 10752, L2_END = L2_OUT + 2 * 64 * BW * 4;
template <bool REV, int PASS>
__device__ __forceinline__ void lru_scan16(const float (&a)[4][4], const float (&b)[4][4], float& cm, float& ptot, float (&h)[4][4], int lane, int fq) {
    const int l16 = REV ? ((lane + 16) & 63) : ((lane - 16) & 63), l32 = REV ? ((lane + 32) & 63) : ((lane - 32) & 63);
    const int ltot = (lane & 15) + (REV ? 0 : 48);
    float P[4], H[4], Pe[4], He[4], Pt[4], Ht[4];
#pragma unroll
    for (int m = 0; m < 4; ++m) {
        P[m] = 1.f; H[m] = 0.f;
#pragma unroll
        for (int jj = 0; jj < 4; ++jj) { const int j = REV ? 3 - jj : jj; H[m] = a[m][j] * H[m] + b[m][j]; P[m] *= a[m][j]; }
    }
    {   float Pp[4], Hp[4];
#pragma unroll
        for (int m = 0; m < 4; ++m) { Pp[m] = __shfl(P[m], l16); Hp[m] = __shfl(H[m], l16); }
#pragma unroll
        for (int m = 0; m < 4; ++m) if (REV ? (fq <= 2) : (fq >= 1)) { H[m] = P[m] * Hp[m] + H[m]; P[m] = P[m] * Pp[m]; }
#pragma unroll
        for (int m = 0; m < 4; ++m) { Pp[m] = __shfl(P[m], l32); Hp[m] = __shfl(H[m], l32); }
#pragma unroll
        for (int m = 0; m < 4; ++m) if (REV ? (fq <= 1) : (fq >= 2)) { H[m] = P[m] * Hp[m] + H[m]; P[m] = P[m] * Pp[m]; }
    }
#pragma unroll
    for (int m = 0; m < 4; ++m) { Pe[m] = __shfl(P[m], l16); He[m] = __shfl(H[m], l16); Pt[m] = __shfl(P[m], ltot); Ht[m] = __shfl(H[m], ltot); }
#pragma unroll
    for (int m = 0; m < 4; ++m) if (REV ? (fq == 3) : (fq == 0)) { Pe[m] = 1.f; He[m] = 0.f; }
#pragma unroll
    for (int mm = 0; mm < 4; ++mm) {
        const int m = REV ? 3 - mm : mm;
        const float hin = Pe[m] * cm + He[m];
        cm = Pt[m] * cm + Ht[m]; ptot *= Pt[m];
        if (PASS == 2) {
            float hh = hin;
#pragma unroll
            for (int jj = 0; jj < 4; ++jj) { const int j = REV ? 3 - jj : jj; hh = a[m][j] * hh + b[m][j]; h[m][j] = hh; }
        }
    }
}
template <int PASS>
__device__ __forceinline__ void ph_lru_pass(Ctx& c) {
    const int wu = __builtin_amdgcn_readfirstlane(c.wid), lane = c.lane, fr = lane & 15, fq = lane >> 4;
    const int dir = wu >> 1, nt0 = (wu & 1) ? 3 : 0, nnt = (wu & 1) ? 2 : 3;
    constexpr int NC = PASS == 1 ? NCH : 64;
    const float* cw = c.p.in[12]; const float* cb = c.p.in[13];
#pragma unroll 1
    for (int unit = vblock(); unit < NB * NC * NBLK; unit += gridDim.x) {
        const int n = unit % NBLK, cidx = (unit / NBLK) % NC + (PASS == 1 ? 0 : 4), b = unit / (NBLK * NC);
        int r0, seq0, seqn;
        if (cidx < 4) { seq0 = TL + b * C; seqn = C; r0 = seq0 + cidx * 64; } else { seq0 = b * S; seqn = S; r0 = seq0 + (cidx - 4) * 64; }
        __syncthreads();
        for (int idx = c.tid; idx < 67 * 10; idx += NTHREADS) {
            const int row = idx / 10, c8i = idx % 10, rr = r0 - 2 + row;
            u32x4 v = (u32x4){0u, 0u, 0u, 0u};
            if (rr >= seq0 && rr < seq0 + seqn) v = *(const u32x4*)(c.PU() + (size_t)rr * DR + n * BW + c8i * 8);
            *(LAS u32x4*)(c.smem + L2_RAW + row * 160 + c8i * 16) = v;
        }
        __syncthreads();
        for (int idx = c.tid; idx < 64 * 20; idx += NTHREADS) {
            const int t = idx / 20, c4 = (idx % 20) * 4, ch = n * BW + c4;
            float u0 = cb[ch], u1 = cb[ch + 1], u2 = cb[ch + 2], u3 = cb[ch + 3];
#pragma unroll
            for (int j = 0; j < 4; ++j) {
                const u32x2 raw = *(const LAS u32x2*)(c.smem + L2_RAW + (t + j) * 160 + c4 * 2);
                const float4 w = *(const float4*)(cw + j * DR + ch);
                u0 += w.x * __uint_as_float(raw.x << 16); u1 += w.y * __uint_as_float(raw.x & 0xffff0000u);
                u2 += w.z * __uint_as_float(raw.y << 16); u3 += w.w * __uint_as_float(raw.y & 0xffff0000u);
            }
            u32x2 o; o.x = pk2(u0, u1); o.y = pk2(u2, u3);
            *(LAS u32x2*)(c.smem + L2_U + (t * LU_PITCH + c4) * 2) = o;
        }
        for (int idx = c.tid; idx < 64 * 3; idx += NTHREADS) { const int t = idx / 3, q = idx % 3; *(LAS u32x4*)(c.smem + L2_U + (t * LU_PITCH + 80 + q * 8) * 2) = (u32x4){0u, 0u, 0u, 0u}; }
        __syncthreads();
        bf16x8 af[4][3];
#pragma unroll
        for (int m = 0; m < 4; ++m)
#pragma unroll
            for (int ks = 0; ks < 3; ++ks) af[m][ks] = *(const LAS bf16x8*)(c.smem + L2_U + (16 * m + fr) * (LU_PITCH * 2) + (ks * 32 + fq * 8) * 2);
        const bf16_t* wbase = c.WGATES() + ((((size_t)dir * 2) * NBLK + n) * BW + fr) * 96 + fq * 8;
        bf16x8 bcur[2][3];
#pragma unroll
        for (int mat = 0; mat < 2; ++mat)
#pragma unroll
            for (int ks = 0; ks < 3; ++ks) bcur[mat][ks] = *(const bf16x8*)(wbase + (size_t)mat * NBLK * BW * 96 + nt0 * 16 * 96 + ks * 32);
#pragma unroll 1
        for (int i = 0; i < nnt; ++i) {
            const int nt = nt0 + i, cl = nt * 16 + fr, ch = n * BW + cl;
            const float bav = c.p.in[15][dir * DR + ch], bxv = c.p.in[17][dir * DR + ch], c8v = c.LC8()[dir * DR + ch];
            float cm = PASS == 1 ? 0.f : c.CARRY()[((size_t)(b * 2 + dir) * NCH + cidx) * DR + ch], ptot = 1.f;
            f32x4 acc[2][4];
#pragma unroll
            for (int mat = 0; mat < 2; ++mat)
#pragma unroll
                for (int m = 0; m < 4; ++m) {
                    acc[mat][m] = (f32x4){0.f, 0.f, 0.f, 0.f};
#pragma unroll
                    for (int ks = 0; ks < 3; ++ks) acc[mat][m] = __builtin_amdgcn_mfma_f32_16x16x32_bf16(af[m][ks], bcur[mat][ks], acc[mat][m], 0, 0, 0);
                }
            if (i + 1 < nnt) {
#pragma unroll
                for (int mat = 0; mat < 2; ++mat)
#pragma unroll
                    for (int ks = 0; ks < 3; ++ks) bcur[mat][ks] = *(const bf16x8*)(wbase + (size_t)mat * NBLK * BW * 96 + (nt + 1) * 16 * 96 + ks * 32);
            }
            float av[4][4], bv[4][4], hv[4][4];
#pragma unroll
            for (int m = 0; m < 4; ++m)
#pragma unroll
                for (int j = 0; j < 4; ++j) {
                    const int t = 16 * m + fq * 4 + j;
                    const float r = fast_sigmoid(acc[0][m][j] + bav), ig = fast_sigmoid(acc[1][m][j] + bxv);
                    const float a = __builtin_amdgcn_exp2f(-c8v * r);
                    const float uv = bf2f(*(const LAS bf16_t*)(c.smem + L2_U + (t * LU_PITCH + cl) * 2));
                    av[m][j] = a; bv[m][j] = __builtin_amdgcn_sqrtf(fmaxf(1.f - a * a, 0.f)) * (ig * uv);
                }
            if (dir == 0) lru_scan16<false, PASS>(av, bv, cm, ptot, hv, lane, fq); else lru_scan16<true, PASS>(av, bv, cm, ptot, hv, lane, fq);
            if (PASS == 1) {
                if (fq == 0) { float* sp = c.sum() + (((size_t)(b * 2 + dir) * NCH + cidx) * 2) * DR + ch; sp[0] = ptot; sp[DR] = cm; }
            } else {
#pragma unroll
                for (int m = 0; m < 4; ++m)
#pragma unroll
                    for (int j = 0; j < 4; ++j) *(LAS float*)(c.smem + L2_OUT + ((dir * 64 + 16 * m + fq * 4 + j) * BW + cl) * 4) = hv[m][j];
            }
        }
        if (PASS == 2) {
            __syncthreads();
            for (int idx = c.tid; idx < 64 * 20; idx += NTHREADS) {
                const int t = idx / 20, c4 = (idx % 20) * 4;
                const f32x4 h0 = *(const LAS f32x4*)(c.smem + L2_OUT + (t * BW + c4) * 4), h1 = *(const LAS f32x4*)(c.smem + L2_OUT + ((64 + t) * BW + c4) * 4);
                bf16_t* gp = c.G() + (size_t)(r0 + t) * DR + n * BW + c4;
                const uint2 g = *(const uint2*)gp;
                st_bf16x4(gp, (h0[0] + h1[0]) * __uint_as_float(g.x << 16), (h0[1] + h1[1]) * __uint_as_float(g.x & 0xffff0000u),
                          (h0[2] + h1[2]) * __uint_as_float(g.y << 16), (h0[3] + h1[3]) * __uint_as_float(g.y & 0xffff0000u));
            }
        }
    }
}
__device__ __forceinline__ void ph_lru_carry(Ctx& c) {
    for (int i = blockIdx.x * NTHREADS + c.tid; i < NB * 2 * DR; i += gridDim.x * NTHREADS) {
        const int ch = i % DR, d = (i / DR) & 1, b = i / (2 * DR);
        const float* sp = c.sum() + ((size_t)(b * 2 + d) * NCH * 2) * DR + ch; float* cp = c.CARRY() + ((size_t)(b * 2 + d) * NCH) * DR + ch;
        float h = 0.f;
#pragma unroll 1
        for (int q = 0; q < 4; ++q) {
            float P[17], Hh[17];
#pragma unroll
            for (int j = 0; j < 17; ++j) { const int s = q * 17 + j, k = d == 0 ? s : (s < 4 ? 3 - s : NCH + 3 - s); P[j] = sp[(size_t)k * 2 * DR]; Hh[j] = sp[(size_t)k * 2 * DR + DR]; }
#pragma unroll
            for (int j = 0; j < 17; ++j) { const int s = q * 17 + j, k = d == 0 ? s : (s < 4 ? 3 - s : NCH + 3 - s); cp[(size_t)k * DR] = h; h = P[j] * h + Hh[j]; }
        }
    }
}


typedef float f32x16 __attribute__((ext_vector_type(16)));
typedef short s16x4 __attribute__((ext_vector_type(4)));
__device__ __forceinline__ s16x4 vtr(const LAS unsigned char* p) { return __builtin_bit_cast(s16x4, __builtin_amdgcn_ds_read_tr16_b64_v4i16((LAS s16x4*)p)); }
constexpr int AT_BUF = 16384;
__device__ __forceinline__ void ph_attn_m(Ctx& c) {
    const int tid = c.tid, lane = c.lane, wu = __builtin_amdgcn_readfirstlane(c.wid), r32 = lane & 31, hi = lane >> 5;
    const float* sinkp = c.p.in[10];
    const int NU = NB * 32 * NH + NB * 2 * NH;
#pragma unroll 1
    for (int unit = vblock(); unit < NU; unit += gridDim.x) {
        int b, qb, h, q0, nt, ilo;
        bool lat = unit < NB * 32 * NH;
        if (lat) { h = unit & 15; qb = (unit >> 4) & 31; b = unit >> 9; q0 = b * S + qb * 128; ilo = (qb == 0) ? 2 : 0; const int ihi = (qb == 31) ? 3 : 5; nt = 4 + (ihi - ilo + 1); }
        else { const int u2 = unit - NB * 32 * NH; h = u2 & 15; qb = (u2 >> 4) & 1; b = u2 >> 5; q0 = TL + b * C + qb * 128; ilo = 0; nt = 4; }
        const int g = h >> 2;
        const bf16_t* kbase = c.Kb() + (size_t)lane * KD + g * 64 + (2 * wu) * 8;
        const bf16_t* vbase = c.Vb() + (size_t)(16 * wu + (lane >> 2)) * KD + g * 64 + (lane & 3) * 8;
#define AT_STAGE(buf, kr0) do { \
        __builtin_amdgcn_global_load_lds((const unsigned*)(kbase + (size_t)(kr0) * KD), (LAS unsigned*)(c.smem + (buf) * AT_BUF + (2 * wu) * 1024), 16, 0, 0); \
        __builtin_amdgcn_global_load_lds((const unsigned*)(kbase + (size_t)(kr0) * KD + 8), (LAS unsigned*)(c.smem + (buf) * AT_BUF + (2 * wu + 1) * 1024), 16, 0, 0); \
        __builtin_amdgcn_global_load_lds((const unsigned*)(vbase + (size_t)(kr0) * KD), (LAS unsigned*)(c.smem + (buf) * AT_BUF + 8192 + wu * 1024), 16, 0, 0); \
        __builtin_amdgcn_global_load_lds((const unsigned*)(vbase + (size_t)(kr0) * KD + 32), (LAS unsigned*)(c.smem + (buf) * AT_BUF + 8192 + 4096 + wu * 1024), 16, 0, 0); } while (0)
#define AT_KR0(j) ((j) < 4 ? (TL + b * C + (j) * 64) : (b * S + qb * 128 - 128 + 64 * (ilo + (j) - 4)))
        bf16x8 qr[4];
        { const bf16_t* qp = c.Qb() + (size_t)(q0 + 32 * wu + r32) * 1024 + h * 64 + hi * 8;
#pragma unroll
          for (int ds = 0; ds < 4; ++ds) qr[ds] = *(const bf16x8*)(qp + ds * 16); }
        float m = sinkp[h] * LOG2E, l = hi == 0 ? 1.f : 0.f;
        f32x16 o0, o1;
#pragma unroll
        for (int r = 0; r < 16; ++r) { o0[r] = 0.f; o1[r] = 0.f; }
        const int qi = 32 * wu + r32;
        const int vaddr = ((lane >> 4) & 1) * 32 + (lane & 3) * 8 + (4 * hi + ((lane & 15) >> 2)) * 64;
        __syncthreads();
        AT_STAGE(0, AT_KR0(0));
        AT_STAGE(1, AT_KR0(1));
        AT_STAGE(2, AT_KR0(2));
#pragma unroll 1
        for (int j = 0; j < nt; ++j) {
            if (j + 2 < nt) asm volatile("s_waitcnt vmcnt(8)" ::: "memory");
            else if (j + 1 < nt) asm volatile("s_waitcnt vmcnt(4)" ::: "memory");
            else asm volatile("s_waitcnt vmcnt(0)" ::: "memory");
            __builtin_amdgcn_s_barrier();
            asm volatile("" ::: "memory");
            if (j + 3 < nt) { const int kr1 = AT_KR0(j + 3); AT_STAGE((j + 3) & 3, kr1); }
            const ldsp_t kb = c.smem + (j & 3) * AT_BUF, vb = kb + 8192;
            f32x16 p0, p1;
#pragma unroll
            for (int r = 0; r < 16; ++r) { p0[r] = 0.f; p1[r] = 0.f; }
#pragma unroll
            for (int ds = 0; ds < 4; ++ds) {
                const bf16x8 k0 = *(const LAS bf16x8*)(kb + (ds * 2 + hi) * 1024 + r32 * 16);
                const bf16x8 k1 = *(const LAS bf16x8*)(kb + (ds * 2 + hi) * 1024 + (32 + r32) * 16);
                p0 = __builtin_amdgcn_mfma_f32_32x32x16_bf16(k0, qr[ds], p0, 0, 0, 0);
                p1 = __builtin_amdgcn_mfma_f32_32x32x16_bf16(k1, qr[ds], p1, 0, 0, 0);
            }
            if (lat && j >= 4) {
                const int i = ilo + j - 4;
                if (i < 2 || i > 3) {
                    const int kj0 = 64 * i + 4 * hi;
#pragma unroll
                    for (int r = 0; r < 16; ++r) {
                        const int kj = kj0 + (r & 3) + 8 * (r >> 2);
                        if (kj < qi || kj > qi + 256) p0[r] = -INFINITY;
                        if (kj + 32 < qi || kj + 32 > qi + 256) p1[r] = -INFINITY;
                    }
                }
            }
            float mx = fmaxf(p0[0], p1[0]);
#pragma unroll
            for (int r = 1; r < 16; ++r) mx = fmaxf(mx, fmaxf(p0[r], p1[r]));
            mx = fmaxf(mx, __shfl_xor(mx, 32));
            const float mn = fmaxf(m, mx);
            const float alpha = __builtin_amdgcn_exp2f(m - mn);
            m = mn;
            float ls = 0.f;
#pragma unroll
            for (int r = 0; r < 16; ++r) { p0[r] = __builtin_amdgcn_exp2f(p0[r] - mn); p1[r] = __builtin_amdgcn_exp2f(p1[r] - mn); ls += p0[r] + p1[r]; }
            l = l * alpha + ls;
            if (__any(alpha != 1.f)) {
#pragma unroll
                for (int r = 0; r < 16; ++r) { o0[r] *= alpha; o1[r] *= alpha; }
            }
#pragma unroll
            for (int sub = 0; sub < 2; ++sub)
#pragma unroll
                for (int sk = 0; sk < 2; ++sk) {
                    u32x4 pw;
                    if (sub == 0) { pw.x = pk2(p0[8 * sk + 0], p0[8 * sk + 1]); pw.y = pk2(p0[8 * sk + 2], p0[8 * sk + 3]); pw.z = pk2(p0[8 * sk + 4], p0[8 * sk + 5]); pw.w = pk2(p0[8 * sk + 6], p0[8 * sk + 7]); }
                    else { pw.x = pk2(p1[8 * sk + 0], p1[8 * sk + 1]); pw.y = pk2(p1[8 * sk + 2], p1[8 * sk + 3]); pw.z = pk2(p1[8 * sk + 4], p1[8 * sk + 5]); pw.w = pk2(p1[8 * sk + 6], p1[8 * sk + 7]); }
                    const bf16x8 pf = __builtin_bit_cast(bf16x8, pw);
                    const int ko = (sub * 32 + sk * 16) * 64;
                    const s16x4 a0 = vtr(vb + vaddr + ko), a1 = vtr(vb + vaddr + ko + 512);
                    const s16x4 b0 = vtr(vb + 4096 + vaddr + ko), b1 = vtr(vb + 4096 + vaddr + ko + 512);
                    const bf16x8 vf0 = (bf16x8){a0[0], a0[1], a0[2], a0[3], a1[0], a1[1], a1[2], a1[3]};
                    const bf16x8 vf1 = (bf16x8){b0[0], b0[1], b0[2], b0[3], b1[0], b1[1], b1[2], b1[3]};
                    o0 = __builtin_amdgcn_mfma_f32_32x32x16_bf16(vf0, pf, o0, 0, 0, 0);
                    o1 = __builtin_amdgcn_mfma_f32_32x32x16_bf16(vf1, pf, o1, 0, 0, 0);
                }
        }
#undef AT_STAGE
#undef AT_KR0
        l += __shfl_xor(l, 32);
        const float rl = 1.f / l;
        bf16_t* op = c.Ob() + (size_t)(q0 + qi) * 1024 + h * 64 + 4 * hi;
#pragma unroll
        for (int g4 = 0; g4 < 4; ++g4) {
            st_bf16x4(op + 8 * g4, o0[4 * g4] * rl, o0[4 * g4 + 1] * rl, o0[4 * g4 + 2] * rl, o0[4 * g4 + 3] * rl);
            st_bf16x4(op + 32 + 8 * g4, o1[4 * g4] * rl, o1[4 * g4 + 1] * rl, o1[4 * g4 + 2] * rl, o1[4 * g4 + 3] * rl);
        }
    }
}


struct Row16 { float v[2][8]; };
__device__ __forceinline__ void row_load(Row16& x, const float* src, int lane) {
#pragma unroll
    for (int j = 0; j < 2; ++j) { const f32x4 a = *(const f32x4*)(src + j * 512 + lane * 8), b = *(const f32x4*)(src + j * 512 + lane * 8 + 4);
        x.v[j][0] = a[0]; x.v[j][1] = a[1]; x.v[j][2] = a[2]; x.v[j][3] = a[3]; x.v[j][4] = b[0]; x.v[j][5] = b[1]; x.v[j][6] = b[2]; x.v[j][7] = b[3]; }
}
__device__ __forceinline__ void row_store(const Row16& x, float* dst, int lane) {
#pragma unroll
    for (int j = 0; j < 2; ++j) { *(f32x4*)(dst + j * 512 + lane * 8) = (f32x4){x.v[j][0], x.v[j][1], x.v[j][2], x.v[j][3]}; *(f32x4*)(dst + j * 512 + lane * 8 + 4) = (f32x4){x.v[j][4], x.v[j][5], x.v[j][6], x.v[j][7]}; }
}
__device__ __forceinline__ float row_rinv(const Row16& x) {
    float ss = 0.f;
#pragma unroll
    for (int j = 0; j < 2; ++j)
#pragma unroll
        for (int e = 0; e < 8; ++e) ss += x.v[j][e] * x.v[j][e];
    return rsqrtf(wave_sum(ss) * (1.0f / D) + RMS_EPS);
}
__device__ __forceinline__ void row_normmod_store(const Row16& x, float rinv, const float* g, const float* shift, const float* scale, bf16_t* dst, int lane) {
#pragma unroll
    for (int j = 0; j < 2; ++j) {
        const int k = j * 512 + lane * 8; float h[8];
#pragma unroll
        for (int q = 0; q < 2; ++q) { const f32x4 gv = *(const f32x4*)(g + k + 4 * q), sh = *(const f32x4*)(shift + k + 4 * q), sc = *(const f32x4*)(scale + k + 4 * q);
#pragma unroll
            for (int e = 0; e < 4; ++e) h[4 * q + e] = (x.v[j][4 * q + e] * rinv * gv[e]) * (1.f + sc[e]) + sh[e]; }
        u32x4 o; o.x = pk2(h[0], h[1]); o.y = pk2(h[2], h[3]); o.z = pk2(h[4], h[5]); o.w = pk2(h[6], h[7]);
        *(u32x4*)(dst + k) = o;
    }
}
__device__ __forceinline__ void row_combine(Row16& x, const bf16_t* Y, int r, const float* g2, int lane) {
#pragma unroll
    for (int j = 0; j < 2; ++j) {
        const int k = j * 512 + lane * 8; float s[8];
#pragma unroll
        for (int e = 0; e < 8; ++e) s[e] = 0.f;
#pragma unroll
        for (int kk = 0; kk < TOPK; ++kk) { const u32x4 y = *(const u32x4*)(Y + ((size_t)r * 8 + kk) * D + k);
            s[0] += __uint_as_float(y.x << 16); s[1] += __uint_as_float(y.x & 0xffff0000u); s[2] += __uint_as_float(y.y << 16); s[3] += __uint_as_float(y.y & 0xffff0000u);
            s[4] += __uint_as_float(y.z << 16); s[5] += __uint_as_float(y.z & 0xffff0000u); s[6] += __uint_as_float(y.w << 16); s[7] += __uint_as_float(y.w & 0xffff0000u); }
        const f32x4 ga = *(const f32x4*)(g2 + k), gb = *(const f32x4*)(g2 + k + 4);
#pragma unroll
        for (int e = 0; e < 4; ++e) { x.v[j][e] += ga[e] * s[e]; x.v[j][4 + e] += gb[e] * s[4 + e]; }
    }
}
__device__ __forceinline__ float* xrow_ptr(Ctx& c, int r) { return r < TL ? c.p.out + (size_t)r * D : c.XC() + (size_t)(r - TL) * D; }
__device__ __forceinline__ void ph_norm1_l0_w(Ctx& c) {
    const float* g = c.p.in[6]; constexpr int RB = 2;
    for (int r0 = (blockIdx.x * 4 + c.wid) * RB; r0 < T0; r0 += gridDim.x * 4 * RB) {
        Row16 x[RB];
#pragma unroll
        for (int i = 0; i < RB; ++i) { const int r = r0 + i; row_load(x[i], r < TL ? c.p.in[0] + (size_t)r * D : c.p.in[2] + (size_t)(r - TL) * D, c.lane); }
#pragma unroll
        for (int i = 0; i < RB; ++i) { const int r = r0 + i; const float* m = c.mod() + mod_row(r) * 6144;
            row_normmod_store(x[i], row_rinv(x[i]), g, m, m + 1024, c.H() + (size_t)r * D, c.lane); }
    }
}
__device__ __forceinline__ void ph_norm2_w(Ctx& c, int layer) {
    const int T = layer == 0 ? T0 : TL; const float* g = c.p.in[7] + layer * D; constexpr int RB = 2;
    for (int r0 = (blockIdx.x * 4 + c.wid) * RB; r0 < T; r0 += gridDim.x * 4 * RB) {
        Row16 x[RB];
#pragma unroll
        for (int i = 0; i < RB; ++i) row_load(x[i], xrow_ptr(c, r0 + i), c.lane);
#pragma unroll
        for (int i = 0; i < RB; ++i) { const int r = r0 + i; const float* m = c.mod() + ((size_t)layer * 5 + mod_row(r)) * 6144;
            row_normmod_store(x[i], row_rinv(x[i]), g, m + 3 * 1024, m + 4 * 1024, c.H() + (size_t)r * D, c.lane); }
    }
}
__device__ __forceinline__ void ph_combine_norm1_w(Ctx& c) {
    const float* g = c.p.in[6] + D; constexpr int RB = 1;
    for (int r0 = (blockIdx.x * 4 + c.wid) * RB; r0 < T0; r0 += gridDim.x * 4 * RB) {
        Row16 x[RB];
#pragma unroll
        for (int i = 0; i < RB; ++i) row_load(x[i], xrow_ptr(c, r0 + i), c.lane);
#pragma unroll
        for (int i = 0; i < RB; ++i) row_combine(x[i], c.Y(), r0 + i, c.mod() + (size_t)mod_row(r0 + i) * 6144 + 5 * 1024, c.lane);
#pragma unroll
        for (int i = 0; i < RB; ++i) { const int r = r0 + i; row_store(x[i], xrow_ptr(c, r), c.lane);
            const float* m = c.mod() + ((size_t)5 + mod_row(r)) * 6144;
            row_normmod_store(x[i], row_rinv(x[i]), g, m, m + 1024, c.H() + (size_t)r * D, c.lane); }
    }
}
__device__ __forceinline__ void ph_final_w(Ctx& c) {
    const float* g = c.p.in[28]; constexpr int RB = 1;
    for (int r0 = (blockIdx.x * 4 + c.wid) * RB; r0 < TL; r0 += gridDim.x * 4 * RB) {
        Row16 x[RB];
#pragma unroll
        for (int i = 0; i < RB; ++i) row_load(x[i], c.p.out + (size_t)(r0 + i) * D, c.lane);
#pragma unroll
        for (int i = 0; i < RB; ++i) row_combine(x[i], c.Y(), r0 + i, c.mod() + ((size_t)5 + mod_row(r0 + i)) * 6144 + 5 * 1024, c.lane);
#pragma unroll
        for (int i = 0; i < RB; ++i) {
            const float rinv = row_rinv(x[i]);
#pragma unroll
            for (int j = 0; j < 2; ++j) { const int k = j * 512 + c.lane * 8; const f32x4 ga = *(const f32x4*)(g + k), gb = *(const f32x4*)(g + k + 4);
#pragma unroll
                for (int e = 0; e < 4; ++e) { x[i].v[j][e] = x[i].v[j][e] * rinv * ga[e]; x[i].v[j][4 + e] = x[i].v[j][4 + e] * rinv * gb[e]; } }
            row_store(x[i], c.p.out + (size_t)(r0 + i) * D, c.lane);
        }
    }
}
struct MEpiRouter { ldsp_t lg;
    __device__ __forceinline__ void operator()(f32x4 (&acc)[4][8], ldsp_t wl, int rbase, int cbase, int lane) const {
        const int fr = lane & 15, fq = lane >> 4, rl = (rbase & 127);
#pragma unroll
        for (int m = 0; m < 4; ++m)
#pragma unroll
            for (int n = 0; n < 2; ++n)
#pragma unroll
                for (int j = 0; j < 4; ++j) *(LAS float*)(lg + ((rl + m * 16 + fr) * 65 + cbase + n * 16 + fq * 4 + j) * 4) = acc[m][n][j];
        __syncthreads();
    }
};
__device__ __forceinline__ void ph_route_m(Ctx& c, int layer) {
    const int T = layer == 0 ? T0 : TL;
    const RowPlain rp{c.H(), D};
    const MEpiRouter ep{c.smem};
    for (int mt = vblock(); mt < T / 128; mt += gridDim.x) {
        router_tile(c.smem, c.H(), c.WROUTER() + (size_t)layer * 128 * D, D, ep, mt * 128);
        LAS unsigned* lcnt = (LAS unsigned*)(c.smem + 128 * 65 * 4);
        if (c.tid < NE) lcnt[c.tid] = 0u;
        __syncthreads();
        int se[TOPK]; float ss[TOPK]; unsigned lp[TOPK]; float norm = 0.f;
        if (c.tid < 128) {
            const LAS float* sc = (const LAS float*)c.smem + c.tid * 65;
            const float* bp = c.p.in[21] + layer * NE;
            float s_[NE], v_[NE];
#pragma unroll
            for (int e = 0; e < NE; ++e) s_[e] = fast_sigmoid(sc[e]);
            float gs[8];
#pragma unroll
            for (int g = 0; g < 8; ++g) {
                float m1 = -INFINITY, m2 = -INFINITY;
#pragma unroll
                for (int i = 0; i < 8; ++i) { const float v = s_[g * 8 + i] + bp[g * 8 + i]; m2 = v > m1 ? m1 : fmaxf(m2, v); m1 = fmaxf(m1, v); }
                gs[g] = m1 + m2;
            }
            unsigned gmask = 0;
#pragma unroll
            for (int it = 0; it < 4; ++it) {
                float best = -INFINITY; int bi = 0;
#pragma unroll
                for (int g = 0; g < 8; ++g) { const bool used = (gmask >> g) & 1u; if (!used && gs[g] > best) { best = gs[g]; bi = g; } }
                gmask |= 1u << bi;
            }
#pragma unroll
            for (int e = 0; e < NE; ++e) v_[e] = ((gmask >> (e >> 3)) & 1u) ? s_[e] + bp[e] : -INFINITY;
            float wsum = 0.f;
#pragma unroll
            for (int it = 0; it < TOPK; ++it) {
                float best = -INFINITY, bs = 0.f; int bi = 0;
#pragma unroll
                for (int e = 0; e < NE; ++e) { const bool t = v_[e] > best; best = t ? v_[e] : best; bi = t ? e : bi; bs = t ? s_[e] : bs; }
#pragma unroll
                for (int e = 0; e < NE; ++e) v_[e] = (e == bi) ? -INFINITY : v_[e];
                se[it] = bi; ss[it] = bs; wsum += bs;
            }
            norm = 2.5f / wsum;
#pragma unroll
            for (int k = 0; k < TOPK; ++k) lp[k] = __hip_atomic_fetch_add(&lcnt[se[k]], 1u, __ATOMIC_RELAXED, __HIP_MEMORY_SCOPE_WORKGROUP);
        }
        __syncthreads();
        if (c.tid < NE) { const unsigned n = lcnt[c.tid]; lcnt[NE + c.tid] = n ? atomicAdd(&c.cnt()[layer * 64 + c.tid], n) : 0u; }
        __syncthreads();
        if (c.tid < 128) {
            const int t = mt * 128 + c.tid;
#pragma unroll
            for (int k = 0; k < TOPK; ++k) {
                const int e = se[k]; const int pos = (int)(lcnt[NE + e] + lp[k]); const int a = t * 8 + k;
                c.AE()[a] = e; c.APOS()[a] = pos; c.AW()[a] = ss[k] * norm; c.LIST()[(size_t)e * T0 + pos] = a;
            }
        }
    }
}

__global__ void __launch_bounds__(NTHREADS, 2) mega(const Params p) {
    __shared__ __attribute__((aligned(16))) unsigned char smem[LDS_LRU_END + 16 + 1024];
    float* lds = (float*)smem;
    Ctx c(p, lds, (ldsp_t)smem);
    volatile unsigned* st = (volatile unsigned*)(smem + LDS_LRU_END);
    if (c.tid < 4) st[c.tid] = 0u;
    __syncthreads();
    const XcdBarrier bar = xcd_barrier_post((unsigned*)(p.ws + CTL_BAR), st);
#define GB() xcd_barrier(bar)
#define REPEAT(n, stmt) do { for (int rep_ = 0; rep_ < (n); ++rep_) { stmt; if (rep_ + 1 < (n)) GB(); } } while (0)
    REPEAT(REP_PREP, (ph_prep(c), ph_convert_small(c), ph_convert_gates(c), ph_convert_moe(c, 0))); GB();
    {
        if (c.tid == 0) {
            unsigned* ctl = (unsigned*)(p.ws + CTL_BAR);
            const unsigned tk = xb_add((unsigned*)(p.ws + CTL_TICKET) + 64 * bar.x, 1u);
            unsigned base = 0u;
            for (unsigned j = 0; j < 16; ++j) { const unsigned n = xb_ld(&ctl[XB_XCNT(j)]); base += (j < bar.x) ? n : 0u; }
            st[2] = base + tk;
        }
        __syncthreads();
        c.vb = __builtin_amdgcn_readfirstlane((int)st[2]);
    }
    ph_norm1_l0_w(c); GB();
    REPEAT(REP_QKV, ph_qkv_m(c)); GB();
    REPEAT(REP_ATTN, ph_attn_m(c)); GB();
    ph_oproj_m(c); GB();
    REPEAT(REP_NORM2, ph_norm2_w(c, 0)); GB();
    ph_route_m(c, 0); GB();
    REPEAT(REP_GATEUP, ph_moe_gateup_m(c, 0, T0)); GB();
    ph_moe_down_m(c, 0, T0); GB();
    ph_combine_norm1_w(c); ph_convert_moe(c, 1); GB();
    REPEAT(REP_INPROJ, ph_inproj_m(c)); GB();
    REPEAT(REP_LRU1, ph_lru_pass<1>(c)); GB();
    ph_lru_carry(c); GB();
    ph_lru_pass<2>(c); GB();
    ph_outproj_m(c); GB();
    ph_norm2_w(c, 1); GB();
    ph_route_m(c, 1); GB();
    ph_moe_gateup_m(c, 1, TL); GB();
    ph_moe_down_m(c, 1, TL); GB();
    ph_final_w(c);
#undef GB
}
}

extern "C" void kernel_launch(void* const* d_in, const int* in_sizes, int n_in, void* d_out, int out_size, void* d_ws, size_t ws_size, hipStream_t stream) {
    if (n_in != 29 || ws_size < WS_END) { fprintf(stderr, "kernel_launch: unexpected n_in %d or ws_size %zu (< %zu)\n", n_in, ws_size, (size_t)WS_END); return; }
    static int grid = 0;
    if (grid == 0) {
        int dev = 0, cus = 0, per_cu = 0;
        hipGetDevice(&dev);
        hipDeviceGetAttribute(&cus, hipDeviceAttributeMultiprocessorCount, dev);
        hipOccupancyMaxActiveBlocksPerMultiprocessor(&per_cu, (const void*)mega, NTHREADS, 0);
        if (per_cu > 2) per_cu = 2;
        if (per_cu < 1) per_cu = 1;
        grid = cus * per_cu;
    }
    hipMemsetAsync((char*)d_ws + WS_CTL, 0, CTL_BYTES, stream);
    Params p{};
    for (int i = 0; i < 29; ++i) p.in[i] = (const float*)d_in[i];
    p.out = (float*)d_out; p.ws = (unsigned char*)d_ws;
    p.ph_lo = 0; p.ph_hi = 20;
    void* args[] = {&p};
    hipError_t e = hipLaunchCooperativeKernel((const void*)mega, dim3(grid), dim3(NTHREADS), args, 0, stream);
    if (e != hipSuccess) fprintf(stderr, "cooperative launch failed: %s (grid %d)\n", hipGetErrorString(e), grid);
}
```

```cpp
#include <hip/hip_runtime.h>
#include <stdint.h>
#include <cstdio>

namespace {
typedef unsigned short bf16_t;
constexpr int D = 1024, NB = 4, S = 4096, C = 256, TL = NB * S, TC = NB * C, T0 = TL + TC;
constexpr int NH = 16, NKV = 4, HD = 64, KD = 256, QKVN = 1536;
constexpr int DR = 1280, NBLK = 16, BW = 80;
constexpr int NE = 64, TOPK = 8, DE = 256;
constexpr float RMS_EPS = 1e-6f;
constexpr float LOG2E = 1.4426950408889634f;
constexpr float QSCALE = 0.125f * LOG2E;
constexpr int NTHREADS = 256;
constexpr int REP_PREP = 1, REP_QKV = 1, REP_ATTN = 1, REP_GATEUP = 1, REP_INPROJ = 1, REP_LRU1 = 1, REP_NORM2 = 1;
constexpr int LDS_U = 0, LDS_A = 13312, LDS_B0 = LDS_A + 20480, LDS_B1 = LDS_B0 + 20480, LDS_LRU_END = LDS_B1 + 20480;

constexpr size_t MiB = 1u << 20;
constexpr size_t WS_CTL = 0, CTL_BYTES = 1 * MiB;
constexpr size_t CTL_BAR = 0;
constexpr size_t CTL_TICKET = 16384;
constexpr size_t CTL_CNT = 32768;
constexpr size_t CTL_MOD = 65536;
constexpr size_t WS_ROPE = 1 * MiB + 512 * 1024;
constexpr size_t WS_SUM = 2 * MiB;
constexpr size_t WS_AE = 8 * MiB;
constexpr size_t WS_AW = WS_AE + 640 * 1024;
constexpr size_t WS_APOS = WS_AW + 640 * 1024;
constexpr size_t WS_LIST = 10 * MiB;
constexpr size_t WS_XC = 15 * MiB;
constexpr size_t WS_WQKV = 19 * MiB, WS_WO = 22 * MiB, WS_WIN = 24 * MiB, WS_WOUT = 29 * MiB, WS_WGATES = 32 * MiB, WS_WROUTER = 33 * MiB, WS_WSH = 34 * MiB;
constexpr size_t WSH_LAYER = 1536 * 1024, WSH_D = 1024 * 1024;
constexpr size_t WMOE_D = 64 * MiB;
constexpr size_t WS_WMOE = 37 * MiB;
constexpr size_t WS_H = 138 * MiB;
constexpr size_t WS_ACT = 172 * MiB;
constexpr size_t WS_ACTS = 240 * MiB;
constexpr size_t WS_BIG = 249 * MiB;
constexpr size_t WS_Q = WS_BIG, WS_K = WS_BIG + 34 * MiB, WS_V = WS_K + 9 * MiB, WS_O = WS_V + 9 * MiB;
constexpr size_t WS_G = WS_BIG, WS_PU = WS_BIG + 40 * MiB, WS_AB = WS_BIG + 83 * MiB;
constexpr size_t WS_CARRY = WS_BIG + 84 * MiB;
constexpr size_t WS_LC8 = 1 * MiB + 640 * 1024;
constexpr size_t WS_END = 521 * MiB;

struct Params {
    const float* in[29];
    float* out;
    unsigned char* ws;
    int ph_lo, ph_hi;
};

__device__ __forceinline__ float bf2f(bf16_t h) { return __uint_as_float(((unsigned)h) << 16); }
__device__ __forceinline__ bf16_t f2bf(float f) { unsigned u = __float_as_uint(f); return (bf16_t)((u + 0x7fffu + ((u >> 16) & 1u)) >> 16); }
__device__ __forceinline__ float silu_f(float v) { return v * __builtin_amdgcn_rcpf(1.f + __builtin_amdgcn_exp2f(-LOG2E * v)); }
__device__ __forceinline__ float gelu_tanh(float v) { const float u = 0.7978845608028654f * (v + 0.044715f * v * v * v); return v * __builtin_amdgcn_rcpf(1.f + __builtin_amdgcn_exp2f(-2.f * LOG2E * u)); }
__device__ __forceinline__ float wave_sum(float v) {
#pragma unroll
    for (int o = 32; o > 0; o >>= 1) v += __shfl_xor(v, o);
    return v;
}
__device__ __forceinline__ int mod_row(int r) { return r < TL ? (r >> 12) : 4; }

#define XB_TMO      128
#define XB_XCNT(j)  (256  + 64 * (j))
#define XB_XSUB(j)  (1280 + 64 * (j))
#define XB_XGEN(j)  (2304 + 64 * (j))
#define XB_TOP      3328
#define XB_TOPGEN   3392
#define XCD_BAR_WORDS 3456
#define XB_SPIN_CAP (1u << 22)
#define LAS __attribute__((address_space(3)))
__device__ __forceinline__ unsigned xb_ld(unsigned* p)              { return __hip_atomic_load(p, __ATOMIC_RELAXED, __HIP_MEMORY_SCOPE_AGENT); }
__device__ __forceinline__ unsigned xb_add(unsigned* p, unsigned v) { return __hip_atomic_fetch_add(p, v, __ATOMIC_RELAXED, __HIP_MEMORY_SCOPE_AGENT); }
__device__ __forceinline__ unsigned xb_xcc_id() { return (unsigned)__builtin_amdgcn_s_getreg((3 << 11) | 20) & 0xFu; }
#define XB_SPIN(cond, bar) do { unsigned _sp = 0; while (cond) { __builtin_amdgcn_s_sleep(1); \
    if ((++_sp & 255u) == 0u) { if (xb_ld(&(bar)[XB_TMO])) break; if (_sp > XB_SPIN_CAP) { atomicAdd(&(bar)[XB_TMO], 1u); break; } } } } while (0)
struct XcdBarrier { unsigned* bar; unsigned x; volatile unsigned* st; };
__device__ __forceinline__ XcdBarrier xcd_barrier_post(unsigned* bar, volatile unsigned* st) {
    XcdBarrier b; b.bar = bar; b.x = xb_xcc_id(); b.st = st;
    if (threadIdx.x == 0) (void)xb_add(&bar[XB_XCNT(b.x)], 1u);
    return b;
}
__device__ __forceinline__ void xcd_barrier_complete(unsigned* bar, unsigned x, unsigned& nloc, unsigned& nx) {
    const unsigned G = gridDim.x * gridDim.y * gridDim.z;
    unsigned sum, cnt, mine, sp = 0u;
    for (;;) {
        sum = 0u; cnt = 0u; mine = 0u;
#pragma unroll
        for (unsigned j = 0; j < 16; ++j) { const unsigned c = xb_ld(&bar[XB_XCNT(j)]); sum += c; cnt += (c > 0u) ? 1u : 0u; mine = (j == x) ? c : mine; }
        if (sum == G) break;
        __builtin_amdgcn_s_sleep(1);
        if ((++sp & 255u) == 0u) { if (xb_ld(&bar[XB_TMO])) break; if (sp > XB_SPIN_CAP) { atomicAdd(&bar[XB_TMO], 1u); break; } }
    }
    nloc = mine > 0u ? mine : 1u; nx = cnt > 0u ? cnt : 1u;
}
__device__ __forceinline__ void xcd_barrier(const XcdBarrier& b) {
    asm volatile("s_waitcnt vmcnt(0)" ::: "memory");
    __syncthreads();
    if (threadIdx.x == 0) {
        unsigned* bar = b.bar;
        __builtin_amdgcn_s_waitcnt(0);
        unsigned nloc = b.st[0], nx = b.st[1];
        if (nloc == 0u) { xcd_barrier_complete(bar, b.x, nloc, nx); b.st[0] = nloc; b.st[1] = nx; }
        const unsigned old = xb_add(&bar[XB_XSUB(b.x)], 1u);
        const unsigned gen = old / nloc;
        if (old + 1u == (gen + 1u) * nloc) {
            __builtin_amdgcn_fence(__ATOMIC_RELEASE, "agent");
            asm volatile("s_waitcnt vmcnt(0)" ::: "memory");
            const unsigned og = xb_add(&bar[XB_TOP], 1u);
            const unsigned tg = og / nx;
            if (og + 1u == (tg + 1u) * nx) xb_add(&bar[XB_TOPGEN], 1u);
            else XB_SPIN(xb_ld(&bar[XB_TOPGEN]) == tg, bar);
            __builtin_amdgcn_fence(__ATOMIC_ACQUIRE, "agent");
            xb_add(&bar[XB_XGEN(b.x)], 1u);
            asm volatile("s_waitcnt vmcnt(0)" ::: "memory");
        } else {
            XB_SPIN(xb_ld(&bar[XB_XGEN(b.x)]) == gen, bar);
            __builtin_amdgcn_fence(__ATOMIC_ACQUIRE, "agent");
            asm volatile("s_waitcnt vmcnt(0)" ::: "memory");
        }
    }
    __syncthreads();
}


typedef short bf16x8 __attribute__((ext_vector_type(8)));
typedef float f32x4 __attribute__((ext_vector_type(4)));
typedef unsigned u32x4 __attribute__((ext_vector_type(4)));
typedef unsigned u32x2 __attribute__((ext_vector_type(2)));
typedef LAS unsigned char* ldsp_t;
constexpr int EP_WAVE = 17408;
constexpr int GT_STG = 24576;
template <class RowPtr, class Epi>
__device__ __forceinline__ void mfma_tile(ldsp_t lds, const RowPtr& rp, const bf16_t* Bt, int K, const Epi& ep, int row0, int col0) {
    int tid_ = threadIdx.x; asm volatile("" : "+v"(tid_));
    const int tid = tid_, lane = tid & 63, wid = __builtin_amdgcn_readfirstlane(tid >> 6), wr = wid >> 1, wc = wid & 1, fr = lane & 15, fq = lane >> 4;
    const int sch = ((tid & 3) ^ ((-(tid >> 4)) & 3)) * 8;
    const bf16_t* ap0 = rp(row0 + (tid >> 2)) + sch;
    const bf16_t* ap1 = rp(row0 + 64 + (tid >> 2)) + sch;
    const bf16_t* bp = Bt + (size_t)(tid >> 2) * K + sch;
    const size_t bstep = (size_t)64 * K;
    const int cterm = ((fq ^ ((-(fr >> 2)) & 3)) << 4);
    const int aoff = (wr * 64 + fr) * 64 + cterm, boff = 8192 + (wc * 128 + fr) * 64 + cterm;
    f32x4 acc[4][8];
#pragma unroll
    for (int m = 0; m < 4; ++m)
#pragma unroll
        for (int n = 0; n < 8; ++n) acc[m][n] = (f32x4){0.f, 0.f, 0.f, 0.f};
#define GT_STAGE(sb, k0) do { const ldsp_t d_ = lds + (sb) + wid * 1024; \
        __builtin_amdgcn_global_load_lds((const unsigned*)(ap0 + (k0)), (LAS unsigned*)(d_), 16, 0, 0); \
        __builtin_amdgcn_global_load_lds((const unsigned*)(ap1 + (k0)), (LAS unsigned*)(d_ + 4096), 16, 0, 0); \
        _Pragma("unroll") for (int i_ = 0; i_ < 4; ++i_) \
            __builtin_amdgcn_global_load_lds((const unsigned*)(bp + i_ * bstep + (k0)), (LAS unsigned*)(d_ + 8192 + i_ * 4096), 16, 0, 0); } while (0)
    const int nt = K >> 5;
    asm volatile("s_waitcnt lgkmcnt(0)" ::: "memory");
    __builtin_amdgcn_s_barrier();
    asm volatile("" ::: "memory");
    GT_STAGE(0, 0);
    GT_STAGE(GT_STG, 32);
    int scur = 0, snx = 2 * GT_STG;
#pragma unroll 1
    for (int t = 0; t < nt; ++t) {
        if (t + 1 < nt) asm volatile("s_waitcnt vmcnt(6)" ::: "memory"); else asm volatile("s_waitcnt vmcnt(0)" ::: "memory");
        __builtin_amdgcn_s_barrier();
        asm volatile("" ::: "memory");
        if (t + 2 < nt) GT_STAGE(snx, (t + 2) * 32);
        const ldsp_t base = lds + scur;
        bf16x8 af[4], bfr[8];
#pragma unroll
        for (int m = 0; m < 4; ++m) af[m] = *(const LAS bf16x8*)(base + aoff + m * 1024);
#pragma unroll
        for (int n = 0; n < 8; ++n) bfr[n] = *(const LAS bf16x8*)(base + boff + n * 1024);
#pragma unroll
        for (int m = 0; m < 4; ++m)
#pragma unroll
            for (int n = 0; n < 8; ++n) acc[m][n] = __builtin_amdgcn_mfma_f32_16x16x32_bf16(bfr[n], af[m], acc[m][n], 0, 0, 0);
        scur = (scur == 2 * GT_STG) ? 0 : scur + GT_STG;
        snx = (snx == 2 * GT_STG) ? 0 : snx + GT_STG;
    }
#undef GT_STAGE
    __syncthreads();
    ep(acc, lds + wid * EP_WAVE, row0 + wr * 64, col0 + wc * 128, lane);
}
constexpr int RT_STG = 12288, RT_NS = 6;
template <class Epi>
__device__ __forceinline__ void router_tile(ldsp_t lds, const bf16_t* A, const bf16_t* Bt, int K, const Epi& ep, int row0) {
    int tid_ = threadIdx.x; asm volatile("" : "+v"(tid_));
    const int tid = tid_, lane = tid & 63, wid = __builtin_amdgcn_readfirstlane(tid >> 6), wr = wid >> 1, wc = wid & 1, fr = lane & 15, fq = lane >> 4;
    const int sch = ((tid & 3) ^ ((-(tid >> 4)) & 3)) * 8;
    const bf16_t* ap0 = A + (size_t)(row0 + (tid >> 2)) * K + sch;
    const bf16_t* ap1 = ap0 + (size_t)64 * K;
    const bf16_t* bp = Bt + (size_t)(tid >> 2) * K + sch;
    const int cterm = ((fq ^ ((-(fr >> 2)) & 3)) << 4);
    const int aoff = (wr * 64 + fr) * 64 + cterm, boff = 8192 + (wc * 32 + fr) * 64 + cterm;
    f32x4 acc[4][8];
#pragma unroll
    for (int m = 0; m < 4; ++m)
#pragma unroll
        for (int n = 0; n < 8; ++n) acc[m][n] = (f32x4){0.f, 0.f, 0.f, 0.f};
#define RT_STAGE(sb, k0) do { const ldsp_t d_ = lds + (sb) + wid * 1024; \
        __builtin_amdgcn_global_load_lds((const unsigned*)(ap0 + (k0)), (LAS unsigned*)(d_), 16, 0, 0); \
        __builtin_amdgcn_global_load_lds((const unsigned*)(ap1 + (k0)), (LAS unsigned*)(d_ + 4096), 16, 0, 0); \
        __builtin_amdgcn_global_load_lds((const unsigned*)(bp + (k0)), (LAS unsigned*)(d_ + 8192), 16, 0, 0); } while (0)
    const int nt = K >> 5;
    asm volatile("s_waitcnt lgkmcnt(0)" ::: "memory");
    __builtin_amdgcn_s_barrier();
    asm volatile("" ::: "memory");
#pragma unroll
    for (int q = 0; q < RT_NS - 1; ++q) RT_STAGE(q * RT_STG, q * 32);
    int scur = 0, snx = (RT_NS - 1) * RT_STG;
#pragma unroll 1
    for (int t = 0; t < nt; ++t) {
        if (t + RT_NS - 1 <= nt) asm volatile("s_waitcnt vmcnt(12)" ::: "memory");
        else asm volatile("s_waitcnt vmcnt(0)" ::: "memory");
        __builtin_amdgcn_s_barrier();
        asm volatile("" ::: "memory");
        if (t + RT_NS - 1 < nt) RT_STAGE(snx, (t + RT_NS - 1) * 32);
        const ldsp_t base = lds + scur;
        bf16x8 af[4], bfr[2];
#pragma unroll
        for (int m = 0; m < 4; ++m) af[m] = *(const LAS bf16x8*)(base + aoff + m * 1024);
#pragma unroll
        for (int n = 0; n < 2; ++n) bfr[n] = *(const LAS bf16x8*)(base + boff + n * 1024);
#pragma unroll
        for (int m = 0; m < 4; ++m)
#pragma unroll
            for (int n = 0; n < 2; ++n) acc[m][n] = __builtin_amdgcn_mfma_f32_16x16x32_bf16(bfr[n], af[m], acc[m][n], 0, 0, 0);
        scur = (scur == (RT_NS - 1) * RT_STG) ? 0 : scur + RT_STG;
        snx = (snx == (RT_NS - 1) * RT_STG) ? 0 : snx + RT_STG;
    }
#undef RT_STAGE
    __syncthreads();
    ep(acc, lds, row0 + wr * 64, wc * 32, lane);
}
typedef float f32x2_t __attribute__((ext_vector_type(2))); typedef __bf16 bf16x2_t __attribute__((ext_vector_type(2)));
__device__ __forceinline__ unsigned pk2(float lo, float hi) { f32x2_t v = {lo, hi}; bf16x2_t b = __builtin_convertvector(v, bf16x2_t); return __builtin_bit_cast(unsigned, b); }
__device__ __forceinline__ void st_bf16x4(bf16_t* p, float a, float b, float c, float d) { uint2 o; o.x = pk2(a, b); o.y = pk2(c, d); *(uint2*)p = o; }

struct RowPlain { const bf16_t* A; int lda; __device__ __forceinline__ const bf16_t* operator()(int r) const { return A + (size_t)r * lda; } };

constexpr int EPB = 272;
constexpr int EPF = 528;
__device__ __forceinline__ void ep_put4(ldsp_t wl, int row, int col, float a, float b, float c, float d) { u32x2 o; o.x = pk2(a, b); o.y = pk2(c, d); *(LAS u32x2*)(wl + row * EPB + col * 2) = o; }
struct MEpiQKV {
    bf16_t *Q, *K, *V; const float* rope;
    __device__ __forceinline__ void operator()(f32x4 (&acc)[4][8], ldsp_t wl, int rbase, int cbase0, int lane) const {
        const int fr = lane & 15, fq = lane >> 4;
#pragma unroll
        for (int hh = 0; hh < 2; ++hh) {
            const int cbase = cbase0 + hh * 64;
            const bool isq = cbase < 1024, isk = (cbase >= 1024 && cbase < 1280);
#pragma unroll
            for (int m = 0; m < 4; ++m) {
                const int r = rbase + m * 16 + fr;
                f32x4 v0 = acc[m][hh * 4 + 0], v1 = acc[m][hh * 4 + 1], v2 = acc[m][hh * 4 + 2], v3 = acc[m][hh * 4 + 3];
                if ((isq || isk) && r < TL) {
                    const int s = r & (S - 1), prow = s >> 6, pcol = s & 63;
                    const f32x4 cr = *(const f32x4*)(rope + prow * 16 + fq * 4), sr = *(const f32x4*)(rope + 1024 + prow * 16 + fq * 4);
                    const f32x4 cc = *(const f32x4*)(rope + pcol * 16 + fq * 4), sc = *(const f32x4*)(rope + 1024 + pcol * 16 + fq * 4);
                    const f32x4 o0 = v0 * cr - v1 * sr, o1 = v1 * cr + v0 * sr, o2 = v2 * cc - v3 * sc, o3 = v3 * cc + v2 * sc;
                    v0 = o0; v1 = o1; v2 = o2; v3 = o3;
                }
                if (isq) { v0 *= QSCALE; v1 *= QSCALE; v2 *= QSCALE; v3 *= QSCALE; }
                const int rl = m * 16 + fr, cl = hh * 64 + fq * 4;
                ep_put4(wl, rl, cl, v0[0], v0[1], v0[2], v0[3]); ep_put4(wl, rl, cl + 16, v1[0], v1[1], v1[2], v1[3]);
                ep_put4(wl, rl, cl + 32, v2[0], v2[1], v2[2], v2[3]); ep_put4(wl, rl, cl + 48, v3[0], v3[1], v3[2], v3[3]);
            }
        }
        const bool isq = cbase0 < 1024, isk = (cbase0 >= 1024 && cbase0 < 1280);
        bf16_t* base = isq ? (Q + cbase0) : isk ? (K + (cbase0 - 1024)) : (V + (cbase0 - 1280));
        const size_t pitch = isq ? 1024 : 256;
#pragma unroll 2
        for (int i = 0; i < 16; ++i) {
            const int rl = 4 * i + (lane >> 4), ch = lane & 15;
            const u32x4 v = *(const LAS u32x4*)(wl + rl * EPB + ch * 16);
            *(u32x4*)(base + (size_t)(rbase + rl) * pitch + ch * 8) = v;
        }
    }
};
struct MEpiResid {
    const float* srcL; const float* srcC; float* dstL; float* dstC; const float* mod; int gchunk;
    __device__ __forceinline__ void operator()(f32x4 (&acc)[4][8], ldsp_t wl, int rbase, int cbase, int lane) const {
        const int fr = lane & 15, fq = lane >> 4, c4 = (lane & 31) * 4;
        const f32x4 gv = *(const f32x4*)(mod + mod_row(rbase) * 6144 + gchunk * 1024 + cbase + c4);
        const bool latent = rbase < TL;
        const float* sbase = (latent ? srcL + (size_t)rbase * D : srcC + (size_t)(rbase - TL) * D) + cbase + c4 + (size_t)(lane >> 5) * D;
        float* dbase = (latent ? dstL + (size_t)rbase * D : dstC + (size_t)(rbase - TL) * D) + cbase + c4 + (size_t)(lane >> 5) * D;
#pragma unroll
        for (int half = 0; half < 2; ++half) {
#pragma unroll
            for (int mm = 0; mm < 2; ++mm)
#pragma unroll
                for (int n = 0; n < 8; ++n) *(LAS f32x4*)(wl + (mm * 16 + fr) * EPF + (n * 16 + fq * 4) * 4) = acc[half * 2 + mm][n];
#pragma unroll
            for (int q = 0; q < 2; ++q) {
                f32x4 sv[8];
#pragma unroll
                for (int i = 0; i < 8; ++i) sv[i] = *(const f32x4*)(sbase + (size_t)(half * 32 + 16 * q + 2 * i) * D);
#pragma unroll
                for (int i = 0; i < 8; ++i) {
                    const int rl = 16 * q + 2 * i + (lane >> 5);
                    const f32x4 v = *(const LAS f32x4*)(wl + rl * EPF + c4 * 4);
                    *(f32x4*)(dbase + (size_t)(half * 32 + 16 * q + 2 * i) * D) = sv[i] + gv * v;
                }
            }
        }
    }
};
struct MEpiInProj {
    bf16_t* G; bf16_t* PU;
    __device__ __forceinline__ void operator()(f32x4 (&acc)[4][8], ldsp_t wl, int rbase, int cbase, int lane) const {
        const int fr = lane & 15, fq = lane >> 4;
        const bool isg = cbase < DR;
#pragma unroll
        for (int m = 0; m < 4; ++m)
#pragma unroll
            for (int n = 0; n < 8; ++n) {
                const f32x4 v = acc[m][n];
                if (isg) ep_put4(wl, m * 16 + fr, n * 16 + fq * 4, gelu_tanh(v[0]), gelu_tanh(v[1]), gelu_tanh(v[2]), gelu_tanh(v[3]));
                else ep_put4(wl, m * 16 + fr, n * 16 + fq * 4, v[0], v[1], v[2], v[3]);
            }
        bf16_t* base = isg ? (G + cbase) : (PU + (cbase - DR));
#pragma unroll 2
        for (int i = 0; i < 16; ++i) {
            const int rl = 4 * i + (lane >> 4), ch = lane & 15, r = rbase + rl;
            const u32x4 v = *(const LAS u32x4*)(wl + rl * EPB + ch * 16);
            if (!isg || r < TL) *(u32x4*)(base + (size_t)r * DR + ch * 8) = v;
        }
    }
};
#define vblock() (c.vb)

template <class RowMap>
__device__ __forceinline__ void tr_item64(const float* W, int ldw, int k0, int n0, bf16_t* dst, int ldd, const RowMap& rm, int lane) {
    const int nq = lane >> 3, kg = lane & 7;
    f32x4 v[16];
    const float* src = W + (size_t)(k0 + kg * 8) * ldw + n0 + 4 * nq;
#pragma unroll
    for (int h = 0; h < 2; ++h)
#pragma unroll
        for (int i = 0; i < 8; ++i) v[h * 8 + i] = *(const f32x4*)(src + (size_t)i * ldw + h * 32);
#pragma unroll
    for (int h = 0; h < 2; ++h)
#pragma unroll
        for (int cc = 0; cc < 4; ++cc) {
            bf16_t* drow = dst + (size_t)rm(n0 + h * 32 + 4 * nq + cc) * ldd + k0 + kg * 8;
            u32x4 o; o.x = pk2(v[h * 8 + 0][cc], v[h * 8 + 1][cc]); o.y = pk2(v[h * 8 + 2][cc], v[h * 8 + 3][cc]); o.z = pk2(v[h * 8 + 4][cc], v[h * 8 + 5][cc]); o.w = pk2(v[h * 8 + 6][cc], v[h * 8 + 7][cc]);
            *(u32x4*)drow = o;
        }
}
struct RMPlain { __device__ __forceinline__ int operator()(int n) const { return n; } };
struct RMGateUp { int mat; __device__ __forceinline__ int operator()(int h) const { return (h >> 7) * 256 + ((h >> 6) & 1) * 128 + (((h >> 4) & 3) * 2 + mat) * 16 + (h & 15); } };
__device__ __forceinline__ void tr_plain(const float* W, int K, int N, bf16_t* dst, int item, int lane) {
    const int nb = N / 64, kb = item / nb, n0 = (item % nb) * 64;
    tr_item64(W, N, kb * 64, n0, dst, K, RMPlain{}, lane);
}
__device__ __forceinline__ void tr_expert(const float* Wg, const float* Wu, const float* Wd, bf16_t* gu, bf16_t* dn, int item, int lane) {
    if (item < 128) {
        const int mat = item >> 6, it = item & 63, kb = it >> 2, n0 = (it & 3) * 64;
        tr_item64(Wg + (size_t)mat * (Wu - Wg), DE, kb * 64, n0, gu, D, RMGateUp{mat}, lane);
    } else {
        const int it = item - 128, kb = it >> 4, n0 = (it & 15) * 64;
        tr_item64(Wd, D, kb * 64, n0, dn, DE, RMPlain{}, lane);
    }
}
struct Ctx {
    const Params& p; float* lds; ldsp_t smem;
    int tid, lane, wid, vb;
    __device__ __forceinline__ Ctx(const Params& p_, float* l, ldsp_t sm) : p(p_), lds(l), smem(sm) { tid = threadIdx.x; lane = tid & 63; wid = tid >> 6; vb = blockIdx.x; }
#define WSF(name, type, off) __device__ __forceinline__ type* name() const { return (type*)(p.ws + (off)); }
    WSF(cnt, unsigned, CTL_CNT) WSF(mod, float, CTL_MOD) WSF(rope, float, WS_ROPE) WSF(sum, float, WS_SUM)
    WSF(AE, int, WS_AE) WSF(AW, float, WS_AW) WSF(APOS, int, WS_APOS) WSF(LIST, int, WS_LIST) WSF(XC, float, WS_XC)
    WSF(H, bf16_t, WS_H) WSF(ACT, bf16_t, WS_ACT) WSF(ACTS, bf16_t, WS_ACTS) WSF(Y, bf16_t, WS_BIG)
    WSF(Qb, bf16_t, WS_Q) WSF(Kb, bf16_t, WS_K) WSF(Vb, bf16_t, WS_V) WSF(Ob, bf16_t, WS_O)
    WSF(WQKV, bf16_t, WS_WQKV) WSF(WO, bf16_t, WS_WO) WSF(WIN, bf16_t, WS_WIN) WSF(WOUT, bf16_t, WS_WOUT) WSF(WSH, bf16_t, WS_WSH) WSF(WMOE, bf16_t, WS_WMOE)
    WSF(WGATES, bf16_t, WS_WGATES) WSF(WROUTER, bf16_t, WS_WROUTER) WSF(LC8, float, WS_LC8) WSF(CARRY, float, WS_CARRY)
    WSF(G, bf16_t, WS_G) WSF(PU, bf16_t, WS_PU) WSF(HG, bf16_t, WS_G) WSF(AB, float, WS_AB) WSF(HS, float, WS_WMOE)
#undef WSF
};

__device__ __forceinline__ void ph_prep(Ctx& c) {
    const float* cv = c.p.in[1]; const float* cctx = c.p.in[3]; const float* aw = c.p.in[4]; const float* ab = c.p.in[5];
    float* sil = c.lds;
    float* red = c.lds + 5120;
    __syncthreads();
    for (int i = c.tid; i < 5 * 1024; i += NTHREADS) { const int r = i >> 10, k = i & 1023; const float v = r < 4 ? cv[r * 1024 + k] : cctx[k]; sil[i] = silu_f(v); }
    __syncthreads();
    for (int item = blockIdx.x; item < 2 * 96; item += gridDim.x) {
        const int l = item / 96, jb = item % 96, kq = c.tid >> 4, cq = c.tid & 15;
        f32x4 a0 = {0, 0, 0, 0}, a1 = a0, a2 = a0, a3 = a0, a4 = a0;
        const float* w = aw + ((size_t)l * 1024 + kq * 64) * 6144 + jb * 64 + cq * 4;
        const float* sl = sil + kq * 64;
#pragma unroll 8
        for (int k = 0; k < 64; ++k) { const f32x4 wv = *(const f32x4*)(w + (size_t)k * 6144); a0 += sl[k] * wv; a1 += sl[1024 + k] * wv; a2 += sl[2048 + k] * wv; a3 += sl[3072 + k] * wv; a4 += sl[4096 + k] * wv; }
        float* rr = red + kq * 320 + cq * 4;
        *(f32x4*)(rr) = a0; *(f32x4*)(rr + 64) = a1; *(f32x4*)(rr + 128) = a2; *(f32x4*)(rr + 192) = a3; *(f32x4*)(rr + 256) = a4;
        __syncthreads();
        for (int i = c.tid; i < 320; i += NTHREADS) {
            const int r = i >> 6, jj = i & 63;
            float v = 0.f;
#pragma unroll
            for (int q = 0; q < 16; ++q) v += red[q * 320 + i];
            c.mod()[((size_t)l * 5 + r) * 6144 + jb * 64 + jj] = v + ab[l * 6144 + jb * 64 + jj];
        }
        __syncthreads();
    }
    if (blockIdx.x == gridDim.x - 1) {
        for (int i = c.tid; i < 1024; i += NTHREADS) {
            const int pos = i >> 4, f = i & 15;
            const float inv = expf(-logf(10000.0f) * (float)f / 16.0f);
            const float ang = (float)pos * inv;
            c.rope()[i] = cosf(ang); c.rope()[1024 + i] = sinf(ang);
        }
    }
}


__device__ __forceinline__ int find_expert(const int* tp, int rt) {
    const int lane = threadIdx.x & 63;
    const unsigned long long m = __ballot(tp[lane] <= rt);
    const int e = tp[64] <= rt ? 64 : (int)__popcll(m) - 1;
    return __builtin_amdgcn_readfirstlane(e);
}


__device__ __forceinline__ void ph_convert_small(Ctx& c) {
    const int wu = __builtin_amdgcn_readfirstlane(c.wid);
    const int gw = blockIdx.x * 4 + wu, NGW = gridDim.x * 4;
    constexpr int I_QKV = 16 * 24, I_O = 16 * 16, I_IN = 16 * 40, I_OUT = 20 * 16, I_SH = 192, I_R = 16;
    constexpr int NIT = I_QKV + I_O + I_IN + I_OUT + 2 * I_SH + 2 * I_R;
    for (int it = gw; it < NIT; it += NGW) {
        int r = it;
        if (r < I_QKV) { tr_plain(c.p.in[8], 1024, 1536, c.WQKV(), r, c.lane); continue; } r -= I_QKV;
        if (r < I_O) { tr_plain(c.p.in[9], 1024, 1024, c.WO(), r, c.lane); continue; } r -= I_O;
        if (r < I_IN) { tr_plain(c.p.in[11], 1024, 2560, c.WIN(), r, c.lane); continue; } r -= I_IN;
        if (r < I_OUT) { tr_plain(c.p.in[19], 1280, 1024, c.WOUT(), r, c.lane); continue; } r -= I_OUT;
        if (r < 2 * I_SH) {
            const int l = r / I_SH; r %= I_SH;
            bf16_t* base = c.WSH() + (size_t)l * (WSH_LAYER / 2);
            tr_expert(c.p.in[25] + (size_t)l * D * DE, c.p.in[26] + (size_t)l * D * DE, c.p.in[27] + (size_t)l * DE * D, base, base + WSH_D / 2, r, c.lane);
            continue;
        }
        r -= 2 * I_SH;
        { const int l = r / I_R; r %= I_R; tr_plain(c.p.in[20] + (size_t)l * D * NE, D, NE, c.WROUTER() + (size_t)l * 128 * D, r, c.lane); }
    }
    for (int i = blockIdx.x * NTHREADS + c.tid; i < 2 * 64 * D / 8; i += gridDim.x * NTHREADS) { const int l = i / (64 * D / 8), o = i % (64 * D / 8); *(u32x4*)(c.WROUTER() + (size_t)l * 128 * D + 64 * D + (size_t)o * 8) = (u32x4){0u, 0u, 0u, 0u}; }
}
__device__ __forceinline__ void ph_convert_moe(Ctx& c, int layer) {
    const int wu = __builtin_amdgcn_readfirstlane(c.wid);
    const int gw = vblock() * 4 + wu, NGW = gridDim.x * 4;
    for (int it = gw; it < NE * 192; it += NGW) {
        const int e = it / 192, r = it % 192; const size_t eo = ((size_t)layer * NE + e) * D * DE;
        tr_expert(c.p.in[22] + eo, c.p.in[23] + eo, c.p.in[24] + eo, c.WMOE() + (size_t)e * 512 * 1024, c.WMOE() + WMOE_D / 2 + (size_t)e * 1024 * 256, r, c.lane);
    }
}
template <class Epi>
__device__ __forceinline__ void dense_gemm(Ctx& c, const bf16_t* A, int lda, int mtiles, const bf16_t* Bt, int K, int ntiles, const Epi& ep) {
    const RowPlain rp{A, lda};
    const int nItems = mtiles * ntiles;
    for (int item = vblock(); item < nItems; item += gridDim.x) {
        const int mt = item / ntiles, nt = item % ntiles;
        mfma_tile(c.smem, rp, Bt + (size_t)nt * 256 * K, K, ep, mt * 128, nt * 256);
    }
}
__device__ __forceinline__ void ph_qkv_m(Ctx& c) { const MEpiQKV ep{c.Qb(), c.Kb(), c.Vb(), c.rope()}; dense_gemm(c, c.H(), D, T0 / 128, c.WQKV(), D, QKVN / 256, ep); }
__device__ __forceinline__ void ph_oproj_m(Ctx& c) { const MEpiResid ep{c.p.in[0], c.p.in[2], c.p.out, c.XC(), c.mod(), 2}; dense_gemm(c, c.Ob(), D, T0 / 128, c.WO(), D, D / 256, ep); }
__device__ __forceinline__ void ph_inproj_m(Ctx& c) { const MEpiInProj ep{c.G(), c.PU()}; dense_gemm(c, c.H(), D, T0 / 128, c.WIN(), D, 2 * DR / 256, ep); }
__device__ __forceinline__ void ph_outproj_m(Ctx& c) { const MEpiResid ep{c.p.out, c.XC(), c.p.out, c.XC(), c.mod() + 5 * 6144, 2}; dense_gemm(c, c.HG(), DR, TL / 128, c.WOUT(), DR, D / 256, ep); }


__device__ __forceinline__ void moe_tables128(Ctx& c, int layer, int T, int* tbl) {
    __syncthreads();
    if (c.tid < 64) {
        const int n = (int)c.cnt()[layer * 64 + c.tid], nt = (n + 127) >> 7;
        int o = n, t = nt;
#pragma unroll
        for (int d = 1; d < 64; d <<= 1) { const int o2 = __shfl_up(o, d), t2 = __shfl_up(t, d); if (c.tid >= d) { o += o2; t += t2; } }
        tbl[136 + c.tid] = n; tbl[c.tid] = o - n; tbl[65 + c.tid] = t - nt;
        if (c.tid == 63) { tbl[64] = o; tbl[65 + 64] = t; tbl[65 + 65] = t + ((T + 127) >> 7); }
    }
    __syncthreads();
}
struct RowGather { const bf16_t* H; const int* list; int n; bool shared;
    __device__ __forceinline__ const bf16_t* operator()(int r) const { if (r >= n) return H; const int tok = shared ? r : (list[r] >> 3); return H + (size_t)tok * D; } };
struct MEpiAct { bf16_t* act; int n;
    __device__ __forceinline__ void operator()(f32x4 (&acc)[4][8], ldsp_t wl, int rbase, int cbase, int lane) const {
        const int fr = lane & 15, fq = lane >> 4;
#pragma unroll
        for (int m = 0; m < 4; ++m)
#pragma unroll
            for (int q = 0; q < 4; ++q) { const f32x4 g = acc[m][2 * q], u = acc[m][2 * q + 1];
                ep_put4(wl, m * 16 + fr, q * 16 + fq * 4, silu_f(g[0]) * u[0], silu_f(g[1]) * u[1], silu_f(g[2]) * u[2], silu_f(g[3]) * u[3]); }
        bf16_t* base = act + (cbase >> 1);
#pragma unroll 2
        for (int i = 0; i < 8; ++i) {
            const int rl = 8 * i + (lane >> 3), ch = lane & 7, r = rbase + rl;
            const u32x4 v = *(const LAS u32x4*)(wl + rl * EPB + ch * 16);
            if (r < n) *(u32x4*)(base + (size_t)r * DE + ch * 8) = v;
        }
    }
};
__device__ __forceinline__ void ph_moe_gateup_m(Ctx& c, int layer, int T) {
    int* tbl = (int*)(c.smem + LDS_LRU_END + 16);
    moe_tables128(c, layer, T, tbl);
    const int* tp = tbl + 65; const int ntile = tp[65];
#pragma unroll 1
    for (int item = vblock(); item < ntile * 2; item += gridDim.x) {
        const int rt = item >> 1, nt = item & 1, e = find_expert(tp, rt), mt = rt - tp[e];
        const bool sh = e >= NE;
        const int n = sh ? T : tbl[136 + e];
        const RowGather rp{c.H(), c.LIST() + (size_t)(sh ? 0 : e) * T0, n, sh};
        const bf16_t* Bt = (sh ? c.WSH() + (size_t)layer * (WSH_LAYER / 2) : c.WMOE() + (size_t)e * 512 * 1024) + (size_t)nt * 256 * D;
        const MEpiAct ep{sh ? c.ACTS() : c.ACT() + (size_t)tbl[e] * DE, n};
        mfma_tile(c.smem, rp, Bt, D, ep, mt * 128, nt * 256);
    }
}
struct MEpiDown { bf16_t* Y; const int* list; const float* aw; int n; bool shared; float* xl; float* xc; const float* mod; int a_reg; float w_reg;
    __device__ __forceinline__ void operator()(f32x4 (&acc)[4][8], ldsp_t wl, int rbase, int cbase, int lane) const {
        const int fr = lane & 15, fq = lane >> 4;
        if (!shared) {
#pragma unroll
            for (int m = 0; m < 4; ++m) {
                const float w = __shfl(w_reg, m * 16 + fr);
#pragma unroll
                for (int nn = 0; nn < 8; ++nn) ep_put4(wl, m * 16 + fr, nn * 16 + fq * 4, w * acc[m][nn][0], w * acc[m][nn][1], w * acc[m][nn][2], w * acc[m][nn][3]);
            }
#pragma unroll 2
            for (int i = 0; i < 16; ++i) {
                const int rl = 4 * i + (lane >> 4), ch = lane & 15, r = rbase + rl;
                const u32x4 v = *(const LAS u32x4*)(wl + rl * EPB + ch * 16);
                const int a = __shfl(a_reg, rl);
                if (r < n) *(u32x4*)(Y + (size_t)a * D + cbase + ch * 8) = v;
            }
        } else {
#pragma unroll
            for (int half = 0; half < 2; ++half) {
#pragma unroll
                for (int mm = 0; mm < 2; ++mm)
#pragma unroll
                    for (int nn = 0; nn < 8; ++nn) *(LAS f32x4*)(wl + (mm * 16 + fr) * EPF + (nn * 16 + fq * 4) * 4) = acc[half * 2 + mm][nn];
#pragma unroll 2
                for (int i = 0; i < 16; ++i) {
                    const int rl = 2 * i + (lane >> 5), c4 = (lane & 31) * 4, r = rbase + half * 32 + rl;
                    const f32x4 v = *(const LAS f32x4*)(wl + rl * EPF + c4 * 4);
                    if (r < n) {
                        const f32x4 gv = *(const f32x4*)(mod + mod_row(r) * 6144 + 5 * 1024 + cbase + c4);
                        float* d = (r < TL ? xl + (size_t)r * D : xc + (size_t)(r - TL) * D) + cbase + c4;
                        *(f32x4*)d += gv * v;
                    }
                }
            }
        }
    }
};
__device__ __forceinline__ void ph_moe_down_m(Ctx& c, int layer, int T) {
    int* tbl = (int*)(c.smem + LDS_LRU_END + 16);
    moe_tables128(c, layer, T, tbl);
    const int* tp = tbl + 65; const int ntile = tp[65];
    const float* modl = c.mod() + (size_t)layer * 5 * 6144;
#pragma unroll 1
    for (int item = vblock(); item < ntile * 4; item += gridDim.x) {
        const int rt = item >> 2, nt = item & 3, e = find_expert(tp, rt), mt = rt - tp[e];
        const bool sh = e >= NE;
        const int n = sh ? T : tbl[136 + e];
        const RowPlain rp{sh ? c.ACTS() : c.ACT() + (size_t)tbl[e] * DE, DE};
        const bf16_t* Bt = (sh ? c.WSH() + (size_t)layer * (WSH_LAYER / 2) + WSH_D / 2 : c.WMOE() + WMOE_D / 2 + (size_t)e * 1024 * 256) + (size_t)nt * 256 * DE;
        int a_reg = 0; float w_reg = 0.f;
        if (!sh) { const int rr = mt * 128 + (__builtin_amdgcn_readfirstlane(c.tid >> 6) >> 1) * 64 + c.lane; if (rr < n) { a_reg = c.LIST()[(size_t)e * T0 + rr]; w_reg = c.AW()[a_reg]; } }
        const MEpiDown ep{c.Y(), c.LIST() + (size_t)(sh ? 0 : e) * T0, c.AW(), n, sh, c.p.out, c.XC(), modl, a_reg, w_reg};
        mfma_tile(c.smem, rp, Bt, DE, ep, mt * 128, nt * 256);
    }
}


constexpr int NCH = 68;
constexpr int LU_PITCH = 104;
__device__ __forceinline__ float fast_sigmoid(float x) { return __builtin_amdgcn_rcpf(1.f + __builtin_amdgcn_exp2f(-LOG2E * x)); }
__device__ __forceinline__ void ph_convert_gates(Ctx& c) {
    const int NT = gridDim.x * NTHREADS, g0 = blockIdx.x * NTHREADS + c.tid;
    for (int i = g0; i < 2 * 2 * NBLK * BW * 96; i += NT) {
        const int k = i % 96, col = (i / 96) % BW, n = (i / (96 * BW)) % NBLK, mat = (i / (96 * BW * NBLK)) & 1, d = i / (96 * BW * NBLK * 2);
        const float* w = (mat ? c.p.in[16] : c.p.in[14]) + (((size_t)d * NBLK + n) * BW) * BW;
        c.WGATES()[i] = k < BW ? f2bf(w[(size_t)k * BW + col]) : (bf16_t)0;
    }
    for (int i = g0; i < 2 * DR; i += NT) c.LC8()[i] = 8.0f * LOG2E * log1pf(expf(-c.p.in[18][i]));
}
constexpr int L2_U = 0, L2_RAW = 13312, L2_OUT = L2_RAW + 10752, L2_END = L2_OUT + 2 * 64 * BW * 4;
template <bool REV, int PASS>
__device__ __forceinline__ void lru_scan16(const float (&a)[4][4], const float (&b)[4][4], float& cm, float& ptot, float (&h)[4][4], int lane, int fq) {
    const int l16 = REV ? ((lane + 16) & 63) : ((lane - 16) & 63), l32 = REV ? ((lane + 32) & 63) : ((lane - 32) & 63);
    const int ltot = (lane & 15) + (REV ? 0 : 48);
    float P[4], H[4], Pe[4], He[4], Pt[4], Ht[4];
#pragma unroll
    for (int m = 0; m < 4; ++m) {
        P[m] = 1.f; H[m] = 0.f;
#pragma unroll
        for (int jj = 0; jj < 4; ++jj) { const int j = REV ? 3 - jj : jj; H[m] = a[m][j] * H[m] + b[m][j]; P[m] *= a[m][j]; }
    }
    {   float Pp[4], Hp[4];
#pragma unroll
        for (int m = 0; m < 4; ++m) { Pp[m] = __shfl(P[m], l16); Hp[m] = __shfl(H[m], l16); }
#pragma unroll
        for (int m = 0; m < 4; ++m) if (REV ? (fq <= 2) : (fq >= 1)) { H[m] = P[m] * Hp[m] + H[m]; P[m] = P[m] * Pp[m]; }
#pragma unroll
        for (int m = 0; m < 4; ++m) { Pp[m] = __shfl(P[m], l32); Hp[m] = __shfl(H[m], l32); }
#pragma unroll
        for (int m = 0; m < 4; ++m) if (REV ? (fq <= 1) : (fq >= 2)) { H[m] = P[m] * Hp[m] + H[m]; P[m] = P[m] * Pp[m]; }
    }
#pragma unroll
    for (int m = 0; m < 4; ++m) { Pe[m] = __shfl(P[m], l16); He[m] = __shfl(H[m], l16); Pt[m] = __shfl(P[m], ltot); Ht[m] = __shfl(H[m], ltot); }
#pragma unroll
    for (int m = 0; m < 4; ++m) if (REV ? (fq == 3) : (fq == 0)) { Pe[m] = 1.f; He[m] = 0.f; }
#pragma unroll
    for (int mm = 0; mm < 4; ++mm) {
        const int m = REV ? 3 - mm : mm;
        const float hin = Pe[m] * cm + He[m];
        cm = Pt[m] * cm + Ht[m]; ptot *= Pt[m];
        if (PASS == 2) {
            float hh = hin;
#pragma unroll
            for (int jj = 0; jj < 4; ++jj) { const int j = REV ? 3 - jj : jj; hh = a[m][j] * hh + b[m][j]; h[m][j] = hh; }
        }
    }
}
template <int PASS>
__device__ __forceinline__ void ph_lru_pass(Ctx& c) {
    const int wu = __builtin_amdgcn_readfirstlane(c.wid), lane = c.lane, fr = lane & 15, fq = lane >> 4;
    const int dir = wu >> 1, nt0 = (wu & 1) ? 3 : 0, nnt = (wu & 1) ? 2 : 3;
    constexpr int NC = PASS == 1 ? NCH : 64;
    const float* cw = c.p.in[12]; const float* cb = c.p.in[13];
#pragma unroll 1
    for (int unit = vblock(); unit < NB * NC * NBLK; unit += gridDim.x) {
        const int n = unit % NBLK, cidx = (unit / NBLK) % NC + (PASS == 1 ? 0 : 4), b = unit / (NBLK * NC);
        int r0, seq0, seqn;
        if (cidx < 4) { seq0 = TL + b * C; seqn = C; r0 = seq0 + cidx * 64; } else { seq0 = b * S; seqn = S; r0 = seq0 + (cidx - 4) * 64; }
        __syncthreads();
        for (int idx = c.tid; idx < 67 * 10; idx += NTHREADS) {
            const int row = idx / 10, c8i = idx % 10, rr = r0 - 2 + row;
            u32x4 v = (u32x4){0u, 0u, 0u, 0u};
            if (rr >= seq0 && rr < seq0 + seqn) v = *(const u32x4*)(c.PU() + (size_t)rr * DR + n * BW + c8i * 8);
            *(LAS u32x4*)(c.smem + L2_RAW + row * 160 + c8i * 16) = v;
        }
        __syncthreads();
        for (int idx = c.tid; idx < 64 * 20; idx += NTHREADS) {
            const int t = idx / 20, c4 = (idx % 20) * 4, ch = n * BW + c4;
            float u0 = cb[ch], u1 = cb[ch + 1], u2 = cb[ch + 2], u3 = cb[ch + 3];
#pragma unroll
            for (int j = 0; j < 4; ++j) {
                const u32x2 raw = *(const LAS u32x2*)(c.smem + L2_RAW + (t + j) * 160 + c4 * 2);
                const float4 w = *(const float4*)(cw + j * DR + ch);
                u0 += w.x * __uint_as_float(raw.x << 16); u1 += w.y * __uint_as_float(raw.x & 0xffff0000u);
                u2 += w.z * __uint_as_float(raw.y << 16); u3 += w.w * __uint_as_float(raw.y & 0xffff0000u);
            }
            u32x2 o; o.x = pk2(u0, u1); o.y = pk2(u2, u3);
            *(LAS u32x2*)(c.smem + L2_U + (t * LU_PITCH + c4) * 2) = o;
        }
        for (int idx = c.tid; idx < 64 * 3; idx += NTHREADS) { const int t = idx / 3, q = idx % 3; *(LAS u32x4*)(c.smem + L2_U + (t * LU_PITCH + 80 + q * 8) * 2) = (u32x4){0u, 0u, 0u, 0u}; }
        __syncthreads();
        bf16x8 af[4][3];
#pragma unroll
        for (int m = 0; m < 4; ++m)
#pragma unroll
            for (int ks = 0; ks < 3; ++ks) af[m][ks] = *(const LAS bf16x8*)(c.smem + L2_U + (16 * m + fr) * (LU_PITCH * 2) + (ks * 32 + fq * 8) * 2);
        const bf16_t* wbase = c.WGATES() + ((((size_t)dir * 2) * NBLK + n) * BW + fr) * 96 + fq * 8;
        bf16x8 bcur[2][3];
#pragma unroll
        for (int mat = 0; mat < 2; ++mat)
#pragma unroll
            for (int ks = 0; ks < 3; ++ks) bcur[mat][ks] = *(const bf16x8*)(wbase + (size_t)mat * NBLK * BW * 96 + nt0 * 16 * 96 + ks * 32);
#pragma unroll 1
        for (int i = 0; i < nnt; ++i) {
            const int nt = nt0 + i, cl = nt * 16 + fr, ch = n * BW + cl;
            const float bav = c.p.in[15][dir * DR + ch], bxv = c.p.in[17][dir * DR + ch], c8v = c.LC8()[dir * DR + ch];
            float cm = PASS == 1 ? 0.f : c.CARRY()[((size_t)(b * 2 + dir) * NCH + cidx) * DR + ch], ptot = 1.f;
            f32x4 acc[2][4];
#pragma unroll
            for (int mat = 0; mat < 2; ++mat)
#pragma unroll
                for (int m = 0; m < 4; ++m) {
                    acc[mat][m] = (f32x4){0.f, 0.f, 0.f, 0.f};
#pragma unroll
                    for (int ks = 0; ks < 3; ++ks) acc[mat][m] = __builtin_amdgcn_mfma_f32_16x16x32_bf16(af[m][ks], bcur[mat][ks], acc[mat][m], 0, 0, 0);
                }
            if (i + 1 < nnt) {
#pragma unroll
                for (int mat = 0; mat < 2; ++mat)
#pragma unroll
                    for (int ks = 0; ks < 3; ++ks) bcur[mat][ks] = *(const bf16x8*)(wbase + (size_t)mat * NBLK * BW * 96 + (nt + 1) * 16 * 96 + ks * 32);
            }
            float av[4][4], bv[4][4], hv[4][4];
#pragma unroll
            for (int m = 0; m < 4; ++m)
#pragma unroll
                for (int j = 0; j < 4; ++j) {
                    const int t = 16 * m + fq * 4 + j;
                    const float r = fast_sigmoid(acc[0][m][j] + bav), ig = fast_sigmoid(acc[1][m][j] + bxv);
                    const float a = __builtin_amdgcn_exp2f(-c8v * r);
                    const float uv = bf2f(*(const LAS bf16_t*)(c.smem + L2_U + (t * LU_PITCH + cl) * 2));
                    av[m][j] = a; bv[m][j] = __builtin_amdgcn_sqrtf(fmaxf(1.f - a * a, 0.f)) * (ig * uv);
                }
            if (dir == 0) lru_scan16<false, PASS>(av, bv, cm, ptot, hv, lane, fq); else lru_scan16<true, PASS>(av, bv, cm, ptot, hv, lane, fq);
            if (PASS == 1) {
                if (fq == 0) { float* sp = c.sum() + (((size_t)(b * 2 + dir) * NCH + cidx) * 2) * DR + ch; sp[0] = ptot; sp[DR] = cm; }
            } else {
#pragma unroll
                for (int m = 0; m < 4; ++m)
#pragma unroll
                    for (int j = 0; j < 4; ++j) *(LAS float*)(c.smem + L2_OUT + ((dir * 64 + 16 * m + fq * 4 + j) * BW + cl) * 4) = hv[m][j];
            }
        }
        if (PASS == 2) {
            __syncthreads();
            for (int idx = c.tid; idx < 64 * 20; idx += NTHREADS) {
                const int t = idx / 20, c4 = (idx % 20) * 4;
                const f32x4 h0 = *(const LAS f32x4*)(c.smem + L2_OUT + (t * BW + c4) * 4), h1 = *(const LAS f32x4*)(c.smem + L2_OUT + ((64 + t) * BW + c4) * 4);
                bf16_t* gp = c.G() + (size_t)(r0 + t) * DR + n * BW + c4;
                const uint2 g = *(const uint2*)gp;
                st_bf16x4(gp, (h0[0] + h1[0]) * __uint_as_float(g.x << 16), (h0[1] + h1[1]) * __uint_as_float(g.x & 0xffff0000u),
                          (h0[2] + h1[2]) * __uint_as_float(g.y << 16), (h0[3] + h1[3]) * __uint_as_float(g.y & 0xffff0000u));
            }
        }
    }
}
__device__ __forceinline__ void ph_lru_carry(Ctx& c) {
    for (int i = blockIdx.x * NTHREADS + c.tid; i < NB * 2 * DR; i += gridDim.x * NTHREADS) {
        const int ch = i % DR, d = (i / DR) & 1, b = i / (2 * DR);
        const float* sp = c.sum() + ((size_t)(b * 2 + d) * NCH * 2) * DR + ch; float* cp = c.CARRY() + ((size_t)(b * 2 + d) * NCH) * DR + ch;
        float h = 0.f;
#pragma unroll 1
        for (int q = 0; q < 4; ++q) {
            float P[17], Hh[17];
#pragma unroll
            for (int j = 0; j < 17; ++j) { const int s = q * 17 + j, k = d == 0 ? s : (s < 4 ? 3 - s : NCH + 3 - s); P[j] = sp[(size_t)k * 2 * DR]; Hh[j] = sp[(size_t)k * 2 * DR + DR]; }
#pragma unroll
            for (int j = 0; j < 17; ++j) { const int s = q * 17 + j, k = d == 0 ? s : (s < 4 ? 3 - s : NCH + 3 - s); cp[(size_t)k * DR] = h; h = P[j] * h + Hh[j]; }
        }
    }
}


typedef float f32x16 __attribute__((ext_vector_type(16)));
typedef short s16x4 __attribute__((ext_vector_type(4)));
__device__ __forceinline__ s16x4 vtr(const LAS unsigned char* p) { return __builtin_bit_cast(s16x4, __builtin_amdgcn_ds_read_tr16_b64_v4i16((LAS s16x4*)p)); }
constexpr int AT_BUF = 16384;
__device__ __forceinline__ void ph_attn_m(Ctx& c) {
    const int tid = c.tid, lane = c.lane, wu = __builtin_amdgcn_readfirstlane(c.wid), r32 = lane & 31, hi = lane >> 5;
    const float* sinkp = c.p.in[10];
    const int NU = NB * 32 * NH + NB * 2 * NH;
#pragma unroll 1
    for (int unit = vblock(); unit < NU; unit += gridDim.x) {
        int b, qb, h, q0, nt, ilo;
        bool lat = unit < NB * 32 * NH;
        if (lat) { h = unit & 15; qb = (unit >> 4) & 31; b = unit >> 9; q0 = b * S + qb * 128; ilo = (qb == 0) ? 2 : 0; const int ihi = (qb == 31) ? 3 : 5; nt = 4 + (ihi - ilo + 1); }
        else { const int u2 = unit - NB * 32 * NH; h = u2 & 15; qb = (u2 >> 4) & 1; b = u2 >> 5; q0 = TL + b * C + qb * 128; ilo = 0; nt = 4; }
        const int g = h >> 2;
        const bf16_t* kbase = c.Kb() + (size_t)lane * KD + g * 64 + (2 * wu) * 8;
        const bf16_t* vbase = c.Vb() + (size_t)(16 * wu + (lane >> 2)) * KD + g * 64 + (lane & 3) * 8;
#define AT_STAGE(buf, kr0) do { \
        __builtin_amdgcn_global_load_lds((const unsigned*)(kbase + (size_t)(kr0) * KD), (LAS unsigned*)(c.smem + (buf) * AT_BUF + (2 * wu) * 1024), 16, 0, 0); \
        __builtin_amdgcn_global_load_lds((const unsigned*)(kbase + (size_t)(kr0) * KD + 8), (LAS unsigned*)(c.smem + (buf) * AT_BUF + (2 * wu + 1) * 1024), 16, 0, 0); \
        __builtin_amdgcn_global_load_lds((const unsigned*)(vbase + (size_t)(kr0) * KD), (LAS unsigned*)(c.smem + (buf) * AT_BUF + 8192 + wu * 1024), 16, 0, 0); \
        __builtin_amdgcn_global_load_lds((const unsigned*)(vbase + (size_t)(kr0) * KD + 32), (LAS unsigned*)(c.smem + (buf) * AT_BUF + 8192 + 4096 + wu * 1024), 16, 0, 0); } while (0)
#define AT_KR0(j) ((j) < 4 ? (TL + b * C + (j) * 64) : (b * S + qb * 128 - 128 + 64 * (ilo + (j) - 4)))
        bf16x8 qr[4];
        { const bf16_t* qp = c.Qb() + (size_t)(q0 + 32 * wu + r32) * 1024 + h * 64 + hi * 8;
#pragma unroll
          for (int ds = 0; ds < 4; ++ds) qr[ds] = *(const bf16x8*)(qp + ds * 16); }
        float m = sinkp[h] * LOG2E, l = hi == 0 ? 1.f : 0.f;
        f32x16 o0, o1;
#pragma unroll
        for (int r = 0; r < 16; ++r) { o0[r] = 0.f; o1[r] = 0.f; }
        const int qi = 32 * wu + r32;
        const int vaddr = ((lane >> 4) & 1) * 32 + (lane & 3) * 8 + (4 * hi + ((lane & 15) >> 2)) * 64;
        __syncthreads();
        AT_STAGE(0, AT_KR0(0));
        AT_STAGE(1, AT_KR0(1));
        AT_STAGE(2, AT_KR0(2));
#pragma unroll 1
        for (int j = 0; j < nt; ++j) {
            if (j + 2 < nt) asm volatile("s_waitcnt vmcnt(8)" ::: "memory");
            else if (j + 1 < nt) asm volatile("s_waitcnt vmcnt(4)" ::: "memory");
            else asm volatile("s_waitcnt vmcnt(0)" ::: "memory");
            __builtin_amdgcn_s_barrier();
            asm volatile("" ::: "memory");
            if (j + 3 < nt) { const int kr1 = AT_KR0(j + 3); AT_STAGE((j + 3) & 3, kr1); }
            const ldsp_t kb = c.smem + (j & 3) * AT_BUF, vb = kb + 8192;
            f32x16 p0, p1;
#pragma unroll
            for (int r = 0; r < 16; ++r) { p0[r] = 0.f; p1[r] = 0.f; }
#pragma unroll
            for (int ds = 0; ds < 4; ++ds) {
                const bf16x8 k0 = *(const LAS bf16x8*)(kb + (ds * 2 + hi) * 1024 + r32 * 16);
                const bf16x8 k1 = *(const LAS bf16x8*)(kb + (ds * 2 + hi) * 1024 + (32 + r32) * 16);
                p0 = __builtin_amdgcn_mfma_f32_32x32x16_bf16(k0, qr[ds], p0, 0, 0, 0);
                p1 = __builtin_amdgcn_mfma_f32_32x32x16_bf16(k1, qr[ds], p1, 0, 0, 0);
            }
            if (lat && j >= 4) {
                const int i = ilo + j - 4;
                if (i < 2 || i > 3) {
                    const int kj0 = 64 * i + 4 * hi;
#pragma unroll
                    for (int r = 0; r < 16; ++r) {
                        const int kj = kj0 + (r & 3) + 8 * (r >> 2);
                        if (kj < qi || kj > qi + 256) p0[r] = -INFINITY;
                        if (kj + 32 < qi || kj + 32 > qi + 256) p1[r] = -INFINITY;
                    }
                }
            }
            float mx = fmaxf(p0[0], p1[0]);
#pragma unroll
            for (int r = 1; r < 16; ++r) mx = fmaxf(mx, fmaxf(p0[r], p1[r]));
            mx = fmaxf(mx, __shfl_xor(mx, 32));
            const float mn = fmaxf(m, mx);
            const float alpha = __builtin_amdgcn_exp2f(m - mn);
            m = mn;
            float ls = 0.f;
#pragma unroll
            for (int r = 0; r < 16; ++r) { p0[r] = __builtin_amdgcn_exp2f(p0[r] - mn); p1[r] = __builtin_amdgcn_exp2f(p1[r] - mn); ls += p0[r] + p1[r]; }
            l = l * alpha + ls;
            if (__any(alpha != 1.f)) {
#pragma unroll
                for (int r = 0; r < 16; ++r) { o0[r] *= alpha; o1[r] *= alpha; }
            }
#pragma unroll
            for (int sub = 0; sub < 2; ++sub)
#pragma unroll
                for (int sk = 0; sk < 2; ++sk) {
                    u32x4 pw;
                    if (sub == 0) { pw.x = pk2(p0[8 * sk + 0], p0[8 * sk + 1]); pw.y = pk2(p0[8 * sk + 2], p0[8 * sk + 3]); pw.z = pk2(p0[8 * sk + 4], p0[8 * sk + 5]); pw.w = pk2(p0[8 * sk + 6], p0[8 * sk + 7]); }
                    else { pw.x = pk2(p1[8 * sk + 0], p1[8 * sk + 1]); pw.y = pk2(p1[8 * sk + 2], p1[8 * sk + 3]); pw.z = pk2(p1[8 * sk + 4], p1[8 * sk + 5]); pw.w = pk2(p1[8 * sk + 6], p1[8 * sk + 7]); }
                    const bf16x8 pf = __builtin_bit_cast(bf16x8, pw);
                    const int ko = (sub * 32 + sk * 16) * 64;
                    const s16x4 a0 = vtr(vb + vaddr + ko), a1 = vtr(vb + vaddr + ko + 512);
                    const s16x4 b0 = vtr(vb + 4096 + vaddr + ko), b1 = vtr(vb + 4096 + vaddr + ko + 512);
                    const bf16x8 vf0 = (bf16x8){a0[0], a0[1], a0[2], a0[3], a1[0], a1[1], a1[2], a1[3]};
                    const bf16x8 vf1 = (bf16x8){b0[0], b0[1], b0[2], b0[3], b1[0], b1[1], b1[2], b1[3]};
                    o0 = __builtin_amdgcn_mfma_f32_32x32x16_bf16(vf0, pf, o0, 0, 0, 0);
                    o1 = __builtin_amdgcn_mfma_f32_32x32x16_bf16(vf1, pf, o1, 0, 0, 0);
                }
        }
#undef AT_STAGE
#undef AT_KR0
        l += __shfl_xor(l, 32);
        const float rl = 1.f / l;
        bf16_t* op = c.Ob() + (size_t)(q0 + qi) * 1024 + h * 64 + 4 * hi;
#pragma unroll
        for (int g4 = 0; g4 < 4; ++g4) {
            st_bf16x4(op + 8 * g4, o0[4 * g4] * rl, o0[4 * g4 + 1] * rl, o0[4 * g4 + 2] * rl, o0[4 * g4 + 3] * rl);
            st_bf16x4(op + 32 + 8 * g4, o1[4 * g4] * rl, o1[4 * g4 + 1] * rl, o1[4 * g4 + 2] * rl, o1[4 * g4 + 3] * rl);
        }
    }
}


struct Row16 { float v[2][8]; };
__device__ __forceinline__ void row_load(Row16& x, const float* src, int lane) {
#pragma unroll
    for (int j = 0; j < 2; ++j) { const f32x4 a = *(const f32x4*)(src + j * 512 + lane * 8), b = *(const f32x4*)(src + j * 512 + lane * 8 + 4);
        x.v[j][0] = a[0]; x.v[j][1] = a[1]; x.v[j][2] = a[2]; x.v[j][3] = a[3]; x.v[j][4] = b[0]; x.v[j][5] = b[1]; x.v[j][6] = b[2]; x.v[j][7] = b[3]; }
}
__device__ __forceinline__ void row_store(const Row16& x, float* dst, int lane) {
#pragma unroll
    for (int j = 0; j < 2; ++j) { *(f32x4*)(dst + j * 512 + lane * 8) = (f32x4){x.v[j][0], x.v[j][1], x.v[j][2], x.v[j][3]}; *(f32x4*)(dst + j * 512 + lane * 8 + 4) = (f32x4){x.v[j][4], x.v[j][5], x.v[j][6], x.v[j][7]}; }
}
__device__ __forceinline__ float row_rinv(const Row16& x) {
    float ss = 0.f;
#pragma unroll
    for (int j = 0; j < 2; ++j)
#pragma unroll
        for (int e = 0; e < 8; ++e) ss += x.v[j][e] * x.v[j][e];
    return rsqrtf(wave_sum(ss) * (1.0f / D) + RMS_EPS);
}
__device__ __forceinline__ void row_normmod_store(const Row16& x, float rinv, const float* g, const float* shift, const float* scale, bf16_t* dst, int lane) {
#pragma unroll
    for (int j = 0; j < 2; ++j) {
        const int k = j * 512 + lane * 8; float h[8];
#pragma unroll
        for (int q = 0; q < 2; ++q) { const f32x4 gv = *(const f32x4*)(g + k + 4 * q), sh = *(const f32x4*)(shift + k + 4 * q), sc = *(const f32x4*)(scale + k + 4 * q);
#pragma unroll
            for (int e = 0; e < 4; ++e) h[4 * q + e] = (x.v[j][4 * q + e] * rinv * gv[e]) * (1.f + sc[e]) + sh[e]; }
        u32x4 o; o.x = pk2(h[0], h[1]); o.y = pk2(h[2], h[3]); o.z = pk2(h[4], h[5]); o.w = pk2(h[6], h[7]);
        *(u32x4*)(dst + k) = o;
    }
}
__device__ __forceinline__ void row_combine(Row16& x, const bf16_t* Y, int r, const float* g2, int lane) {
#pragma unroll
    for (int j = 0; j < 2; ++j) {
        const int k = j * 512 + lane * 8; float s[8];
#pragma unroll
        for (int e = 0; e < 8; ++e) s[e] = 0.f;
#pragma unroll
        for (int kk = 0; kk < TOPK; ++kk) { const u32x4 y = *(const u32x4*)(Y + ((size_t)r * 8 + kk) * D + k);
            s[0] += __uint_as_float(y.x << 16); s[1] += __uint_as_float(y.x & 0xffff0000u); s[2] += __uint_as_float(y.y << 16); s[3] += __uint_as_float(y.y & 0xffff0000u);
            s[4] += __uint_as_float(y.z << 16); s[5] += __uint_as_float(y.z & 0xffff0000u); s[6] += __uint_as_float(y.w << 16); s[7] += __uint_as_float(y.w & 0xffff0000u); }
        const f32x4 ga = *(const f32x4*)(g2 + k), gb = *(const f32x4*)(g2 + k + 4);
#pragma unroll
        for (int e = 0; e < 4; ++e) { x.v[j][e] += ga[e] * s[e]; x.v[j][4 + e] += gb[e] * s[4 + e]; }
    }
}
__device__ __forceinline__ float* xrow_ptr(Ctx& c, int r) { return r < TL ? c.p.out + (size_t)r * D : c.XC() + (size_t)(r - TL) * D; }
struct Vec16 { float v[2][8]; };
__device__ __forceinline__ void vec_load(Vec16& x, const float* src, int lane) {
#pragma unroll
    for (int j = 0; j < 2; ++j) { const f32x4 a = *(const f32x4*)(src + j * 512 + lane * 8), b = *(const f32x4*)(src + j * 512 + lane * 8 + 4);
        x.v[j][0] = a[0]; x.v[j][1] = a[1]; x.v[j][2] = a[2]; x.v[j][3] = a[3]; x.v[j][4] = b[0]; x.v[j][5] = b[1]; x.v[j][6] = b[2]; x.v[j][7] = b[3]; }
}
__device__ __forceinline__ void row_normmod_store_r(const Row16& x, float rinv, const Vec16& g, const Vec16& sh, const Vec16& sc, bf16_t* dst, int lane) {
#pragma unroll
    for (int j = 0; j < 2; ++j) {
        float h[8];
#pragma unroll
        for (int e = 0; e < 8; ++e) h[e] = (x.v[j][e] * rinv * g.v[j][e]) * (1.f + sc.v[j][e]) + sh.v[j][e];
        u32x4 o; o.x = pk2(h[0], h[1]); o.y = pk2(h[2], h[3]); o.z = pk2(h[4], h[5]); o.w = pk2(h[6], h[7]);
        *(u32x4*)(dst + j * 512 + lane * 8) = o;
    }
}
__device__ __forceinline__ const float* norm_src(Ctx& c, bool input, int r) {
    return input ? (r < TL ? c.p.in[0] + (size_t)r * D : c.p.in[2] + (size_t)(r - TL) * D) : (r < TL ? c.p.out + (size_t)r * D : c.XC() + (size_t)(r - TL) * D);
}
__device__ __forceinline__ void norm_rows(Ctx& c, int T, const float* g, const float* modl, int shc, bool input) {
    const int NW = gridDim.x * 4, w = blockIdx.x * 4 + c.wid, per = (TL + NW - 1) / NW;
    Vec16 gv, shv, scv; vec_load(gv, g, c.lane);
    int r = w * per; const int rend = (r + per < TL) ? r + per : TL;
    int curb = -1;
    Row16 cur, nxt;
    if (r < rend) row_load(cur, norm_src(c, input, r), c.lane);
#pragma unroll 1
    while (r < rend) {
        if (r + 1 < rend) row_load(nxt, norm_src(c, input, r + 1), c.lane);
        const int b = r >> 12;
        if (b != curb) { const float* m = modl + (size_t)b * 6144 + shc * 1024; vec_load(shv, m, c.lane); vec_load(scv, m + 1024, c.lane); curb = b; }
        row_normmod_store_r(cur, row_rinv(cur), gv, shv, scv, c.H() + (size_t)r * D, c.lane);
        cur = nxt; ++r;
    }
    if (T > TL) {
        const float* m = modl + (size_t)4 * 6144 + shc * 1024;
#pragma unroll 1
        for (int rc = TL + w; rc < T; rc += NW) {
            row_load(cur, norm_src(c, input, rc), c.lane);
            vec_load(shv, m, c.lane); vec_load(scv, m + 1024, c.lane);
            row_normmod_store_r(cur, row_rinv(cur), gv, shv, scv, c.H() + (size_t)rc * D, c.lane);
        }
    }
}
__device__ __forceinline__ void ph_norm1_l0_w(Ctx& c) { norm_rows(c, T0, c.p.in[6], c.mod(), 0, true); }
__device__ __forceinline__ void ph_norm2_w(Ctx& c, int layer) { norm_rows(c, layer == 0 ? T0 : TL, c.p.in[7] + layer * D, c.mod() + (size_t)layer * 5 * 6144, 3, false); }
__device__ __forceinline__ void ph_combine_norm1_w(Ctx& c) {
    const float* g = c.p.in[6] + D; constexpr int RB = 1;
    for (int r0 = (blockIdx.x * 4 + c.wid) * RB; r0 < T0; r0 += gridDim.x * 4 * RB) {
        Row16 x[RB];
#pragma unroll
        for (int i = 0; i < RB; ++i) row_load(x[i], xrow_ptr(c, r0 + i), c.lane);
#pragma unroll
        for (int i = 0; i < RB; ++i) row_combine(x[i], c.Y(), r0 + i, c.mod() + (size_t)mod_row(r0 + i) * 6144 + 5 * 1024, c.lane);
#pragma unroll
        for (int i = 0; i < RB; ++i) { const int r = r0 + i; row_store(x[i], xrow_ptr(c, r), c.lane);
            const float* m = c.mod() + ((size_t)5 + mod_row(r)) * 6144;
            row_normmod_store(x[i], row_rinv(x[i]), g, m, m + 1024, c.H() + (size_t)r * D, c.lane); }
    }
}
__device__ __forceinline__ void ph_final_w(Ctx& c) {
    const float* g = c.p.in[28]; constexpr int RB = 1;
    for (int r0 = (blockIdx.x * 4 + c.wid) * RB; r0 < TL; r0 += gridDim.x * 4 * RB) {
        Row16 x[RB];
#pragma unroll
        for (int i = 0; i < RB; ++i) row_load(x[i], c.p.out + (size_t)(r0 + i) * D, c.lane);
#pragma unroll
        for (int i = 0; i < RB; ++i) row_combine(x[i], c.Y(), r0 + i, c.mod() + ((size_t)5 + mod_row(r0 + i)) * 6144 + 5 * 1024, c.lane);
#pragma unroll
        for (int i = 0; i < RB; ++i) {
            const float rinv = row_rinv(x[i]);
#pragma unroll
            for (int j = 0; j < 2; ++j) { const int k = j * 512 + c.lane * 8; const f32x4 ga = *(const f32x4*)(g + k), gb = *(const f32x4*)(g + k + 4);
#pragma unroll
                for (int e = 0; e < 4; ++e) { x[i].v[j][e] = x[i].v[j][e] * rinv * ga[e]; x[i].v[j][4 + e] = x[i].v[j][4 + e] * rinv * gb[e]; } }
            row_store(x[i], c.p.out + (size_t)(r0 + i) * D, c.lane);
        }
    }
}
struct MEpiRouter { ldsp_t lg;
    __device__ __forceinline__ void operator()(f32x4 (&acc)[4][8], ldsp_t wl, int rbase, int cbase, int lane) const {
        const int fr = lane & 15, fq = lane >> 4, rl = (rbase & 127);
#pragma unroll
        for (int m = 0; m < 4; ++m)
#pragma unroll
            for (int n = 0; n < 2; ++n)
#pragma unroll
                for (int j = 0; j < 4; ++j) *(LAS float*)(lg + ((rl + m * 16 + fr) * 65 + cbase + n * 16 + fq * 4 + j) * 4) = acc[m][n][j];
        __syncthreads();
    }
};
__device__ __forceinline__ void ph_route_m(Ctx& c, int layer) {
    const int T = layer == 0 ? T0 : TL;
    const RowPlain rp{c.H(), D};
    const MEpiRouter ep{c.smem};
    for (int mt = vblock(); mt < T / 128; mt += gridDim.x) {
        router_tile(c.smem, c.H(), c.WROUTER() + (size_t)layer * 128 * D, D, ep, mt * 128);
        LAS unsigned* lcnt = (LAS unsigned*)(c.smem + 128 * 65 * 4);
        if (c.tid < NE) lcnt[c.tid] = 0u;
        __syncthreads();
        int se[TOPK]; float ss[TOPK]; unsigned lp[TOPK]; float norm = 0.f;
        if (c.tid < 128) {
            const LAS float* sc = (const LAS float*)c.smem + c.tid * 65;
            const float* bp = c.p.in[21] + layer * NE;
            float s_[NE], v_[NE];
#pragma unroll
            for (int e = 0; e < NE; ++e) s_[e] = fast_sigmoid(sc[e]);
            float gs[8];
#pragma unroll
            for (int g = 0; g < 8; ++g) {
                float m1 = -INFINITY, m2 = -INFINITY;
#pragma unroll
                for (int i = 0; i < 8; ++i) { const float v = s_[g * 8 + i] + bp[g * 8 + i]; m2 = v > m1 ? m1 : fmaxf(m2, v); m1 = fmaxf(m1, v); }
                gs[g] = m1 + m2;
            }
            unsigned gmask = 0;
#pragma unroll
            for (int it = 0; it < 4; ++it) {
                float best = -INFINITY; int bi = 0;
#pragma unroll
                for (int g = 0; g < 8; ++g) { const bool used = (gmask >> g) & 1u; if (!used && gs[g] > best) { best = gs[g]; bi = g; } }
                gmask |= 1u << bi;
            }
#pragma unroll
            for (int e = 0; e < NE; ++e) v_[e] = ((gmask >> (e >> 3)) & 1u) ? s_[e] + bp[e] : -INFINITY;
            float wsum = 0.f;
#pragma unroll
            for (int it = 0; it < TOPK; ++it) {
                float best = -INFINITY, bs = 0.f; int bi = 0;
#pragma unroll
                for (int e = 0; e < NE; ++e) { const bool t = v_[e] > best; best = t ? v_[e] : best; bi = t ? e : bi; bs = t ? s_[e] : bs; }
#pragma unroll
                for (int e = 0; e < NE; ++e) v_[e] = (e == bi) ? -INFINITY : v_[e];
                se[it] = bi; ss[it] = bs; wsum += bs;
            }
            norm = 2.5f / wsum;
#pragma unroll
            for (int k = 0; k < TOPK; ++k) lp[k] = __hip_atomic_fetch_add(&lcnt[se[k]], 1u, __ATOMIC_RELAXED, __HIP_MEMORY_SCOPE_WORKGROUP);
        }
        __syncthreads();
        if (c.tid < NE) { const unsigned n = lcnt[c.tid]; lcnt[NE + c.tid] = n ? atomicAdd(&c.cnt()[layer * 64 + c.tid], n) : 0u; }
        __syncthreads();
        if (c.tid < 128) {
            const int t = mt * 128 + c.tid;
#pragma unroll
            for (int k = 0; k < TOPK; ++k) {
                const int e = se[k]; const int pos = (int)(lcnt[NE + e] + lp[k]); const int a = t * 8 + k;
                c.AE()[a] = e; c.APOS()[a] = pos; c.AW()[a] = ss[k] * norm; c.LIST()[(size_t)e * T0 + pos] = a;
            }
        }
    }
}

__global__ void __launch_bounds__(NTHREADS, 2) mega(const Params p) {
    __shared__ __attribute__((aligned(16))) unsigned char smem[LDS_LRU_END + 16 + 1024];
    float* lds = (float*)smem;
    Ctx c(p, lds, (ldsp_t)smem);
    volatile unsigned* st = (volatile unsigned*)(smem + LDS_LRU_END);
    if (c.tid < 4) st[c.tid] = 0u;
    __syncthreads();
    const XcdBarrier bar = xcd_barrier_post((unsigned*)(p.ws + CTL_BAR), st);
#define GB() xcd_barrier(bar)
#define REPEAT(n, stmt) do { for (int rep_ = 0; rep_ < (n); ++rep_) { stmt; if (rep_ + 1 < (n)) GB(); } } while (0)
    REPEAT(REP_PREP, (ph_prep(c), ph_convert_small(c), ph_convert_gates(c), ph_convert_moe(c, 0))); GB();
    {
        if (c.tid == 0) {
            unsigned* ctl = (unsigned*)(p.ws + CTL_BAR);
            const unsigned tk = xb_add((unsigned*)(p.ws + CTL_TICKET) + 64 * bar.x, 1u);
            unsigned base = 0u;
            for (unsigned j = 0; j < 16; ++j) { const unsigned n = xb_ld(&ctl[XB_XCNT(j)]); base += (j < bar.x) ? n : 0u; }
            st[2] = base + tk;
        }
        __syncthreads();
        c.vb = __builtin_amdgcn_readfirstlane((int)st[2]);
    }
    ph_norm1_l0_w(c); GB();
    REPEAT(REP_QKV, ph_qkv_m(c)); GB();
    REPEAT(REP_ATTN, ph_attn_m(c)); GB();
    ph_oproj_m(c); GB();
    REPEAT(REP_NORM2, ph_norm2_w(c, 0)); GB();
    ph_route_m(c, 0); GB();
    REPEAT(REP_GATEUP, ph_moe_gateup_m(c, 0, T0)); GB();
    ph_moe_down_m(c, 0, T0); GB();
    ph_combine_norm1_w(c); ph_convert_moe(c, 1); GB();
    REPEAT(REP_INPROJ, ph_inproj_m(c)); GB();
    REPEAT(REP_LRU1, ph_lru_pass<1>(c)); GB();
    ph_lru_carry(c); GB();
    ph_lru_pass<2>(c); GB();
    ph_outproj_m(c); GB();
    ph_norm2_w(c, 1); GB();
    ph_route_m(c, 1); GB();
    ph_moe_gateup_m(c, 1, TL); GB();
    ph_moe_down_m(c, 1, TL); GB();
    ph_final_w(c);
#undef GB
}
}

extern "C" void kernel_launch(void* const* d_in, const int* in_sizes, int n_in, void* d_out, int out_size, void* d_ws, size_t ws_size, hipStream_t stream) {
    if (n_in != 29 || ws_size < WS_END) { fprintf(stderr, "kernel_launch: unexpected n_in %d or ws_size %zu (< %zu)\n", n_in, ws_size, (size_t)WS_END); return; }
    static int grid = 0;
    if (grid == 0) {
        int dev = 0, cus = 0, per_cu = 0;
        hipGetDevice(&dev);
        hipDeviceGetAttribute(&cus, hipDeviceAttributeMultiprocessorCount, dev);
        hipOccupancyMaxActiveBlocksPerMultiprocessor(&per_cu, (const void*)mega, NTHREADS, 0);
        if (per_cu > 2) per_cu = 2;
        if (per_cu < 1) per_cu = 1;
        grid = cus * per_cu;
    }
    hipMemsetAsync((char*)d_ws + WS_CTL, 0, CTL_BYTES, stream);
    Params p{};
    for (int i = 0; i < 29; ++i) p.in[i] = (const float*)d_in[i];
    p.out = (float*)d_out; p.ws = (unsigned char*)d_ws;
    p.ph_lo = 0; p.ph_hi = 20;
    void* args[] = {&p};
    hipError_t e = hipLaunchCooperativeKernel((const void*)mega, dim3(grid), dim3(NTHREADS), args, 0, stream);
    if (e != hipSuccess) fprintf(stderr, "cooperative launch failed: %s (grid %d)\n", hipGetErrorString(e), grid);
}
```

```cpp
#include <hip/hip_runtime.h>
#include <stdint.h>
#include <cstdio>

namespace {
typedef unsigned short bf16_t;
constexpr int D = 1024, NB = 4, S = 4096, C = 256, TL = NB * S, TC = NB * C, T0 = TL + TC;
constexpr int NH = 16, NKV = 4, HD = 64, KD = 256, QKVN = 1536;
constexpr int DR = 1280, NBLK = 16, BW = 80;
constexpr int NE = 64, TOPK = 8, DE = 256;
constexpr float RMS_EPS = 1e-6f;
constexpr float LOG2E = 1.4426950408889634f;
constexpr float QSCALE = 0.125f * LOG2E;
constexpr int NTHREADS = 512, GT = 256;
constexpr int REP_PREP = 1, REP_QKV = 1, REP_ATTN = 1, REP_GATEUP = 1, REP_INPROJ = 1, REP_LRU1 = 1, REP_NORM2 = 1;
constexpr int LDS_U = 0, LDS_A = 13312, LDS_B0 = LDS_A + 20480, LDS_B1 = LDS_B0 + 20480, LDS_LRU_END = LDS_B1 + 20480, HALF_LDS = LDS_LRU_END, SH_ST = 2 * HALF_LDS, SH_TBL = SH_ST + 16, LDS_TOTAL = SH_TBL + 1024;

constexpr size_t MiB = 1u << 20;
constexpr size_t WS_CTL = 0, CTL_BYTES = 1 * MiB;
constexpr size_t CTL_BAR = 0;
constexpr size_t CTL_TICKET = 16384;
constexpr size_t CTL_CNT = 32768;
constexpr size_t CTL_MOD = 65536;
constexpr size_t WS_ROPE = 1 * MiB + 512 * 1024;
constexpr size_t WS_SUM = 2 * MiB;
constexpr size_t WS_AE = 8 * MiB;
constexpr size_t WS_AW = WS_AE + 640 * 1024;
constexpr size_t WS_APOS = WS_AW + 640 * 1024;
constexpr size_t WS_LIST = 10 * MiB;
constexpr size_t WS_XC = 15 * MiB;
constexpr size_t WS_WQKV = 19 * MiB, WS_WO = 22 * MiB, WS_WIN = 24 * MiB, WS_WOUT = 29 * MiB, WS_WGATES = 32 * MiB, WS_WROUTER = 33 * MiB, WS_WSH = 34 * MiB;
constexpr size_t WSH_LAYER = 1536 * 1024, WSH_D = 1024 * 1024;
constexpr size_t WMOE_D = 64 * MiB;
constexpr size_t WS_WMOE = 37 * MiB;
constexpr size_t WS_H = 138 * MiB;
constexpr size_t WS_ACT = 172 * MiB;
constexpr size_t WS_ACTS = 240 * MiB;
constexpr size_t WS_BIG = 249 * MiB;
constexpr size_t WS_Q = WS_BIG, WS_K = WS_BIG + 34 * MiB, WS_V = WS_K + 9 * MiB, WS_O = WS_V + 9 * MiB;
constexpr size_t WS_G = WS_BIG, WS_PU = WS_BIG + 40 * MiB, WS_AB = WS_BIG + 83 * MiB;
constexpr size_t WS_CARRY = WS_BIG + 84 * MiB;
constexpr size_t WS_LC8 = 1 * MiB + 640 * 1024;
constexpr size_t WS_END = 521 * MiB;

struct Params {
    const float* in[29];
    float* out;
    unsigned char* ws;
    int ph_lo, ph_hi;
};

__device__ __forceinline__ float bf2f(bf16_t h) { return __uint_as_float(((unsigned)h) << 16); }
__device__ __forceinline__ bf16_t f2bf(float f) { unsigned u = __float_as_uint(f); return (bf16_t)((u + 0x7fffu + ((u >> 16) & 1u)) >> 16); }
__device__ __forceinline__ float silu_f(float v) { return v * __builtin_amdgcn_rcpf(1.f + __builtin_amdgcn_exp2f(-LOG2E * v)); }
__device__ __forceinline__ float gelu_tanh(float v) { const float u = 0.7978845608028654f * (v + 0.044715f * v * v * v); return v * __builtin_amdgcn_rcpf(1.f + __builtin_amdgcn_exp2f(-2.f * LOG2E * u)); }
__device__ __forceinline__ float wave_sum(float v) {
#pragma unroll
    for (int o = 32; o > 0; o >>= 1) v += __shfl_xor(v, o);
    return v;
}
__device__ __forceinline__ int mod_row(int r) { return r < TL ? (r >> 12) : 4; }

#define XB_TMO      128
#define XB_XCNT(j)  (256  + 64 * (j))
#define XB_XSUB(j)  (1280 + 64 * (j))
#define XB_XGEN(j)  (2304 + 64 * (j))
#define XB_TOP      3328
#define XB_TOPGEN   3392
#define XCD_BAR_WORDS 3456
#define XB_SPIN_CAP (1u << 22)
#define LAS __attribute__((address_space(3)))
__device__ __forceinline__ unsigned xb_ld(unsigned* p)              { return __hip_atomic_load(p, __ATOMIC_RELAXED, __HIP_MEMORY_SCOPE_AGENT); }
__device__ __forceinline__ unsigned xb_add(unsigned* p, unsigned v) { return __hip_atomic_fetch_add(p, v, __ATOMIC_RELAXED, __HIP_MEMORY_SCOPE_AGENT); }
__device__ __forceinline__ unsigned xb_xcc_id() { return (unsigned)__builtin_amdgcn_s_getreg((3 << 11) | 20) & 0xFu; }
#define XB_SPIN(cond, bar) do { unsigned _sp = 0; while (cond) { __builtin_amdgcn_s_sleep(1); \
    if ((++_sp & 255u) == 0u) { if (xb_ld(&(bar)[XB_TMO])) break; if (_sp > XB_SPIN_CAP) { atomicAdd(&(bar)[XB_TMO], 1u); break; } } } } while (0)
struct XcdBarrier { unsigned* bar; unsigned x; volatile unsigned* st; };
__device__ __forceinline__ XcdBarrier xcd_barrier_post(unsigned* bar, volatile unsigned* st) {
    XcdBarrier b; b.bar = bar; b.x = xb_xcc_id(); b.st = st;
    if (threadIdx.x == 0) (void)xb_add(&bar[XB_XCNT(b.x)], 1u);
    return b;
}
__device__ __forceinline__ void xcd_barrier_complete(unsigned* bar, unsigned x, unsigned& nloc, unsigned& nx) {
    const unsigned G = gridDim.x * gridDim.y * gridDim.z;
    unsigned sum, cnt, mine, sp = 0u;
    for (;;) {
        sum = 0u; cnt = 0u; mine = 0u;
#pragma unroll
        for (unsigned j = 0; j < 16; ++j) { const unsigned c = xb_ld(&bar[XB_XCNT(j)]); sum += c; cnt += (c > 0u) ? 1u : 0u; mine = (j == x) ? c : mine; }
        if (sum == G) break;
        __builtin_amdgcn_s_sleep(1);
        if ((++sp & 255u) == 0u) { if (xb_ld(&bar[XB_TMO])) break; if (sp > XB_SPIN_CAP) { atomicAdd(&bar[XB_TMO], 1u); break; } }
    }
    nloc = mine > 0u ? mine : 1u; nx = cnt > 0u ? cnt : 1u;
}
__device__ __forceinline__ void xcd_barrier(const XcdBarrier& b) {
    asm volatile("s_waitcnt vmcnt(0)" ::: "memory");
    __syncthreads();
    if (threadIdx.x == 0) {
        unsigned* bar = b.bar;
        __builtin_amdgcn_s_waitcnt(0);
        unsigned nloc = b.st[0], nx = b.st[1];
        if (nloc == 0u) { xcd_barrier_complete(bar, b.x, nloc, nx); b.st[0] = nloc; b.st[1] = nx; }
        const unsigned old = xb_add(&bar[XB_XSUB(b.x)], 1u);
        const unsigned gen = old / nloc;
        if (old + 1u == (gen + 1u) * nloc) {
            __builtin_amdgcn_fence(__ATOMIC_RELEASE, "agent");
            asm volatile("s_waitcnt vmcnt(0)" ::: "memory");
            const unsigned og = xb_add(&bar[XB_TOP], 1u);
            const unsigned tg = og / nx;
            if (og + 1u == (tg + 1u) * nx) xb_add(&bar[XB_TOPGEN], 1u);
            else XB_SPIN(xb_ld(&bar[XB_TOPGEN]) == tg, bar);
            __builtin_amdgcn_fence(__ATOMIC_ACQUIRE, "agent");
            xb_add(&bar[XB_XGEN(b.x)], 1u);
            asm volatile("s_waitcnt vmcnt(0)" ::: "memory");
        } else {
            XB_SPIN(xb_ld(&bar[XB_XGEN(b.x)]) == gen, bar);
            __builtin_amdgcn_fence(__ATOMIC_ACQUIRE, "agent");
            asm volatile("s_waitcnt vmcnt(0)" ::: "memory");
        }
    }
    __syncthreads();
}


typedef short bf16x8 __attribute__((ext_vector_type(8)));
typedef float f32x4 __attribute__((ext_vector_type(4)));
typedef unsigned u32x4 __attribute__((ext_vector_type(4)));
typedef unsigned u32x2 __attribute__((ext_vector_type(2)));
typedef LAS unsigned char* ldsp_t;
constexpr int RT_STG = 12288, RT_NS = 6;
template <class Epi>
__device__ __forceinline__ void router_tile(ldsp_t lds, const bf16_t* A, const bf16_t* Bt, int K, const Epi& ep, int row0) {
    int tid_ = threadIdx.x & (GT - 1); asm volatile("" : "+v"(tid_));
    const int tid = tid_, lane = tid & 63, wid = __builtin_amdgcn_readfirstlane(tid >> 6), wr = wid >> 1, wc = wid & 1, fr = lane & 15, fq = lane >> 4;
    const int sch = ((tid & 3) ^ ((-(tid >> 4)) & 3)) * 8;
    const bf16_t* ap0 = A + (size_t)(row0 + (tid >> 2)) * K + sch;
    const bf16_t* ap1 = ap0 + (size_t)64 * K;
    const bf16_t* bp = Bt + (size_t)(tid >> 2) * K + sch;
    const int cterm = ((fq ^ ((-(fr >> 2)) & 3)) << 4);
    const int aoff = (wr * 64 + fr) * 64 + cterm, boff = 8192 + (wc * 32 + fr) * 64 + cterm;
    f32x4 acc[4][8];
#pragma unroll
    for (int m = 0; m < 4; ++m)
#pragma unroll
        for (int n = 0; n < 8; ++n) acc[m][n] = (f32x4){0.f, 0.f, 0.f, 0.f};
#define RT_STAGE(sb, k0) do { const ldsp_t d_ = lds + (sb) + wid * 1024; \
        __builtin_amdgcn_global_load_lds((const unsigned*)(ap0 + (k0)), (LAS unsigned*)(d_), 16, 0, 0); \
        __builtin_amdgcn_global_load_lds((const unsigned*)(ap1 + (k0)), (LAS unsigned*)(d_ + 4096), 16, 0, 0); \
        __builtin_amdgcn_global_load_lds((const unsigned*)(bp + (k0)), (LAS unsigned*)(d_ + 8192), 16, 0, 0); } while (0)
    const int nt = K >> 5;
    asm volatile("s_waitcnt lgkmcnt(0)" ::: "memory");
    __builtin_amdgcn_s_barrier();
    asm volatile("" ::: "memory");
#pragma unroll
    for (int q = 0; q < RT_NS - 1; ++q) RT_STAGE(q * RT_STG, q * 32);
    int scur = 0, snx = (RT_NS - 1) * RT_STG;
#pragma unroll 1
    for (int t = 0; t < nt; ++t) {
        if (t + RT_NS - 1 <= nt) asm volatile("s_waitcnt vmcnt(12)" ::: "memory");
        else asm volatile("s_waitcnt vmcnt(0)" ::: "memory");
        __builtin_amdgcn_s_barrier();
        asm volatile("" ::: "memory");
        if (t + RT_NS - 1 < nt) RT_STAGE(snx, (t + RT_NS - 1) * 32);
        const ldsp_t base = lds + scur;
        bf16x8 af[4], bfr[2];
#pragma unroll
        for (int m = 0; m < 4; ++m) af[m] = *(const LAS bf16x8*)(base + aoff + m * 1024);
#pragma unroll
        for (int n = 0; n < 2; ++n) bfr[n] = *(const LAS bf16x8*)(base + boff + n * 1024);
#pragma unroll
        for (int m = 0; m < 4; ++m)
#pragma unroll
            for (int n = 0; n < 2; ++n) acc[m][n] = __builtin_amdgcn_mfma_f32_16x16x32_bf16(bfr[n], af[m], acc[m][n], 0, 0, 0);
        scur = (scur == (RT_NS - 1) * RT_STG) ? 0 : scur + RT_STG;
        snx = (snx == (RT_NS - 1) * RT_STG) ? 0 : snx + RT_STG;
    }
#undef RT_STAGE
    __syncthreads();
    ep(acc, lds, row0 + wr * 64, wc * 32, lane);
}
typedef float f32x2_t __attribute__((ext_vector_type(2))); typedef __bf16 bf16x2_t __attribute__((ext_vector_type(2)));
__device__ __forceinline__ unsigned pk2(float lo, float hi) { f32x2_t v = {lo, hi}; bf16x2_t b = __builtin_convertvector(v, bf16x2_t); return __builtin_bit_cast(unsigned, b); }
__device__ __forceinline__ void st_bf16x4(bf16_t* p, float a, float b, float c, float d) { uint2 o; o.x = pk2(a, b); o.y = pk2(c, d); *(uint2*)p = o; }

namespace pg8 {
constexpr int BM = 256, BK = 64, HALF = 128, HTB = HALF * BK * 2, STAGE_BYTES = 8 * HTB;
__device__ __forceinline__ int lds_byte(int r, int c) { const int st = (r >> 4) * 2 + (c >> 5), rr = r & 15, cc = c & 31, ob = rr * 64 + cc * 2; return st * 1024 + (ob ^ (((ob >> 9) & 1) << 5)); }
__device__ __forceinline__ void stage_rc(int b, int& R, int& C) { const int st = b / 1024, sb = b % 1024, swz = sb ^ (((sb >> 9) & 1) << 5); R = (st >> 1) * 16 + swz / 64; C = (st & 1) * 32 + (swz % 64) / 2; }
__device__ __forceinline__ int perm32(int rho) { const int n = rho >> 4, i = rho & 15; return 8 * (i >> 2) + 4 * n + (i & 3); }
struct Unit { int pm, pn, e, n, o; };

template <class Epi, class Sched>
__device__ __forceinline__ void gemm_phase(ldsp_t lds, const unsigned char* ws, const Sched& S, const Epi& E, const int K) {
    int tid_ = threadIdx.x; asm volatile("" : "+v"(tid_));
    const int tid = tid_, wid = __builtin_amdgcn_readfirstlane(tid >> 6), lane = tid & 63, wr = wid >> 2, wc = wid & 3, fr = lane & 15, fq = lane >> 4;
    const int nt = K / BK;
    int RA[2]; unsigned CA[2], voffB[2];
#pragma unroll
    for (int i = 0; i < 2; ++i) { int R, C; stage_rc(tid * 16 + i * 8192, R, C); RA[i] = R; CA[i] = (unsigned)C * 2u; const int Rb = (R & ~31) + perm32(R & 31); voffB[i] = (unsigned)(Rb * K + C) * 2u; }
    constexpr unsigned kstep = BK * 2;
    const size_t hstep = (size_t)HALF * K * 2;
    const unsigned ldsw = (unsigned)wid * 1024u;
    const int aoff = lds_byte(wr * 64 + fr, fq * 8), boff = lds_byte(wc * 32 + fr, fq * 8);
#define PG8_SA(b, h) (((b) * 2 + (h)) * HTB)
#define PG8_SB(b, h) ((4 + (b) * 2 + (h)) * HTB)
#define PG8_STAGE_B(bufoff, gbase) do { _Pragma("unroll") for (int _i = 0; _i < 2; ++_i) \
        __builtin_amdgcn_global_load_lds((const unsigned*)((const char*)(gbase) + voffB[_i]), (LAS unsigned*)(lds + (bufoff) + ldsw + _i * 8192), 16, 0, 0); } while (0)
#define PG8_STAGE_A(bufoff, o0, o1) do { \
        __builtin_amdgcn_global_load_lds((const unsigned*)(ws + (o0)), (LAS unsigned*)(lds + (bufoff) + ldsw), 16, 0, 0); \
        __builtin_amdgcn_global_load_lds((const unsigned*)(ws + (o1)), (LAS unsigned*)(lds + (bufoff) + ldsw + 8192), 16, 0, 0); } while (0)
#define PG8_LDA(dst, b, h) do { _Pragma("unroll") for (int m = 0; m < 4; ++m) _Pragma("unroll") for (int k = 0; k < 2; ++k) dst[m][k] = *(const LAS bf16x8*)(lds + PG8_SA(b, h) + aoff + m * 2048 + k * 1024); } while (0)
#define PG8_LDB(dst, b, h) do { _Pragma("unroll") for (int n = 0; n < 2; ++n) _Pragma("unroll") for (int k = 0; k < 2; ++k) dst[n][k] = *(const LAS bf16x8*)(lds + PG8_SB(b, h) + boff + n * 2048 + k * 1024); } while (0)
#define PG8_MMA(ai, bj, At, Bt) do { __builtin_amdgcn_s_setprio(1); _Pragma("unroll") for (int m = 0; m < 4; ++m) _Pragma("unroll") for (int n = 0; n < 2; ++n) _Pragma("unroll") for (int k = 0; k < 2; ++k) \
        acc[ai][bj][m][n] = __builtin_amdgcn_mfma_f32_16x16x32_bf16(Bt[n][k], At[m][k], acc[ai][bj][m][n], 0, 0, 0); __builtin_amdgcn_s_setprio(0); } while (0)
#define PG8_WAIT_V(n) asm volatile("s_waitcnt vmcnt(" #n ")" ::: "memory")
#define PG8_WAIT_L(n) asm volatile("s_waitcnt lgkmcnt(" #n ")" ::: "memory")
#define PG8_BAR __builtin_amdgcn_s_barrier()
#define PG8_SCHED __builtin_amdgcn_sched_barrier(0)
    Unit cur, nxt; int ui = 0;
    if (!S.next(0, cur)) return;
    f32x4 acc[2][2][4][2];
#pragma unroll
    for (int a = 0; a < 2; ++a)
#pragma unroll
        for (int b = 0; b < 2; ++b)
#pragma unroll
            for (int m = 0; m < 4; ++m)
#pragma unroll
                for (int n = 0; n < 2; ++n) acc[a][b][m][n] = (f32x4){0.f, 0.f, 0.f, 0.f};
    bf16x8 At[4][2], B0[2][2], B1[2][2];
    unsigned vA00, vA01, vA10, vA11, nA00, nA01, nA10, nA11;
    vA00 = S.arow(cur, RA[0]) + CA[0]; vA01 = S.arow(cur, RA[1]) + CA[1]; vA10 = S.arow(cur, HALF + RA[0]) + CA[0]; vA11 = S.arow(cur, HALF + RA[1]) + CA[1];
    const char* cB = S.bbase(cur);
    PG8_STAGE_B(PG8_SB(0, 0), cB); PG8_STAGE_B(PG8_SB(0, 1), cB + hstep); PG8_STAGE_A(PG8_SA(0, 0), vA00, vA01); PG8_STAGE_A(PG8_SA(0, 1), vA10, vA11);
    if (wr == 1) PG8_BAR;
    PG8_WAIT_V(2); PG8_BAR;
    PG8_STAGE_B(PG8_SB(1, 0), cB + kstep); PG8_STAGE_A(PG8_SA(1, 0), vA00 + kstep, vA01 + kstep); PG8_STAGE_B(PG8_SB(1, 1), cB + hstep + kstep);
    PG8_WAIT_V(6); PG8_BAR;
    for (;;) {
        const bool has_next = S.next(ui + 1, nxt);
        const char* nB = cB; nA00 = vA00; nA01 = vA01; nA10 = vA10; nA11 = vA11;
        if (has_next) { nB = S.bbase(nxt); nA00 = S.arow(nxt, RA[0]) + CA[0]; nA01 = S.arow(nxt, RA[1]) + CA[1]; nA10 = S.arow(nxt, HALF + RA[0]) + CA[0]; nA11 = S.arow(nxt, HALF + RA[1]) + CA[1]; }
#pragma unroll 1
        for (int t = 0; t < nt; t += 2) {
            const bool last = (t == nt - 2);
            const unsigned k1 = (unsigned)(t + 1) * kstep, k2 = last ? 0u : (unsigned)(t + 2) * kstep;
            const char* b2 = last ? nB : cB + (size_t)(t + 2) * kstep; const char* b3 = b2 + kstep;
            const unsigned w00 = (last ? nA00 : vA00) + k2, w01 = (last ? nA01 : vA01) + k2, w10 = (last ? nA10 : vA10) + k2, w11 = (last ? nA11 : vA11) + k2;
            PG8_LDB(B0, 0, 0); PG8_LDB(B1, 0, 1); PG8_SCHED; PG8_LDA(At, 0, 0); PG8_STAGE_A(PG8_SA(1, 1), vA10 + k1, vA11 + k1);
            PG8_WAIT_V(8); PG8_WAIT_L(0); PG8_BAR; PG8_MMA(0, 0, At, B0); PG8_MMA(0, 1, At, B1); PG8_BAR; PG8_SCHED;
            PG8_LDA(At, 0, 1); PG8_STAGE_B(PG8_SB(0, 0), b2); PG8_STAGE_B(PG8_SB(0, 1), b2 + hstep); PG8_STAGE_A(PG8_SA(0, 0), w00, w01);
            PG8_WAIT_V(8); PG8_WAIT_L(0); PG8_BAR; PG8_MMA(1, 0, At, B0); PG8_MMA(1, 1, At, B1); PG8_BAR; PG8_SCHED;
            PG8_LDB(B0, 1, 0); PG8_LDB(B1, 1, 1); PG8_SCHED; PG8_LDA(At, 1, 0); PG8_STAGE_A(PG8_SA(0, 1), w10, w11);
            PG8_WAIT_V(8); PG8_WAIT_L(0); PG8_BAR; PG8_MMA(0, 0, At, B0); PG8_MMA(0, 1, At, B1); PG8_BAR; PG8_SCHED;
            PG8_LDA(At, 1, 1); PG8_STAGE_B(PG8_SB(1, 0), b3); PG8_STAGE_B(PG8_SB(1, 1), b3 + hstep); PG8_STAGE_A(PG8_SA(1, 0), w00 + kstep, w01 + kstep);
            PG8_WAIT_V(8); PG8_WAIT_L(0); PG8_BAR; PG8_MMA(1, 0, At, B0); PG8_MMA(1, 1, At, B1); PG8_BAR; PG8_SCHED;
        }
        if (wr == 0) PG8_BAR;
        E(acc, cur, wr, wc, fr, fq);
        if (!has_next) break;
#pragma unroll
        for (int a = 0; a < 2; ++a)
#pragma unroll
            for (int b = 0; b < 2; ++b)
#pragma unroll
                for (int m = 0; m < 4; ++m)
#pragma unroll
                    for (int n = 0; n < 2; ++n) acc[a][b][m][n] = (f32x4){0.f, 0.f, 0.f, 0.f};
        cur = nxt; cB = nB; vA00 = nA00; vA01 = nA01; vA10 = nA10; vA11 = nA11; ++ui;
        if (wr == 1) PG8_BAR;
    }
    PG8_WAIT_V(0);
    PG8_BAR;
#undef PG8_SA
#undef PG8_SB
#undef PG8_STAGE_A
#undef PG8_STAGE_B
#undef PG8_LDA
#undef PG8_LDB
#undef PG8_MMA
#undef PG8_WAIT_V
#undef PG8_WAIT_L
#undef PG8_BAR
#undef PG8_SCHED
}

struct SchedDense {
    unsigned aoff; const char* Bt; int K, nN, nU, G, c;
    __device__ __forceinline__ bool next(int i, Unit& u) const { const int L = i * G + c; if (L >= nU) return false; u.pm = L / nN; u.pn = L - u.pm * nN; u.e = 0; u.n = 0; u.o = 0; return true; }
    __device__ __forceinline__ unsigned arow(const Unit& u, int r) const { return aoff + (unsigned)((u.pm * BM + r) * K) * 2u; }
    __device__ __forceinline__ const char* bbase(const Unit& u) const { return Bt + (size_t)u.pn * BM * K * 2; }
};
}

typedef f32x4 PAcc[2][2][4][2];
__device__ __forceinline__ u32x4 pk8(const f32x4& a, const f32x4& b) { u32x4 w; w.x = pk2(a[0], a[1]); w.y = pk2(a[2], a[3]); w.z = pk2(b[0], b[1]); w.w = pk2(b[2], b[3]); return w; }
struct PEpiQKV {
    bf16_t *Q, *K, *V; const float* rope;
    __device__ __forceinline__ void operator()(const PAcc& acc, const pg8::Unit& u, int wr, int wc, int fr, int fq) const {
        const bool latent = u.pm < TL / 256;
#pragma unroll
        for (int bj = 0; bj < 2; ++bj) {
            const int cb = u.pn * 256 + bj * 128 + wc * 32;
            const bool isq = cb < 1024, isk = (cb >= 1024 && cb < 1280), roped = (isq || isk) && latent, colpos = (cb >> 5) & 1;
            bf16_t* base = (isq ? Q + cb : isk ? K + (cb - 1024) : V + (cb - 1280)) + 8 * fq;
            const size_t pitch = isq ? 1024 : 256;
            const float sc = isq ? QSCALE : 1.f;
#pragma unroll
            for (int ai = 0; ai < 2; ++ai)
#pragma unroll
                for (int m = 0; m < 4; ++m) {
                    const int r = u.pm * 256 + ai * 128 + wr * 64 + m * 16 + fr;
                    f32x4 v0 = acc[ai][bj][m][0], v1 = acc[ai][bj][m][1];
                    if (roped) {
                        f32x4 p0, p1;
#pragma unroll
                        for (int j = 0; j < 4; ++j) { p0[j] = __shfl_xor(v0[j], 32); p1[j] = __shfl_xor(v1[j], 32); }
                        const int s = r & (S - 1), pos = colpos ? (s & 63) : (s >> 6);
                        const float* rp = rope + pos * 16 + (fq & 1) * 8;
                        const f32x4 c0 = *(const f32x4*)rp, c1 = *(const f32x4*)(rp + 4), s0 = *(const f32x4*)(rp + 1024), s1 = *(const f32x4*)(rp + 1028);
                        if (fq < 2) { v0 = v0 * c0 - p0 * s0; v1 = v1 * c1 - p1 * s1; } else { v0 = v0 * c0 + p0 * s0; v1 = v1 * c1 + p1 * s1; }
                    }
                    *(u32x4*)(base + (size_t)r * pitch) = pk8(v0 * sc, v1 * sc);
                }
        }
    }
};
struct PEpiResid {
    const float* srcL; const float* srcC; float* dstL; float* dstC; const float* mod; int gchunk;
    __device__ __forceinline__ void operator()(const PAcc& acc, const pg8::Unit& u, int wr, int wc, int fr, int fq) const {
        const bool latent = u.pm < TL / 256;
        const int rt0 = u.pm * 256 - (latent ? 0 : TL);
        const float* sb = (latent ? srcL : srcC) + (size_t)(rt0 + wr * 64 + fr) * D + u.pn * 256 + wc * 32 + 8 * fq;
        float* db = (latent ? dstL : dstC) + (size_t)(rt0 + wr * 64 + fr) * D + u.pn * 256 + wc * 32 + 8 * fq;
        const float* gp = mod + mod_row(u.pm * 256) * 6144 + gchunk * 1024 + u.pn * 256 + wc * 32 + 8 * fq;
        const f32x4 g00 = *(const f32x4*)gp, g01 = *(const f32x4*)(gp + 4), g10 = *(const f32x4*)(gp + 128), g11 = *(const f32x4*)(gp + 132);
#pragma unroll
        for (int ai = 0; ai < 2; ++ai)
#pragma unroll
            for (int m = 0; m < 4; ++m) {
                const size_t ro = (size_t)(ai * 128 + m * 16) * D;
                const f32x4 a0 = *(const f32x4*)(sb + ro), a1 = *(const f32x4*)(sb + ro + 4), a2 = *(const f32x4*)(sb + ro + 128), a3 = *(const f32x4*)(sb + ro + 132);
                *(f32x4*)(db + ro) = a0 + g00 * acc[ai][0][m][0]; *(f32x4*)(db + ro + 4) = a1 + g01 * acc[ai][0][m][1];
                *(f32x4*)(db + ro + 128) = a2 + g10 * acc[ai][1][m][0]; *(f32x4*)(db + ro + 132) = a3 + g11 * acc[ai][1][m][1];
            }
    }
};
struct PEpiInProj {
    bf16_t* G; bf16_t* PU;
    __device__ __forceinline__ void operator()(const PAcc& acc, const pg8::Unit& u, int wr, int wc, int fr, int fq) const {
        const bool isg = u.pn < 5;
        if (isg && u.pm >= TL / 256) return;
        bf16_t* base = (isg ? G + u.pn * 256 : PU + (u.pn * 256 - DR)) + (size_t)(u.pm * 256 + wr * 64 + fr) * DR + wc * 32 + 8 * fq;
#pragma unroll
        for (int ai = 0; ai < 2; ++ai)
#pragma unroll
            for (int m = 0; m < 4; ++m)
#pragma unroll
                for (int bj = 0; bj < 2; ++bj) {
                    f32x4 v0 = acc[ai][bj][m][0], v1 = acc[ai][bj][m][1];
                    if (isg) {
#pragma unroll
                        for (int j = 0; j < 4; ++j) { v0[j] = gelu_tanh(v0[j]); v1[j] = gelu_tanh(v1[j]); }
                    }
                    *(u32x4*)(base + (size_t)(ai * 128 + m * 16) * DR + bj * 128) = pk8(v0, v1);
                }
    }
};
struct PEpiAct {
    bf16_t* act; bf16_t* acts;
    __device__ __forceinline__ void operator()(const PAcc& acc, const pg8::Unit& u, int wr, int wc, int fr, int fq) const {
        bf16_t* base = (u.e >= NE ? acts : act + (size_t)u.o * DE) + u.pn * 128 + wc * 32 + 8 * fq;
#pragma unroll
        for (int ai = 0; ai < 2; ++ai)
#pragma unroll
            for (int m = 0; m < 4; ++m) {
                const int r = u.pm * 256 + ai * 128 + wr * 64 + m * 16 + fr;
                f32x4 v0, v1;
#pragma unroll
                for (int j = 0; j < 4; ++j) { v0[j] = silu_f(acc[ai][0][m][0][j]) * acc[ai][1][m][0][j]; v1[j] = silu_f(acc[ai][0][m][1][j]) * acc[ai][1][m][1][j]; }
                if (r < u.n) *(u32x4*)(base + (size_t)r * DE) = pk8(v0, v1);
            }
    }
};
struct PEpiDown {
    bf16_t* Y; float* xl; float* xc; const float* mod;
    __device__ __forceinline__ void operator()(const PAcc& acc, const pg8::Unit& u, int wr, int wc, int fr, int fq) const {
        if (u.e < NE) {
            bf16_t* base = Y + (size_t)u.o * D + u.pn * 256 + wc * 32 + 8 * fq;
#pragma unroll
            for (int ai = 0; ai < 2; ++ai)
#pragma unroll
                for (int m = 0; m < 4; ++m) {
                    const int r = u.pm * 256 + ai * 128 + wr * 64 + m * 16 + fr;
                    if (r < u.n) {
                        *(u32x4*)(base + (size_t)r * D) = pk8(acc[ai][0][m][0], acc[ai][0][m][1]);
                        *(u32x4*)(base + (size_t)r * D + 128) = pk8(acc[ai][1][m][0], acc[ai][1][m][1]);
                    }
                }
        } else {
            const bool latent = u.pm < TL / 256;
            float* db = (latent ? xl + (size_t)(u.pm * 256) * D : xc + (size_t)(u.pm * 256 - TL) * D) + (size_t)(wr * 64 + fr) * D + u.pn * 256 + wc * 32 + 8 * fq;
            const float* gp = mod + mod_row(u.pm * 256) * 6144 + 5 * 1024 + u.pn * 256 + wc * 32 + 8 * fq;
            const f32x4 g00 = *(const f32x4*)gp, g01 = *(const f32x4*)(gp + 4), g10 = *(const f32x4*)(gp + 128), g11 = *(const f32x4*)(gp + 132);
#pragma unroll
            for (int ai = 0; ai < 2; ++ai)
#pragma unroll
                for (int m = 0; m < 4; ++m) {
                    float* d = db + (size_t)(ai * 128 + m * 16) * D;
                    const f32x4 a0 = *(const f32x4*)d, a1 = *(const f32x4*)(d + 4), a2 = *(const f32x4*)(d + 128), a3 = *(const f32x4*)(d + 132);
                    *(f32x4*)d = a0 + g00 * acc[ai][0][m][0]; *(f32x4*)(d + 4) = a1 + g01 * acc[ai][0][m][1];
                    *(f32x4*)(d + 128) = a2 + g10 * acc[ai][1][m][0]; *(f32x4*)(d + 132) = a3 + g11 * acc[ai][1][m][1];
                }
        }
    }
};

#define vblock() (c.vb)

template <class RowMap>
__device__ __forceinline__ void tr_item64(const float* W, int ldw, int k0, int n0, bf16_t* dst, int ldd, const RowMap& rm, int lane) {
    const int nq = lane >> 3, kg = lane & 7;
    f32x4 v[16];
    const float* src = W + (size_t)(k0 + kg * 8) * ldw + n0 + 4 * nq;
#pragma unroll
    for (int h = 0; h < 2; ++h)
#pragma unroll
        for (int i = 0; i < 8; ++i) v[h * 8 + i] = *(const f32x4*)(src + (size_t)i * ldw + h * 32);
#pragma unroll
    for (int h = 0; h < 2; ++h)
#pragma unroll
        for (int cc = 0; cc < 4; ++cc) {
            bf16_t* drow = dst + (size_t)rm(n0 + h * 32 + 4 * nq + cc) * ldd + k0 + kg * 8;
            u32x4 o; o.x = pk2(v[h * 8 + 0][cc], v[h * 8 + 1][cc]); o.y = pk2(v[h * 8 + 2][cc], v[h * 8 + 3][cc]); o.z = pk2(v[h * 8 + 4][cc], v[h * 8 + 5][cc]); o.w = pk2(v[h * 8 + 6][cc], v[h * 8 + 7][cc]);
            *(u32x4*)drow = o;
        }
}
struct RMPlain { __device__ __forceinline__ int operator()(int n) const { return n; } };
struct RMGateUp { int mat; __device__ __forceinline__ int operator()(int h) const { return (h >> 7) * 256 + mat * 128 + (h & 127); } };
__device__ __forceinline__ void tr_plain(const float* W, int K, int N, bf16_t* dst, int item, int lane) {
    const int nb = N / 64, kb = item / nb, n0 = (item % nb) * 64;
    tr_item64(W, N, kb * 64, n0, dst, K, RMPlain{}, lane);
}
__device__ __forceinline__ void tr_expert(const float* Wg, const float* Wu, const float* Wd, bf16_t* gu, bf16_t* dn, int item, int lane) {
    if (item < 128) {
        const int mat = item >> 6, it = item & 63, kb = it >> 2, n0 = (it & 3) * 64;
        tr_item64(Wg + (size_t)mat * (Wu - Wg), DE, kb * 64, n0, gu, D, RMGateUp{mat}, lane);
    } else {
        const int it = item - 128, kb = it >> 4, n0 = (it & 15) * 64;
        tr_item64(Wd, D, kb * 64, n0, dn, DE, RMPlain{}, lane);
    }
}
struct Ctx {
    const Params& p; float* lds; ldsp_t smem; ldsp_t bsmem; unsigned char* blds;
    int tid, lane, wid, vb, vbid, vgrid;
    __device__ __forceinline__ Ctx(const Params& p_, unsigned char* base) : p(p_) {
        const int g = __builtin_amdgcn_readfirstlane((int)threadIdx.x >> 8);
        blds = base; bsmem = (ldsp_t)base; lds = (float*)(base + g * HALF_LDS); smem = (ldsp_t)base + g * HALF_LDS;
        tid = threadIdx.x & (GT - 1); lane = tid & 63; wid = tid >> 6; vbid = blockIdx.x * 2 + g; vgrid = gridDim.x * 2; vb = vbid; }
    __device__ __forceinline__ void refresh() { int t = threadIdx.x; asm volatile("" : "+v"(t)); tid = t & (GT - 1); lane = tid & 63; wid = tid >> 6; }
#define WSF(name, type, off) __device__ __forceinline__ type* name() const { return (type*)(p.ws + (off)); }
    WSF(cnt, unsigned, CTL_CNT) WSF(mod, float, CTL_MOD) WSF(rope, float, WS_ROPE) WSF(sum, float, WS_SUM)
    WSF(AE, int, WS_AE) WSF(AW, float, WS_AW) WSF(APOS, int, WS_APOS) WSF(LIST, int, WS_LIST) WSF(XC, float, WS_XC)
    WSF(H, bf16_t, WS_H) WSF(ACT, bf16_t, WS_ACT) WSF(ACTS, bf16_t, WS_ACTS) WSF(Y, bf16_t, WS_BIG)
    WSF(Qb, bf16_t, WS_Q) WSF(Kb, bf16_t, WS_K) WSF(Vb, bf16_t, WS_V) WSF(Ob, bf16_t, WS_O)
    WSF(WQKV, bf16_t, WS_WQKV) WSF(WO, bf16_t, WS_WO) WSF(WIN, bf16_t, WS_WIN) WSF(WOUT, bf16_t, WS_WOUT) WSF(WSH, bf16_t, WS_WSH) WSF(WMOE, bf16_t, WS_WMOE)
    WSF(WGATES, bf16_t, WS_WGATES) WSF(WROUTER, bf16_t, WS_WROUTER) WSF(LC8, float, WS_LC8) WSF(CARRY, float, WS_CARRY)
    WSF(G, bf16_t, WS_G) WSF(PU, bf16_t, WS_PU) WSF(HG, bf16_t, WS_G) WSF(AB, float, WS_AB) WSF(HS, float, WS_WMOE)
#undef WSF
};

__device__ __forceinline__ void ph_prep(Ctx& c) {
    const float* cv = c.p.in[1]; const float* cctx = c.p.in[3]; const float* aw = c.p.in[4]; const float* ab = c.p.in[5];
    float* sil = c.lds;
    float* red = c.lds + 5120;
    __syncthreads();
    for (int i = c.tid; i < 5 * 1024; i += GT) { const int r = i >> 10, k = i & 1023; const float v = r < 4 ? cv[r * 1024 + k] : cctx[k]; sil[i] = silu_f(v); }
    __syncthreads();
    for (int item = c.vbid; item < 2 * 96; item += c.vgrid) {
        const int l = item / 96, jb = item % 96, kq = c.tid >> 4, cq = c.tid & 15;
        f32x4 a0 = {0, 0, 0, 0}, a1 = a0, a2 = a0, a3 = a0, a4 = a0;
        const float* w = aw + ((size_t)l * 1024 + kq * 64) * 6144 + jb * 64 + cq * 4;
        const float* sl = sil + kq * 64;
#pragma unroll 8
        for (int k = 0; k < 64; ++k) { const f32x4 wv = *(const f32x4*)(w + (size_t)k * 6144); a0 += sl[k] * wv; a1 += sl[1024 + k] * wv; a2 += sl[2048 + k] * wv; a3 += sl[3072 + k] * wv; a4 += sl[4096 + k] * wv; }
        float* rr = red + kq * 320 + cq * 4;
        *(f32x4*)(rr) = a0; *(f32x4*)(rr + 64) = a1; *(f32x4*)(rr + 128) = a2; *(f32x4*)(rr + 192) = a3; *(f32x4*)(rr + 256) = a4;
        __syncthreads();
        for (int i = c.tid; i < 320; i += GT) {
            const int r = i >> 6, jj = i & 63;
            float v = 0.f;
#pragma unroll
            for (int q = 0; q < 16; ++q) v += red[q * 320 + i];
            c.mod()[((size_t)l * 5 + r) * 6144 + jb * 64 + jj] = v + ab[l * 6144 + jb * 64 + jj];
        }
        __syncthreads();
    }
    if (c.vbid == c.vgrid - 1) {
        for (int i = c.tid; i < 1024; i += GT) {
            const int pos = i >> 4, f = i & 15;
            const float inv = expf(-logf(10000.0f) * (float)f / 16.0f);
            const float ang = (float)pos * inv;
            c.rope()[i] = cosf(ang); c.rope()[1024 + i] = sinf(ang);
        }
    }
}


__device__ __forceinline__ int find_expert(const int* tp, int rt) {
    const int lane = threadIdx.x & 63;
    const unsigned long long m = __ballot(tp[lane] <= rt);
    const int e = tp[64] <= rt ? 64 : (int)__popcll(m) - 1;
    return __builtin_amdgcn_readfirstlane(e);
}


__device__ __forceinline__ void ph_convert_small(Ctx& c) {
    const int wu = __builtin_amdgcn_readfirstlane(c.wid);
    const int gw = c.vbid * 4 + wu, NGW = c.vgrid * 4;
    constexpr int I_QKV = 16 * 24, I_O = 16 * 16, I_IN = 16 * 40, I_OUT = 20 * 16, I_SH = 192, I_R = 16;
    constexpr int NIT = I_QKV + I_O + I_IN + I_OUT + 2 * I_SH + 2 * I_R;
    for (int it = gw; it < NIT; it += NGW) {
        int r = it;
        if (r < I_QKV) { tr_plain(c.p.in[8], 1024, 1536, c.WQKV(), r, c.lane); continue; } r -= I_QKV;
        if (r < I_O) { tr_plain(c.p.in[9], 1024, 1024, c.WO(), r, c.lane); continue; } r -= I_O;
        if (r < I_IN) { tr_plain(c.p.in[11], 1024, 2560, c.WIN(), r, c.lane); continue; } r -= I_IN;
        if (r < I_OUT) { tr_plain(c.p.in[19], 1280, 1024, c.WOUT(), r, c.lane); continue; } r -= I_OUT;
        if (r < 2 * I_SH) {
            const int l = r / I_SH; r %= I_SH;
            bf16_t* base = c.WSH() + (size_t)l * (WSH_LAYER / 2);
            tr_expert(c.p.in[25] + (size_t)l * D * DE, c.p.in[26] + (size_t)l * D * DE, c.p.in[27] + (size_t)l * DE * D, base, base + WSH_D / 2, r, c.lane);
            continue;
        }
        r -= 2 * I_SH;
        { const int l = r / I_R; r %= I_R; tr_plain(c.p.in[20] + (size_t)l * D * NE, D, NE, c.WROUTER() + (size_t)l * 128 * D, r, c.lane); }
    }
    for (int i = c.vbid * GT + c.tid; i < 2 * 64 * D / 8; i += c.vgrid * GT) { const int l = i / (64 * D / 8), o = i % (64 * D / 8); *(u32x4*)(c.WROUTER() + (size_t)l * 128 * D + 64 * D + (size_t)o * 8) = (u32x4){0u, 0u, 0u, 0u}; }
}
__device__ __forceinline__ void ph_convert_moe(Ctx& c, int layer) {
    const int wu = __builtin_amdgcn_readfirstlane(c.wid);
    const int gw = vblock() * 4 + wu, NGW = c.vgrid * 4;
    for (int it = gw; it < NE * 192; it += NGW) {
        const int e = it / 192, r = it % 192; const size_t eo = ((size_t)layer * NE + e) * D * DE;
        tr_expert(c.p.in[22] + eo, c.p.in[23] + eo, c.p.in[24] + eo, c.WMOE() + (size_t)e * 512 * 1024, c.WMOE() + WMOE_D / 2 + (size_t)e * 1024 * 256, r, c.lane);
    }
}
__device__ __forceinline__ pg8::SchedDense mk_dense(Ctx& c, size_t aoff, const bf16_t* Bt, int K, int nM, int nN) {
    return pg8::SchedDense{(unsigned)aoff, (const char*)Bt, K, nN, nM * nN, (int)gridDim.x, c.vb >> 1};
}
__device__ __forceinline__ void ph_qkv_m(Ctx& c) { const PEpiQKV ep{c.Qb(), c.Kb(), c.Vb(), c.rope()}; const pg8::SchedDense sd = mk_dense(c, WS_H, c.WQKV(), D, T0 / 256, QKVN / 256); pg8::gemm_phase(c.bsmem, c.p.ws, sd, ep, D); }
__device__ __forceinline__ void ph_oproj_m(Ctx& c) { const PEpiResid ep{c.p.in[0], c.p.in[2], c.p.out, c.XC(), c.mod(), 2}; const pg8::SchedDense sd = mk_dense(c, WS_O, c.WO(), D, T0 / 256, D / 256); pg8::gemm_phase(c.bsmem, c.p.ws, sd, ep, D); }
__device__ __forceinline__ void ph_inproj_m(Ctx& c) { const PEpiInProj ep{c.G(), c.PU()}; const pg8::SchedDense sd = mk_dense(c, WS_H, c.WIN(), D, T0 / 256, 2 * DR / 256); pg8::gemm_phase(c.bsmem, c.p.ws, sd, ep, D); }
__device__ __forceinline__ void ph_outproj_m(Ctx& c) { const PEpiResid ep{c.p.out, c.XC(), c.p.out, c.XC(), c.mod() + 5 * 6144, 2}; const pg8::SchedDense sd = mk_dense(c, WS_G, c.WOUT(), DR, TL / 256, D / 256); pg8::gemm_phase(c.bsmem, c.p.ws, sd, ep, DR); }

__device__ __forceinline__ void moe_tables(Ctx& c, int layer, int T, int* tbl) {
    const int tx = threadIdx.x;
    __syncthreads();
    if (tx < 64) {
        const int n = (int)c.cnt()[layer * 64 + tx], nt = (n + 255) >> 8;
        int o = n, t = nt;
#pragma unroll
        for (int d = 1; d < 64; d <<= 1) { const int o2 = __shfl_up(o, d), t2 = __shfl_up(t, d); if (tx >= d) { o += o2; t += t2; } }
        tbl[136 + tx] = n; tbl[tx] = o - n; tbl[65 + tx] = t - nt;
        if (tx == 63) { tbl[64] = o; tbl[65 + 64] = t; tbl[65 + 65] = t + ((T + 255) >> 8); }
    }
    __syncthreads();
}
template <bool GATHER>
struct SchedMoE {
    const int* tbl; const int* list; const char* Wr; const char* Wsh; size_t wstride; int K, NT, T, nU, G, c;
    __device__ __forceinline__ bool next(int i, pg8::Unit& u) const {
        const int L = i * G + c; if (L >= nU) return false;
        const int rt = L / NT, e = find_expert(tbl + 65, rt);
        u.pn = L - rt * NT; u.e = e; u.pm = __builtin_amdgcn_readfirstlane(rt - tbl[65 + e]);
        u.n = e >= NE ? T : __builtin_amdgcn_readfirstlane(tbl[136 + e]); u.o = e >= NE ? 0 : __builtin_amdgcn_readfirstlane(tbl[e]);
        return true;
    }
    __device__ __forceinline__ unsigned arow(const pg8::Unit& u, int r) const {
        const int idx = u.pm * 256 + r;
        if (GATHER) { int tok = idx; if (u.e < NE) tok = idx < u.n ? (list[(size_t)u.e * T0 + idx] >> 3) : 0; return (unsigned)WS_H + (unsigned)tok * (unsigned)(D * 2); }
        return u.e >= NE ? (unsigned)WS_ACTS + (unsigned)idx * (unsigned)(DE * 2) : (unsigned)WS_ACT + (unsigned)(u.o + idx) * (unsigned)(DE * 2);
    }
    __device__ __forceinline__ const char* bbase(const pg8::Unit& u) const { return (u.e >= NE ? Wsh : Wr + (size_t)u.e * wstride) + (size_t)u.pn * 256 * K * 2; }
};
__device__ __forceinline__ void ph_moe_gateup_m(Ctx& c, int layer, int T) {
    int* tbl = (int*)(c.blds + SH_TBL);
    moe_tables(c, layer, T, tbl);
    const PEpiAct ep{c.ACT(), c.ACTS()};
    const SchedMoE<true> sm{tbl, c.LIST(), (const char*)c.WMOE(), (const char*)(c.WSH() + (size_t)layer * (WSH_LAYER / 2)), (size_t)512 * 1024 * 2, D, 2, T, __builtin_amdgcn_readfirstlane(tbl[65 + 65]) * 2, (int)gridDim.x, c.vb >> 1};
    pg8::gemm_phase(c.bsmem, c.p.ws, sm, ep, D);
}
__device__ __forceinline__ void ph_moe_down_m(Ctx& c, int layer, int T) {
    int* tbl = (int*)(c.blds + SH_TBL);
    moe_tables(c, layer, T, tbl);
    const PEpiDown ep{c.Y(), c.p.out, c.XC(), c.mod() + (size_t)layer * 5 * 6144};
    const SchedMoE<false> sm{tbl, c.LIST(), (const char*)c.WMOE() + WMOE_D, (const char*)(c.WSH() + (size_t)layer * (WSH_LAYER / 2) + WSH_D / 2), (size_t)1024 * 256 * 2, DE, 4, T, __builtin_amdgcn_readfirstlane(tbl[65 + 65]) * 4, (int)gridDim.x, c.vb >> 1};
    pg8::gemm_phase(c.bsmem, c.p.ws, sm, ep, DE);
}


constexpr int NCH = 68;
constexpr int LU_PITCH = 104;
__device__ __forceinline__ float fast_sigmoid(float x) { return __builtin_amdgcn_rcpf(1.f + __builtin_amdgcn_exp2f(-LOG2E * x)); }
__device__ __forceinline__ void ph_convert_gates(Ctx& c) {
    const int NT = c.vgrid * GT, g0 = c.vbid * GT + c.tid;
    for (int i = g0; i < 2 * 2 * NBLK * BW * 96; i += NT) {
        const int k = i % 96, col = (i / 96) % BW, n = (i / (96 * BW)) % NBLK, mat = (i / (96 * BW * NBLK)) & 1, d = i / (96 * BW * NBLK * 2);
        const float* w = (mat ? c.p.in[16] : c.p.in[14]) + (((size_t)d * NBLK + n) * BW) * BW;
        c.WGATES()[i] = k < BW ? f2bf(w[(size_t)k * BW + col]) : (bf16_t)0;
    }
    for (int i = g0; i < 2 * DR; i += NT) c.LC8()[i] = 8.0f * LOG2E * log1pf(expf(-c.p.in[18][i]));
}
constexpr int L2_U = 0, L2_RAW = 13312, L2_OUT = L2_RAW + 10752, L2_END = L2_OUT + 2 * 64 * BW * 4;
template <bool REV, int PASS>
__device__ __forceinline__ void lru_scan16(const float (&a)[4][4], const float (&b)[4][4], float& cm, float& ptot, float (&h)[4][4], int lane, int fq) {
    const int l16 = REV ? ((lane + 16) & 63) : ((lane - 16) & 63), l32 = REV ? ((lane + 32) & 63) : ((lane - 32) & 63);
    const int ltot = (lane & 15) + (REV ? 0 : 48);
    float P[4], H[4], Pe[4], He[4], Pt[4], Ht[4];
#pragma unroll
    for (int m = 0; m < 4; ++m) {
        P[m] = 1.f; H[m] = 0.f;
#pragma unroll
        for (int jj = 0; jj < 4; ++jj) { const int j = REV ? 3 - jj : jj; H[m] = a[m][j] * H[m] + b[m][j]; P[m] *= a[m][j]; }
    }
    {   float Pp[4], Hp[4];
#pragma unroll
        for (int m = 0; m < 4; ++m) { Pp[m] = __shfl(P[m], l16); Hp[m] = __shfl(H[m], l16); }
#pragma unroll
        for (int m = 0; m < 4; ++m) if (REV ? (fq <= 2) : (fq >= 1)) { H[m] = P[m] * Hp[m] + H[m]; P[m] = P[m] * Pp[m]; }
#pragma unroll
        for (int m = 0; m < 4; ++m) { Pp[m] = __shfl(P[m], l32); Hp[m] = __shfl(H[m], l32); }
#pragma unroll
        for (int m = 0; m < 4; ++m) if (REV ? (fq <= 1) : (fq >= 2)) { H[m] = P[m] * Hp[m] + H[m]; P[m] = P[m] * Pp[m]; }
    }
#pragma unroll
    for (int m = 0; m < 4; ++m) { Pe[m] = __shfl(P[m], l16); He[m] = __shfl(H[m], l16); Pt[m] = __shfl(P[m], ltot); Ht[m] = __shfl(H[m], ltot); }
#pragma unroll
    for (int m = 0; m < 4; ++m) if (REV ? (fq == 3) : (fq == 0)) { Pe[m] = 1.f; He[m] = 0.f; }
#pragma unroll
    for (int mm = 0; mm < 4; ++mm) {
        const int m = REV ? 3 - mm : mm;
        const float hin = Pe[m] * cm + He[m];
        cm = Pt[m] * cm + Ht[m]; ptot *= Pt[m];
        if (PASS == 2) {
            float hh = hin;
#pragma unroll
            for (int jj = 0; jj < 4; ++jj) { const int j = REV ? 3 - jj : jj; hh = a[m][j] * hh + b[m][j]; h[m][j] = hh; }
        }
    }
}
template <int PASS>
__device__ __forceinline__ void ph_lru_pass(Ctx& c) {
    const int wu = __builtin_amdgcn_readfirstlane(c.wid), lane = c.lane, fr = lane & 15, fq = lane >> 4;
    const int dir = wu >> 1, nt0 = (wu & 1) ? 3 : 0, nnt = (wu & 1) ? 2 : 3;
    constexpr int NC = PASS == 1 ? NCH : 64;
    const float* cw = c.p.in[12]; const float* cb = c.p.in[13];
#pragma unroll 1
    for (int unit = vblock(); unit < NB * NC * NBLK; unit += c.vgrid) {
        const int n = unit % NBLK, cidx = (unit / NBLK) % NC + (PASS == 1 ? 0 : 4), b = unit / (NBLK * NC);
        int r0, seq0, seqn;
        if (cidx < 4) { seq0 = TL + b * C; seqn = C; r0 = seq0 + cidx * 64; } else { seq0 = b * S; seqn = S; r0 = seq0 + (cidx - 4) * 64; }
        __syncthreads();
        for (int idx = c.tid; idx < 67 * 10; idx += GT) {
            const int row = idx / 10, c8i = idx % 10, rr = r0 - 2 + row;
            u32x4 v = (u32x4){0u, 0u, 0u, 0u};
            if (rr >= seq0 && rr < seq0 + seqn) v = *(const u32x4*)(c.PU() + (size_t)rr * DR + n * BW + c8i * 8);
            *(LAS u32x4*)(c.smem + L2_RAW + row * 160 + c8i * 16) = v;
        }
        __syncthreads();
        for (int idx = c.tid; idx < 64 * 20; idx += GT) {
            const int t = idx / 20, c4 = (idx % 20) * 4, ch = n * BW + c4;
            float u0 = cb[ch], u1 = cb[ch + 1], u2 = cb[ch + 2], u3 = cb[ch + 3];
#pragma unroll
            for (int j = 0; j < 4; ++j) {
                const u32x2 raw = *(const LAS u32x2*)(c.smem + L2_RAW + (t + j) * 160 + c4 * 2);
                const float4 w = *(const float4*)(cw + j * DR + ch);
                u0 += w.x * __uint_as_float(raw.x << 16); u1 += w.y * __uint_as_float(raw.x & 0xffff0000u);
                u2 += w.z * __uint_as_float(raw.y << 16); u3 += w.w * __uint_as_float(raw.y & 0xffff0000u);
            }
            u32x2 o; o.x = pk2(u0, u1); o.y = pk2(u2, u3);
            *(LAS u32x2*)(c.smem + L2_U + (t * LU_PITCH + c4) * 2) = o;
        }
        for (int idx = c.tid; idx < 64 * 3; idx += GT) { const int t = idx / 3, q = idx % 3; *(LAS u32x4*)(c.smem + L2_U + (t * LU_PITCH + 80 + q * 8) * 2) = (u32x4){0u, 0u, 0u, 0u}; }
        __syncthreads();
        bf16x8 af[4][3];
#pragma unroll
        for (int m = 0; m < 4; ++m)
#pragma unroll
            for (int ks = 0; ks < 3; ++ks) af[m][ks] = *(const LAS bf16x8*)(c.smem + L2_U + (16 * m + fr) * (LU_PITCH * 2) + (ks * 32 + fq * 8) * 2);
        const bf16_t* wbase = c.WGATES() + ((((size_t)dir * 2) * NBLK + n) * BW + fr) * 96 + fq * 8;
        bf16x8 bcur[2][3];
#pragma unroll
        for (int mat = 0; mat < 2; ++mat)
#pragma unroll
            for (int ks = 0; ks < 3; ++ks) bcur[mat][ks] = *(const bf16x8*)(wbase + (size_t)mat * NBLK * BW * 96 + nt0 * 16 * 96 + ks * 32);
#pragma unroll 1
        for (int i = 0; i < nnt; ++i) {
            const int nt = nt0 + i, cl = nt * 16 + fr, ch = n * BW + cl;
            const float bav = c.p.in[15][dir * DR + ch], bxv = c.p.in[17][dir * DR + ch], c8v = c.LC8()[dir * DR + ch];
            float cm = PASS == 1 ? 0.f : c.CARRY()[((size_t)(b * 2 + dir) * NCH + cidx) * DR + ch], ptot = 1.f;
            f32x4 acc[2][4];
#pragma unroll
            for (int mat = 0; mat < 2; ++mat)
#pragma unroll
                for (int m = 0; m < 4; ++m) {
                    acc[mat][m] = (f32x4){0.f, 0.f, 0.f, 0.f};
#pragma unroll
                    for (int ks = 0; ks < 3; ++ks) acc[mat][m] = __builtin_amdgcn_mfma_f32_16x16x32_bf16(af[m][ks], bcur[mat][ks], acc[mat][m], 0, 0, 0);
                }
            if (i + 1 < nnt) {
#pragma unroll
                for (int mat = 0; mat < 2; ++mat)
#pragma unroll
                    for (int ks = 0; ks < 3; ++ks) bcur[mat][ks] = *(const bf16x8*)(wbase + (size_t)mat * NBLK * BW * 96 + (nt + 1) * 16 * 96 + ks * 32);
            }
            float av[4][4], bv[4][4], hv[4][4];
#pragma unroll
            for (int m = 0; m < 4; ++m)
#pragma unroll
                for (int j = 0; j < 4; ++j) {
                    const int t = 16 * m + fq * 4 + j;
                    const float r = fast_sigmoid(acc[0][m][j] + bav), ig = fast_sigmoid(acc[1][m][j] + bxv);
                    const float a = __builtin_amdgcn_exp2f(-c8v * r);
                    const float uv = bf2f(*(const LAS bf16_t*)(c.smem + L2_U + (t * LU_PITCH + cl) * 2));
                    av[m][j] = a; bv[m][j] = __builtin_amdgcn_sqrtf(fmaxf(1.f - a * a, 0.f)) * (ig * uv);
                }
            if (dir == 0) lru_scan16<false, PASS>(av, bv, cm, ptot, hv, lane, fq); else lru_scan16<true, PASS>(av, bv, cm, ptot, hv, lane, fq);
            if (PASS == 1) {
                if (fq == 0) { float* sp = c.sum() + (((size_t)(b * 2 + dir) * NCH + cidx) * 2) * DR + ch; sp[0] = ptot; sp[DR] = cm; }
            } else {
#pragma unroll
                for (int m = 0; m < 4; ++m)
#pragma unroll
                    for (int j = 0; j < 4; ++j) *(LAS float*)(c.smem + L2_OUT + ((dir * 64 + 16 * m + fq * 4 + j) * BW + cl) * 4) = hv[m][j];
            }
        }
        if (PASS == 2) {
            __syncthreads();
            for (int idx = c.tid; idx < 64 * 20; idx += GT) {
                const int t = idx / 20, c4 = (idx % 20) * 4;
                const f32x4 h0 = *(const LAS f32x4*)(c.smem + L2_OUT + (t * BW + c4) * 4), h1 = *(const LAS f32x4*)(c.smem + L2_OUT + ((64 + t) * BW + c4) * 4);
                bf16_t* gp = c.G() + (size_t)(r0 + t) * DR + n * BW + c4;
                const uint2 g = *(const uint2*)gp;
                st_bf16x4(gp, (h0[0] + h1[0]) * __uint_as_float(g.x << 16), (h0[1] + h1[1]) * __uint_as_float(g.x & 0xffff0000u),
                          (h0[2] + h1[2]) * __uint_as_float(g.y << 16), (h0[3] + h1[3]) * __uint_as_float(g.y & 0xffff0000u));
            }
        }
    }
}
__device__ __forceinline__ void ph_lru_carry(Ctx& c) {
    for (int i = c.vbid * GT + c.tid; i < NB * 2 * DR; i += c.vgrid * GT) {
        const int ch = i % DR, d = (i / DR) & 1, b = i / (2 * DR);
        const float* sp = c.sum() + ((size_t)(b * 2 + d) * NCH * 2) * DR + ch; float* cp = c.CARRY() + ((size_t)(b * 2 + d) * NCH) * DR + ch;
        float h = 0.f;
#pragma unroll 1
        for (int q = 0; q < 4; ++q) {
            float P[17], Hh[17];
#pragma unroll
            for (int j = 0; j < 17; ++j) { const int s = q * 17 + j, k = d == 0 ? s : (s < 4 ? 3 - s : NCH + 3 - s); P[j] = sp[(size_t)k * 2 * DR]; Hh[j] = sp[(size_t)k * 2 * DR + DR]; }
#pragma unroll
            for (int j = 0; j < 17; ++j) { const int s = q * 17 + j, k = d == 0 ? s : (s < 4 ? 3 - s : NCH + 3 - s); cp[(size_t)k * DR] = h; h = P[j] * h + Hh[j]; }
        }
    }
}


typedef float f32x16 __attribute__((ext_vector_type(16)));
typedef short s16x4 __attribute__((ext_vector_type(4)));
__device__ __forceinline__ s16x4 vtr(const LAS unsigned char* p) { return __builtin_bit_cast(s16x4, __builtin_amdgcn_ds_read_tr16_b64_v4i16((LAS s16x4*)p)); }
constexpr int AT_BUF = 16384;
__device__ __forceinline__ void ph_attn_m(Ctx& c) {
    const int tid = c.tid, lane = c.lane, wu = __builtin_amdgcn_readfirstlane(c.wid), r32 = lane & 31, hi = lane >> 5;
    const float* sinkp = c.p.in[10];
    const int NU = NB * 32 * NH + NB * 2 * NH;
#pragma unroll 1
    for (int unit = vblock(); unit < NU; unit += c.vgrid) {
        int b, qb, h, q0, nt, ilo;
        bool lat = unit < NB * 32 * NH;
        if (lat) { h = unit & 15; qb = (unit >> 4) & 31; b = unit >> 9; q0 = b * S + qb * 128; ilo = (qb == 0) ? 2 : 0; const int ihi = (qb == 31) ? 3 : 5; nt = 4 + (ihi - ilo + 1); }
        else { const int u2 = unit - NB * 32 * NH; h = u2 & 15; qb = (u2 >> 4) & 1; b = u2 >> 5; q0 = TL + b * C + qb * 128; ilo = 0; nt = 4; }
        const int g = h >> 2;
        const bf16_t* kbase = c.Kb() + (size_t)lane * KD + g * 64 + (2 * wu) * 8;
        const bf16_t* vbase = c.Vb() + (size_t)(16 * wu + (lane >> 2)) * KD + g * 64 + (lane & 3) * 8;
#define AT_STAGE(buf, kr0) do { \
        __builtin_amdgcn_global_load_lds((const unsigned*)(kbase + (size_t)(kr0) * KD), (LAS unsigned*)(c.smem + (buf) * AT_BUF + (2 * wu) * 1024), 16, 0, 0); \
        __builtin_amdgcn_global_load_lds((const unsigned*)(kbase + (size_t)(kr0) * KD + 8), (LAS unsigned*)(c.smem + (buf) * AT_BUF + (2 * wu + 1) * 1024), 16, 0, 0); \
        __builtin_amdgcn_global_load_lds((const unsigned*)(vbase + (size_t)(kr0) * KD), (LAS unsigned*)(c.smem + (buf) * AT_BUF + 8192 + wu * 1024), 16, 0, 0); \
        __builtin_amdgcn_global_load_lds((const unsigned*)(vbase + (size_t)(kr0) * KD + 32), (LAS unsigned*)(c.smem + (buf) * AT_BUF + 8192 + 4096 + wu * 1024), 16, 0, 0); } while (0)
#define AT_KR0(j) ((j) < 4 ? (TL + b * C + (j) * 64) : (b * S + qb * 128 - 128 + 64 * (ilo + (j) - 4)))
        bf16x8 qr[4];
        { const bf16_t* qp = c.Qb() + (size_t)(q0 + 32 * wu + r32) * 1024 + h * 64 + hi * 8;
#pragma unroll
          for (int ds = 0; ds < 4; ++ds) qr[ds] = *(const bf16x8*)(qp + ds * 16); }
        float m = sinkp[h] * LOG2E, l = hi == 0 ? 1.f : 0.f;
        f32x16 o0, o1;
#pragma unroll
        for (int r = 0; r < 16; ++r) { o0[r] = 0.f; o1[r] = 0.f; }
        const int qi = 32 * wu + r32;
        const int vaddr = ((lane >> 4) & 1) * 32 + (lane & 3) * 8 + (4 * hi + ((lane & 15) >> 2)) * 64;
        __syncthreads();
        AT_STAGE(0, AT_KR0(0));
        AT_STAGE(1, AT_KR0(1));
        AT_STAGE(2, AT_KR0(2));
#pragma unroll 1
        for (int j = 0; j < nt; ++j) {
            if (j + 2 < nt) asm volatile("s_waitcnt vmcnt(8)" ::: "memory");
            else if (j + 1 < nt) asm volatile("s_waitcnt vmcnt(4)" ::: "memory");
            else asm volatile("s_waitcnt vmcnt(0)" ::: "memory");
            __builtin_amdgcn_s_barrier();
            asm volatile("" ::: "memory");
            if (j + 3 < nt) { const int kr1 = AT_KR0(j + 3); AT_STAGE((j + 3) & 3, kr1); }
            const ldsp_t kb = c.smem + (j & 3) * AT_BUF, vb = kb + 8192;
            f32x16 p0, p1;
#pragma unroll
            for (int r = 0; r < 16; ++r) { p0[r] = 0.f; p1[r] = 0.f; }
#pragma unroll
            for (int ds = 0; ds < 4; ++ds) {
                const bf16x8 k0 = *(const LAS bf16x8*)(kb + (ds * 2 + hi) * 1024 + r32 * 16);
                const bf16x8 k1 = *(const LAS bf16x8*)(kb + (ds * 2 + hi) * 1024 + (32 + r32) * 16);
                p0 = __builtin_amdgcn_mfma_f32_32x32x16_bf16(k0, qr[ds], p0, 0, 0, 0);
                p1 = __builtin_amdgcn_mfma_f32_32x32x16_bf16(k1, qr[ds], p1, 0, 0, 0);
            }
            if (lat && j >= 4) {
                const int i = ilo + j - 4;
                if (i < 2 || i > 3) {
                    const int kj0 = 64 * i + 4 * hi;
#pragma unroll
                    for (int r = 0; r < 16; ++r) {
                        const int kj = kj0 + (r & 3) + 8 * (r >> 2);
                        if (kj < qi || kj > qi + 256) p0[r] = -INFINITY;
                        if (kj + 32 < qi || kj + 32 > qi + 256) p1[r] = -INFINITY;
                    }
                }
            }
            float mx = fmaxf(p0[0], p1[0]);
#pragma unroll
            for (int r = 1; r < 16; ++r) mx = fmaxf(mx, fmaxf(p0[r], p1[r]));
            mx = fmaxf(mx, __shfl_xor(mx, 32));
            const float mn = fmaxf(m, mx);
            const float alpha = __builtin_amdgcn_exp2f(m - mn);
            m = mn;
            float ls = 0.f;
#pragma unroll
            for (int r = 0; r < 16; ++r) { p0[r] = __builtin_amdgcn_exp2f(p0[r] - mn); p1[r] = __builtin_amdgcn_exp2f(p1[r] - mn); ls += p0[r] + p1[r]; }
            l = l * alpha + ls;
            if (__any(alpha != 1.f)) {
#pragma unroll
                for (int r = 0; r < 16; ++r) { o0[r] *= alpha; o1[r] *= alpha; }
            }
#pragma unroll
            for (int sub = 0; sub < 2; ++sub)
#pragma unroll
                for (int sk = 0; sk < 2; ++sk) {
                    u32x4 pw;
                    if (sub == 0) { pw.x = pk2(p0[8 * sk + 0], p0[8 * sk + 1]); pw.y = pk2(p0[8 * sk + 2], p0[8 * sk + 3]); pw.z = pk2(p0[8 * sk + 4], p0[8 * sk + 5]); pw.w = pk2(p0[8 * sk + 6], p0[8 * sk + 7]); }
                    else { pw.x = pk2(p1[8 * sk + 0], p1[8 * sk + 1]); pw.y = pk2(p1[8 * sk + 2], p1[8 * sk + 3]); pw.z = pk2(p1[8 * sk + 4], p1[8 * sk + 5]); pw.w = pk2(p1[8 * sk + 6], p1[8 * sk + 7]); }
                    const bf16x8 pf = __builtin_bit_cast(bf16x8, pw);
                    const int ko = (sub * 32 + sk * 16) * 64;
                    const s16x4 a0 = vtr(vb + vaddr + ko), a1 = vtr(vb + vaddr + ko + 512);
                    const s16x4 b0 = vtr(vb + 4096 + vaddr + ko), b1 = vtr(vb + 4096 + vaddr + ko + 512);
                    const bf16x8 vf0 = (bf16x8){a0[0], a0[1], a0[2], a0[3], a1[0], a1[1], a1[2], a1[3]};
                    const bf16x8 vf1 = (bf16x8){b0[0], b0[1], b0[2], b0[3], b1[0], b1[1], b1[2], b1[3]};
                    o0 = __builtin_amdgcn_mfma_f32_32x32x16_bf16(vf0, pf, o0, 0, 0, 0);
                    o1 = __builtin_amdgcn_mfma_f32_32x32x16_bf16(vf1, pf, o1, 0, 0, 0);
                }
        }
#undef AT_STAGE
#undef AT_KR0
        l += __shfl_xor(l, 32);
        const float rl = 1.f / l;
        bf16_t* op = c.Ob() + (size_t)(q0 + qi) * 1024 + h * 64 + 4 * hi;
#pragma unroll
        for (int g4 = 0; g4 < 4; ++g4) {
            st_bf16x4(op + 8 * g4, o0[4 * g4] * rl, o0[4 * g4 + 1] * rl, o0[4 * g4 + 2] * rl, o0[4 * g4 + 3] * rl);
            st_bf16x4(op + 32 + 8 * g4, o1[4 * g4] * rl, o1[4 * g4 + 1] * rl, o1[4 * g4 + 2] * rl, o1[4 * g4 + 3] * rl);
        }
    }
}


struct Row16 { float v[2][8]; };
__device__ __forceinline__ void row_load(Row16& x, const float* src, int lane) {
#pragma unroll
    for (int j = 0; j < 2; ++j) { const f32x4 a = *(const f32x4*)(src + j * 512 + lane * 8), b = *(const f32x4*)(src + j * 512 + lane * 8 + 4);
        x.v[j][0] = a[0]; x.v[j][1] = a[1]; x.v[j][2] = a[2]; x.v[j][3] = a[3]; x.v[j][4] = b[0]; x.v[j][5] = b[1]; x.v[j][6] = b[2]; x.v[j][7] = b[3]; }
}
__device__ __forceinline__ void row_store(const Row16& x, float* dst, int lane) {
#pragma unroll
    for (int j = 0; j < 2; ++j) { *(f32x4*)(dst + j * 512 + lane * 8) = (f32x4){x.v[j][0], x.v[j][1], x.v[j][2], x.v[j][3]}; *(f32x4*)(dst + j * 512 + lane * 8 + 4) = (f32x4){x.v[j][4], x.v[j][5], x.v[j][6], x.v[j][7]}; }
}
__device__ __forceinline__ float row_rinv(const Row16& x) {
    float ss = 0.f;
#pragma unroll
    for (int j = 0; j < 2; ++j)
#pragma unroll
        for (int e = 0; e < 8; ++e) ss += x.v[j][e] * x.v[j][e];
    return rsqrtf(wave_sum(ss) * (1.0f / D) + RMS_EPS);
}
__device__ __forceinline__ void row_normmod_store(const Row16& x, float rinv, const float* g, const float* shift, const float* scale, bf16_t* dst, int lane) {
#pragma unroll
    for (int j = 0; j < 2; ++j) {
        const int k = j * 512 + lane * 8; float h[8];
#pragma unroll
        for (int q = 0; q < 2; ++q) { const f32x4 gv = *(const f32x4*)(g + k + 4 * q), sh = *(const f32x4*)(shift + k + 4 * q), sc = *(const f32x4*)(scale + k + 4 * q);
#pragma unroll
            for (int e = 0; e < 4; ++e) h[4 * q + e] = (x.v[j][4 * q + e] * rinv * gv[e]) * (1.f + sc[e]) + sh[e]; }
        u32x4 o; o.x = pk2(h[0], h[1]); o.y = pk2(h[2], h[3]); o.z = pk2(h[4], h[5]); o.w = pk2(h[6], h[7]);
        *(u32x4*)(dst + k) = o;
    }
}
__device__ __forceinline__ void comb_idx(Ctx& c, const int* off, int r, int lane, int& row, float& w) {
    row = 0; w = 0.f;
    if (lane < TOPK) { const int a = r * 8 + lane; row = off[c.AE()[a]] + c.APOS()[a]; w = c.AW()[a]; }
}
__device__ __forceinline__ void row_combine(Row16& x, const bf16_t* Y, int row, float w, const float* g2, int lane) {
#pragma unroll
    for (int j = 0; j < 2; ++j) {
        const int k = j * 512 + lane * 8; float s[8];
#pragma unroll
        for (int e = 0; e < 8; ++e) s[e] = 0.f;
#pragma unroll
        for (int kk = 0; kk < TOPK; ++kk) {
            const int ri = __builtin_amdgcn_readlane(row, kk); const float wk = __int_as_float(__builtin_amdgcn_readlane(__float_as_int(w), kk));
            const u32x4 y = *(const u32x4*)(Y + (size_t)ri * D + k);
            s[0] += wk * __uint_as_float(y.x << 16); s[1] += wk * __uint_as_float(y.x & 0xffff0000u); s[2] += wk * __uint_as_float(y.y << 16); s[3] += wk * __uint_as_float(y.y & 0xffff0000u);
            s[4] += wk * __uint_as_float(y.z << 16); s[5] += wk * __uint_as_float(y.z & 0xffff0000u); s[6] += wk * __uint_as_float(y.w << 16); s[7] += wk * __uint_as_float(y.w & 0xffff0000u); }
        const f32x4 ga = *(const f32x4*)(g2 + k), gb = *(const f32x4*)(g2 + k + 4);
#pragma unroll
        for (int e = 0; e < 4; ++e) { x.v[j][e] += ga[e] * s[e]; x.v[j][4 + e] += gb[e] * s[4 + e]; }
    }
}
__device__ __forceinline__ float* xrow_ptr(Ctx& c, int r) { return r < TL ? c.p.out + (size_t)r * D : c.XC() + (size_t)(r - TL) * D; }
struct Vec16 { float v[2][8]; };
__device__ __forceinline__ void vec_load(Vec16& x, const float* src, int lane) {
#pragma unroll
    for (int j = 0; j < 2; ++j) { const f32x4 a = *(const f32x4*)(src + j * 512 + lane * 8), b = *(const f32x4*)(src + j * 512 + lane * 8 + 4);
        x.v[j][0] = a[0]; x.v[j][1] = a[1]; x.v[j][2] = a[2]; x.v[j][3] = a[3]; x.v[j][4] = b[0]; x.v[j][5] = b[1]; x.v[j][6] = b[2]; x.v[j][7] = b[3]; }
}
__device__ __forceinline__ void row_normmod_store_r(const Row16& x, float rinv, const Vec16& g, const Vec16& sh, const Vec16& sc, bf16_t* dst, int lane) {
#pragma unroll
    for (int j = 0; j < 2; ++j) {
        float h[8];
#pragma unroll
        for (int e = 0; e < 8; ++e) h[e] = (x.v[j][e] * rinv * g.v[j][e]) * (1.f + sc.v[j][e]) + sh.v[j][e];
        u32x4 o; o.x = pk2(h[0], h[1]); o.y = pk2(h[2], h[3]); o.z = pk2(h[4], h[5]); o.w = pk2(h[6], h[7]);
        *(u32x4*)(dst + j * 512 + lane * 8) = o;
    }
}
__device__ __forceinline__ const float* norm_src(Ctx& c, bool input, int r) {
    return input ? (r < TL ? c.p.in[0] + (size_t)r * D : c.p.in[2] + (size_t)(r - TL) * D) : (r < TL ? c.p.out + (size_t)r * D : c.XC() + (size_t)(r - TL) * D);
}
__device__ __forceinline__ void norm_rows(Ctx& c, int T, const float* g, const float* modl, int shc, bool input) {
    const int NW = c.vgrid * 4, w = c.vbid * 4 + c.wid, per = (TL + NW - 1) / NW;
    Vec16 gv, shv, scv; vec_load(gv, g, c.lane);
    int r = w * per; const int rend = (r + per < TL) ? r + per : TL;
    int curb = -1;
    Row16 cur, nxt;
    if (r < rend) row_load(cur, norm_src(c, input, r), c.lane);
#pragma unroll 1
    while (r < rend) {
        if (r + 1 < rend) row_load(nxt, norm_src(c, input, r + 1), c.lane);
        const int b = r >> 12;
        if (b != curb) { const float* m = modl + (size_t)b * 6144 + shc * 1024; vec_load(shv, m, c.lane); vec_load(scv, m + 1024, c.lane); curb = b; }
        row_normmod_store_r(cur, row_rinv(cur), gv, shv, scv, c.H() + (size_t)r * D, c.lane);
        cur = nxt; ++r;
    }
    if (T > TL) {
        const float* m = modl + (size_t)4 * 6144 + shc * 1024;
#pragma unroll 1
        for (int rc = TL + w; rc < T; rc += NW) {
            row_load(cur, norm_src(c, input, rc), c.lane);
            vec_load(shv, m, c.lane); vec_load(scv, m + 1024, c.lane);
            row_normmod_store_r(cur, row_rinv(cur), gv, shv, scv, c.H() + (size_t)rc * D, c.lane);
        }
    }
}
__device__ __forceinline__ void ph_norm1_l0_w(Ctx& c) { norm_rows(c, T0, c.p.in[6], c.mod(), 0, true); }
__device__ __forceinline__ void ph_norm2_w(Ctx& c, int layer) { norm_rows(c, layer == 0 ? T0 : TL, c.p.in[7] + layer * D, c.mod() + (size_t)layer * 5 * 6144, 3, false); }
__device__ __forceinline__ void ph_combine_norm1_w(Ctx& c) {
    int* tbl = (int*)(c.blds + SH_TBL);
    moe_tables(c, 0, T0, tbl);
    const float* g = c.p.in[6] + D;
    const int stride = c.vgrid * 4;
    int r = c.vbid * 4 + c.wid, row = 0; float w = 0.f;
    if (r < T0) comb_idx(c, tbl, r, c.lane, row, w);
#pragma unroll 1
    for (; r < T0; r += stride) {
        Row16 x; row_load(x, xrow_ptr(c, r), c.lane);
        int nrow = 0; float nw = 0.f;
        if (r + stride < T0) comb_idx(c, tbl, r + stride, c.lane, nrow, nw);
        row_combine(x, c.Y(), row, w, c.mod() + (size_t)mod_row(r) * 6144 + 5 * 1024, c.lane);
        row_store(x, xrow_ptr(c, r), c.lane);
        const float* m = c.mod() + ((size_t)5 + mod_row(r)) * 6144;
        row_normmod_store(x, row_rinv(x), g, m, m + 1024, c.H() + (size_t)r * D, c.lane);
        row = nrow; w = nw;
    }
}
__device__ __forceinline__ void ph_final_w(Ctx& c) {
    int* tbl = (int*)(c.blds + SH_TBL);
    moe_tables(c, 1, TL, tbl);
    const float* g = c.p.in[28];
    const int stride = c.vgrid * 4;
    int r = c.vbid * 4 + c.wid, row = 0; float w = 0.f;
    if (r < TL) comb_idx(c, tbl, r, c.lane, row, w);
#pragma unroll 1
    for (; r < TL; r += stride) {
        Row16 x; row_load(x, c.p.out + (size_t)r * D, c.lane);
        int nrow = 0; float nw = 0.f;
        if (r + stride < TL) comb_idx(c, tbl, r + stride, c.lane, nrow, nw);
        row_combine(x, c.Y(), row, w, c.mod() + ((size_t)5 + mod_row(r)) * 6144 + 5 * 1024, c.lane);
        const float rinv = row_rinv(x);
#pragma unroll
        for (int j = 0; j < 2; ++j) { const int k = j * 512 + c.lane * 8; const f32x4 ga = *(const f32x4*)(g + k), gb = *(const f32x4*)(g + k + 4);
#pragma unroll
            for (int e = 0; e < 4; ++e) { x.v[j][e] = x.v[j][e] * rinv * ga[e]; x.v[j][4 + e] = x.v[j][4 + e] * rinv * gb[e]; } }
        row_store(x, c.p.out + (size_t)r * D, c.lane);
        row = nrow; w = nw;
    }
}
struct MEpiRouter { ldsp_t lg;
    __device__ __forceinline__ void operator()(f32x4 (&acc)[4][8], ldsp_t wl, int rbase, int cbase, int lane) const {
        const int fr = lane & 15, fq = lane >> 4, rl = (rbase & 127);
#pragma unroll
        for (int m = 0; m < 4; ++m)
#pragma unroll
            for (int n = 0; n < 2; ++n)
#pragma unroll
                for (int j = 0; j < 4; ++j) *(LAS float*)(lg + ((rl + m * 16 + fr) * 65 + cbase + n * 16 + fq * 4 + j) * 4) = acc[m][n][j];
        __syncthreads();
    }
};
__device__ __forceinline__ void ph_route_m(Ctx& c, int layer) {
    const int T = layer == 0 ? T0 : TL;
    const MEpiRouter ep{c.smem};
    for (int mt = vblock(); mt < T / 128; mt += c.vgrid) {
        router_tile(c.smem, c.H(), c.WROUTER() + (size_t)layer * 128 * D, D, ep, mt * 128);
        LAS unsigned* lcnt = (LAS unsigned*)(c.smem + 128 * 65 * 4);
        if (c.tid < NE) lcnt[c.tid] = 0u;
        __syncthreads();
        int se[TOPK]; float ss[TOPK]; unsigned lp[TOPK]; float norm = 0.f;
        if (c.tid < 128) {
            const LAS float* sc = (const LAS float*)c.smem + c.tid * 65;
            const float* bp = c.p.in[21] + layer * NE;
            float s_[NE], v_[NE];
#pragma unroll
            for (int e = 0; e < NE; ++e) s_[e] = fast_sigmoid(sc[e]);
            float gs[8];
#pragma unroll
            for (int g = 0; g < 8; ++g) {
                float m1 = -INFINITY, m2 = -INFINITY;
#pragma unroll
                for (int i = 0; i < 8; ++i) { const float v = s_[g * 8 + i] + bp[g * 8 + i]; m2 = v > m1 ? m1 : fmaxf(m2, v); m1 = fmaxf(m1, v); }
                gs[g] = m1 + m2;
            }
            unsigned gmask = 0;
#pragma unroll
            for (int it = 0; it < 4; ++it) {
                float best = -INFINITY; int bi = 0;
#pragma unroll
                for (int g = 0; g < 8; ++g) { const bool used = (gmask >> g) & 1u; if (!used && gs[g] > best) { best = gs[g]; bi = g; } }
                gmask |= 1u << bi;
            }
#pragma unroll
            for (int e = 0; e < NE; ++e) v_[e] = ((gmask >> (e >> 3)) & 1u) ? s_[e] + bp[e] : -INFINITY;
            float wsum = 0.f;
#pragma unroll
            for (int it = 0; it < TOPK; ++it) {
                float best = -INFINITY, bs = 0.f; int bi = 0;
#pragma unroll
                for (int e = 0; e < NE; ++e) { const bool t = v_[e] > best; best = t ? v_[e] : best; bi = t ? e : bi; bs = t ? s_[e] : bs; }
#pragma unroll
                for (int e = 0; e < NE; ++e) v_[e] = (e == bi) ? -INFINITY : v_[e];
                se[it] = bi; ss[it] = bs; wsum += bs;
            }
            norm = 2.5f / wsum;
#pragma unroll
            for (int k = 0; k < TOPK; ++k) lp[k] = __hip_atomic_fetch_add(&lcnt[se[k]], 1u, __ATOMIC_RELAXED, __HIP_MEMORY_SCOPE_WORKGROUP);
        }
        __syncthreads();
        if (c.tid < NE) { const unsigned n = lcnt[c.tid]; lcnt[NE + c.tid] = n ? atomicAdd(&c.cnt()[layer * 64 + c.tid], n) : 0u; }
        __syncthreads();
        if (c.tid < 128) {
            const int t = mt * 128 + c.tid;
#pragma unroll
            for (int k = 0; k < TOPK; ++k) {
                const int e = se[k]; const int pos = (int)(lcnt[NE + e] + lp[k]); const int a = t * 8 + k;
                c.AE()[a] = e; c.APOS()[a] = pos; c.AW()[a] = ss[k] * norm; c.LIST()[(size_t)e * T0 + pos] = a;
            }
        }
    }
}

__global__ void __launch_bounds__(NTHREADS) mega(const Params p) {
    __shared__ __attribute__((aligned(16))) unsigned char smem[LDS_TOTAL];
    Ctx c(p, smem);
    volatile unsigned* st = (volatile unsigned*)(smem + SH_ST);
    if (threadIdx.x < 4) st[threadIdx.x] = 0u;
    __syncthreads();
    const XcdBarrier bar = xcd_barrier_post((unsigned*)(p.ws + CTL_BAR), st);
#define GB() do { xcd_barrier(bar); c.refresh(); } while (0)
#define REPEAT(n, stmt) do { for (int rep_ = 0; rep_ < (n); ++rep_) { stmt; if (rep_ + 1 < (n)) GB(); } } while (0)
    REPEAT(REP_PREP, (ph_prep(c), ph_convert_small(c), ph_convert_gates(c), ph_convert_moe(c, 0))); GB();
    {
        if (threadIdx.x == 0) {
            unsigned* ctl = (unsigned*)(p.ws + CTL_BAR);
            const unsigned tk = xb_add((unsigned*)(p.ws + CTL_TICKET) + 64 * bar.x, 1u);
            unsigned base = 0u;
            for (unsigned j = 0; j < 16; ++j) { const unsigned n = xb_ld(&ctl[XB_XCNT(j)]); base += (j < bar.x) ? n : 0u; }
            st[2] = base + tk;
        }
        __syncthreads();
        c.vb = 2 * __builtin_amdgcn_readfirstlane((int)st[2]) + (c.vbid & 1);
    }
    ph_norm1_l0_w(c); GB();
    REPEAT(REP_QKV, ph_qkv_m(c)); GB();
    REPEAT(REP_ATTN, ph_attn_m(c)); GB();
    ph_oproj_m(c); GB();
    REPEAT(REP_NORM2, ph_norm2_w(c, 0)); GB();
    ph_route_m(c, 0); GB();
    REPEAT(REP_GATEUP, ph_moe_gateup_m(c, 0, T0)); GB();
    ph_moe_down_m(c, 0, T0); GB();
    ph_combine_norm1_w(c); ph_convert_moe(c, 1); GB();
    REPEAT(REP_INPROJ, ph_inproj_m(c)); GB();
    REPEAT(REP_LRU1, ph_lru_pass<1>(c)); GB();
    ph_lru_carry(c); GB();
    ph_lru_pass<2>(c); GB();
    ph_outproj_m(c); GB();
    ph_norm2_w(c, 1); GB();
    ph_route_m(c, 1); GB();
    ph_moe_gateup_m(c, 1, TL); GB();
    ph_moe_down_m(c, 1, TL); GB();
    ph_final_w(c);
#undef GB
}
}

extern "C" void kernel_launch(void* const* d_in, const int* in_sizes, int n_in, void* d_out, int out_size, void* d_ws, size_t ws_size, hipStream_t stream) {
    if (n_in != 29 || ws_size < WS_END) { fprintf(stderr, "kernel_launch: unexpected n_in %d or ws_size %zu (< %zu)\n", n_in, ws_size, (size_t)WS_END); return; }
    static int grid = 0;
    if (grid == 0) {
        int dev = 0, cus = 0, per_cu = 0;
        hipGetDevice(&dev);
        hipDeviceGetAttribute(&cus, hipDeviceAttributeMultiprocessorCount, dev);
        hipOccupancyMaxActiveBlocksPerMultiprocessor(&per_cu, (const void*)mega, NTHREADS, 0);
        if (per_cu > 1) per_cu = 1;
        if (per_cu < 1) per_cu = 1;
        grid = cus * per_cu;
    }
    hipMemsetAsync((char*)d_ws + WS_CTL, 0, CTL_BYTES, stream);
    Params p{};
    for (int i = 0; i < 29; ++i) p.in[i] = (const float*)d_in[i];
    p.out = (float*)d_out; p.ws = (unsigned char*)d_ws;
    p.ph_lo = 0; p.ph_hi = 20;
    void* args[] = {&p};
    hipError_t e = hipLaunchCooperativeKernel((const void*)mega, dim3(grid), dim3(NTHREADS), args, 0, stream);
    if (e != hipSuccess) fprintf(stderr, "cooperative launch failed: %s (grid %d)\n", hipGetErrorString(e), grid);
}
```
